# Optimizing an MI355X kernel written in HIP

```python
import jax, jax.numpy as jnp
from jax import lax
import numpy as np

D_MODEL = 1024
BATCH = 2
SEQ = 8192
DEPTH = 4

GRID_W = 64
CTX_LEN = 256
N_BRANCH = 3
BRANCH_W = 512
POOL_WINDOWS = (2, 4, 8, 16)
POOL_GROUPS = 4
POOL_GW = BRANCH_W // POOL_GROUPS
RWKV_HEADS = 8
RWKV_HD = BRANCH_W // RWKV_HEADS
DECAY_LORA = 32
ICLR_LORA = 32
GATE_LORA = 96
GN_EPS = 64e-5
NAT_HEADS = 8
NAT_HD = BRANCH_W // NAT_HEADS
NAT_KH_MAX = 8
NAT_KW = 16
NAT_SCALE = NAT_HD ** -0.5
D_FF = 2816
N_EXPERTS = 8
TOP_K = 2
N_DENSE = (DEPTH + 1) // 2
N_MOE = DEPTH // 2
RMS_EPS = 1e-6
IN_RWKV = 3 * BRANCH_W + 2 * DECAY_LORA + 2 * ICLR_LORA + GATE_LORA
OFF_RWKV = BRANCH_W
OFF_Q = OFF_RWKV + IN_RWKV
OFF_K = OFF_Q + BRANCH_W
OFF_V = OFF_K + BRANCH_W
OFF_GATE = OFF_V + BRANCH_W
IN_TOTAL = OFF_GATE + N_BRANCH * D_MODEL

kernel_name = 'hybrid_pool_rwkv7_nat_moe_dit'


def rms_norm(x, g):
    xf = x.astype(jnp.float32)
    y = xf * lax.rsqrt(jnp.mean(xf * xf, axis=-1, keepdims=True) + RMS_EPS)
    return (y * g.astype(jnp.float32)).astype(x.dtype)


def split_heads(t, n_heads):
    return t.reshape(*t.shape[:-1], n_heads, t.shape[-1] // n_heads)


def centred_pool_minus_identity(z):
    B, T, _ = z.shape
    zf = z.astype(jnp.float32)
    csum = jnp.concatenate([jnp.zeros((B, 1, BRANCH_W), jnp.float32), jnp.cumsum(zf, axis=1)], axis=1)
    t = jnp.arange(T)
    groups = []
    for gi, win in enumerate(POOL_WINDOWS):
        lo = jnp.clip(t - win // 2, 0, T)
        hi = jnp.clip(t - win // 2 + win, 0, T)
        sl = slice(gi * POOL_GW, (gi + 1) * POOL_GW)
        cg = csum[:, :, sl]
        mean = (cg[:, hi] - cg[:, lo]) / (hi - lo).astype(jnp.float32)[None, :, None]
        groups.append(mean - zf[:, :, sl])
    return jnp.stack(groups, axis=2)


def pool_branch(z, pool_w, pool_scale):
    B, T, _ = z.shape
    p = centred_pool_minus_identity(z)
    return jnp.einsum('btgc,gcd->btgd', p, pool_w).reshape(B, T, BRANCH_W) * pool_scale


def centred_shift(z, mu_prev, mu_next):
    zp = jnp.pad(z, ((0, 0), (1, 0), (0, 0)))[:, :-1]
    zn = jnp.pad(z, ((0, 0), (0, 1), (0, 0)))[:, 1:]
    return z + mu_prev * (zp - z) + mu_next * (zn - z)


def rwkv_prepare(zr, w0, w2, a0, a2, k_kk, k_ka):
    B, T, _ = zr.shape
    f32 = jnp.float32
    r, k, v, wlo, alo, glo = jnp.split(zr, [BRANCH_W, 2 * BRANCH_W, 3 * BRANCH_W, 3 * BRANCH_W + 2 * DECAY_LORA, 3 * BRANCH_W + 2 * DECAY_LORA + 2 * ICLR_LORA], axis=-1)
    wlo = wlo.reshape(B, T, 2, DECAY_LORA)
    alo = alo.reshape(B, T, 2, ICLR_LORA)
    w_log = -jax.nn.softplus(-(w0 + jnp.einsum('btdr,drc->btdc', jnp.tanh(wlo), w2)).astype(f32)) - 0.5
    decay = jnp.exp(-jnp.exp(w_log))
    a = jax.nn.sigmoid((a0 + jnp.einsum('btdr,drc->btdc', alo, a2)).astype(f32))
    kk = split_heads((k * k_kk).astype(f32), RWKV_HEADS)
    kk = kk / jnp.maximum(jnp.sqrt(jnp.sum(kk * kk, axis=-1, keepdims=True)), 1e-12)
    k_dir = k.astype(f32)[:, :, None] * (1 + (a - 1) * k_ka.astype(f32))
    hd = lambda t: t.reshape(B, T, 2, RWKV_HEADS, RWKV_HD)
    kka = hd(a) * kk[:, :, None]
    return (split_heads(r.astype(f32), RWKV_HEADS), split_heads(v.astype(f32), RWKV_HEADS), kk, hd(decay), hd(k_dir), kka, glo)


def wkv_scan(state0, decay, k, v, kk, kka, r, reverse):
    seq = lambda t: jnp.moveaxis(t, 1, 0)
    xs = (seq(decay), seq(k), seq(v), seq(kk), seq(kka))
    if r is not None:
        xs = xs + (seq(r),)

    def step(S, inp):
        w_t, k_t, v_t, kk_t, kka_t = inp[:5]
        sa = jnp.einsum('bhij,bhj->bhi', S, kk_t)
        S = S * w_t[:, :, None, :] - sa[..., None] * kka_t[:, :, None, :] + v_t[..., None] * k_t[:, :, None, :]
        out = jnp.einsum('bhij,bhj->bhi', S, inp[5]) if len(inp) == 6 else None
        return S, out

    S, outs = lax.scan(step, state0, xs, reverse=reverse)
    return S, (None if r is None else jnp.moveaxis(outs, 0, 1))


def bidirectional_wkv(lat, cx, need_ctx_out):
    r, v, kk, decay, k_dir, kka, _ = lat
    rc, vc, kkc, decayc, k_dirc, kkac, _ = cx
    B = r.shape[0]
    outs, outs_c = [], []
    for d, reverse in enumerate((False, True)):
        S0 = jnp.zeros((B, RWKV_HEADS, RWKV_HD, RWKV_HD), jnp.float32)
        S_ctx, o_c = wkv_scan(S0, decayc[:, :, d], k_dirc[:, :, d], vc, kkc, kkac[:, :, d], rc if need_ctx_out else None, reverse)
        _, o = wkv_scan(S_ctx, decay[:, :, d], k_dir[:, :, d], v, kk, kka[:, :, d], r, reverse)
        outs.append(o)
        outs_c.append(o_c)
    return outs[0] + outs[1], (outs_c[0] + outs_c[1] if need_ctx_out else None)


def rwkv_readout(wkv, prep, bonus_rk, gn_g, gn_b, gate_g2):
    r, v, _, _, k_dir, _, glo = prep
    B, T = wkv.shape[:2]
    mu = jnp.mean(wkv, axis=-1, keepdims=True)
    var = jnp.mean(jnp.square(wkv - mu), axis=-1, keepdims=True)
    y = ((wkv - mu) * lax.rsqrt(var + GN_EPS)).reshape(B, T, BRANCH_W) * gn_g + gn_b
    bonus = jnp.sum(r[:, :, None] * k_dir * bonus_rk, axis=(2, 4))[..., None] * v
    gate = jax.nn.sigmoid(glo) @ gate_g2
    return (y + bonus.reshape(B, T, BRANCH_W)) * gate


def neighbourhood_attention(q, k, v, kc, vc, rpb):
    B, T, H, hd = q.shape
    rows = T // GRID_W
    kh = min(NAT_KH_MAX, rows)
    qg = jnp.moveaxis(q.reshape(B, rows, GRID_W, H, hd), 1, 0)
    kg = k.reshape(B, rows, GRID_W, H, hd)
    vg = v.reshape(B, rows, GRID_W, H, hd)
    cols = jnp.arange(GRID_W)
    cstart = jnp.clip(cols - NAT_KW // 2, 0, GRID_W - NAT_KW)
    col_idx = cstart[:, None] + jnp.arange(NAT_KW)
    col_off = col_idx - cols[:, None] + (NAT_KW - 1)
    n_loc = kh * NAT_KW

    def row_fn(args):
        r, q_r = args
        rs = jnp.clip(r - kh // 2, 0, rows - kh)
        k_win = lax.dynamic_slice_in_dim(kg, rs, kh, axis=1)[:, :, col_idx]
        v_win = lax.dynamic_slice_in_dim(vg, rs, kh, axis=1)[:, :, col_idx]
        row_off = rs + jnp.arange(kh) - r + (NAT_KH_MAX - 1)
        bias = rpb[:, row_off[None, :, None], col_off[:, None, :]]
        s_loc = jnp.einsum('bqhd,brqchd->bhqrc', q_r, k_win).astype(jnp.float32) + bias.astype(jnp.float32)
        s_ctx = jnp.einsum('bqhd,bchd->bhqc', q_r, kc).astype(jnp.float32)
        s = jnp.concatenate([s_loc.reshape(B, H, GRID_W, n_loc), s_ctx], axis=-1)
        p = jax.nn.softmax(s, axis=-1).astype(v.dtype)
        p_loc = p[..., :n_loc].reshape(B, H, GRID_W, kh, NAT_KW)
        return jnp.einsum('bhqrc,brqchd->bqhd', p_loc, v_win) + jnp.einsum('bhqc,bchd->bqhd', p[..., n_loc:], vc)

    o = lax.map(row_fn, (jnp.arange(rows), qg))
    return jnp.moveaxis(o, 0, 1).reshape(B, T, H * hd)


def context_attention(qc, kc, vc):
    B, L, H, hd = qc.shape
    s = jnp.einsum('bqhd,bkhd->bhqk', qc, kc).astype(jnp.float32)
    p = jax.nn.softmax(s, axis=-1).astype(vc.dtype)
    return jnp.einsum('bhqk,bkhd->bqhd', p, vc).reshape(B, L, H * hd)


def gated_merge(branches, gate_pre, w_branch, w_out):
    B, T, _ = gate_pre.shape
    proj = jnp.einsum('btnc,ncd->btnd', jnp.stack(branches, axis=2), w_branch)
    gates = jax.nn.sigmoid(gate_pre.reshape(B, T, N_BRANCH, D_MODEL))
    return jnp.sum(gates * proj, axis=2) @ w_out


def token_mixer(h, hc, w_in, pool_w, pool_scale, shift_mu, decay_w0, decay_w2, iclr_a0, iclr_a2, key_kk, key_ka, bonus_rk, gn_g, gn_b, gate_g2, nat_qn_g, nat_kn_g, nat_rpb, w_branch, w_out, need_ctx_out):
    splits = [OFF_RWKV, OFF_Q, OFF_K, OFF_V, OFF_GATE]
    zp, zr, zq, zk, zv, zg = jnp.split(h @ w_in, splits, axis=-1)
    if need_ctx_out:
        zpc, zrc, zqc, zkc, zvc, zgc = jnp.split(hc @ w_in, splits, axis=-1)
    else:
        zrc = hc @ w_in[:, OFF_RWKV:OFF_Q]
        zkc, zvc = jnp.split(hc @ w_in[:, OFF_K:OFF_GATE], 2, axis=-1)
    rwkv_p = (decay_w0, decay_w2, iclr_a0, iclr_a2, key_kk, key_ka)
    lat = rwkv_prepare(centred_shift(zr, shift_mu[0], shift_mu[1]), *rwkv_p)
    cx = rwkv_prepare(centred_shift(zrc, shift_mu[0], shift_mu[1]), *rwkv_p)
    wkv, wkv_c = bidirectional_wkv(lat, cx, need_ctx_out)
    kc = rms_norm(split_heads(zkc, NAT_HEADS), nat_kn_g)
    vc = split_heads(zvc, NAT_HEADS)
    q = rms_norm(split_heads(zq, NAT_HEADS), nat_qn_g) * NAT_SCALE
    k = rms_norm(split_heads(zk, NAT_HEADS), nat_kn_g)
    nat = neighbourhood_attention(q, k, split_heads(zv, NAT_HEADS), kc, vc, nat_rpb)
    branches = (pool_branch(zp, pool_w, pool_scale), rwkv_readout(wkv, lat, bonus_rk, gn_g, gn_b, gate_g2), nat)
    y = gated_merge(branches, zg, w_branch, w_out)
    if not need_ctx_out:
        return y, None
    qc = rms_norm(split_heads(zqc, NAT_HEADS), nat_qn_g) * NAT_SCALE
    branches_c = (pool_branch(zpc, pool_w, pool_scale), rwkv_readout(wkv_c, cx, bonus_rk, gn_g, gn_b, gate_g2), context_attention(qc, kc, vc))
    yc = gated_merge(branches_c, zgc, w_branch, w_out)
    return y, yc


def swiglu(h, w1, w3, w2):
    return (jax.nn.silu(h @ w1) * (h @ w3)) @ w2


def moe_swiglu(h, router, w1, w3, w2):
    logits = (h @ router).astype(jnp.float32)
    top_logit, top_idx = lax.top_k(logits, TOP_K)
    top_w = jax.nn.softmax(top_logit, axis=-1)
    gate = jnp.sum(jax.nn.one_hot(top_idx, N_EXPERTS, dtype=jnp.float32) * top_w[..., None], axis=-2)
    out = jnp.zeros_like(h)
    for e in range(N_EXPERTS):
        out = out + gate[..., e:e + 1].astype(h.dtype) * swiglu(h, w1[e], w3[e], w2[e])
    return out


def channel_mixer(h, li, ffn_w1, ffn_w3, ffn_w2, router, moe_w1, moe_w3, moe_w2):
    j = li // 2
    if li % 2 == 0:
        return swiglu(h, ffn_w1[j], ffn_w3[j], ffn_w2[j])
    return moe_swiglu(h, router[j], moe_w1[j], moe_w3[j], moe_w2[j])


def setup_inputs(seed: int = 0) -> dict:
    key = jax.random.key(seed)
    ks = iter(jax.random.split(key, 40))
    nrm = lambda shape, scale: jax.random.normal(next(ks), shape, jnp.float32) * scale
    unif = lambda shape, lo, hi: jax.random.uniform(next(ks), shape, jnp.float32, lo, hi)
    D = D_MODEL
    return {
        'x': nrm((BATCH, SEQ, D), 1.0),
        'c': nrm((BATCH, D), 1.0),
        'ctx': nrm((BATCH, CTX_LEN, D), 1.0),
        'c_ctx': nrm((D,), 1.0),
        'w_mod': nrm((DEPTH, D, 6 * D), 0.5 * D ** -0.5),
        'b_mod': nrm((DEPTH, 6 * D), 0.02),
        'norm_mix_g': 1.0 + nrm((DEPTH, D), 0.05),
        'norm_ffn_g': 1.0 + nrm((DEPTH, D), 0.05),
        'w_in': nrm((DEPTH, D, IN_TOTAL), D ** -0.5),
        'pool_w': nrm((DEPTH, POOL_GROUPS, POOL_GW, POOL_GW), POOL_GW ** -0.5),
        'pool_scale': 1.0 + nrm((DEPTH, BRANCH_W), 0.1),
        'shift_mu': unif((DEPTH, 2, IN_RWKV), 0.0, 0.5),
        'decay_w0': unif((DEPTH, 2, BRANCH_W), -6.0, 1.0),
        'decay_w2': nrm((DEPTH, 2, DECAY_LORA, BRANCH_W), 0.5 * DECAY_LORA ** -0.5),
        'iclr_a0': nrm((DEPTH, 2, BRANCH_W), 0.5),
        'iclr_a2': nrm((DEPTH, 2, ICLR_LORA, BRANCH_W), 0.5 * ICLR_LORA ** -0.5),
        'key_kk': 0.85 + nrm((DEPTH, BRANCH_W), 0.05),
        'key_ka': 1.0 + nrm((DEPTH, BRANCH_W), 0.05),
        'bonus_rk': nrm((DEPTH, RWKV_HEADS, RWKV_HD), 0.1),
        'gn_g': 1.0 + nrm((DEPTH, BRANCH_W), 0.05),
        'gn_b': nrm((DEPTH, BRANCH_W), 0.02),
        'gate_g2': nrm((DEPTH, GATE_LORA, BRANCH_W), GATE_LORA ** -0.5),
        'nat_qn_g': 1.0 + nrm((DEPTH, NAT_HD), 0.05),
        'nat_kn_g': 1.0 + nrm((DEPTH, NAT_HD), 0.05),
        'nat_rpb': nrm((DEPTH, NAT_HEADS, 2 * NAT_KH_MAX - 1, 2 * NAT_KW - 1), 0.2),
        'w_branch': nrm((DEPTH, N_BRANCH, BRANCH_W, D), BRANCH_W ** -0.5),
        'w_out': nrm((DEPTH, D, D), D ** -0.5),
        'ffn_w1': nrm((N_DENSE, D, D_FF), D ** -0.5),
        'ffn_w3': nrm((N_DENSE, D, D_FF), D ** -0.5),
        'ffn_w2': nrm((N_DENSE, D_FF, D), D_FF ** -0.5),
        'router': nrm((N_MOE, D, N_EXPERTS), D ** -0.5),
        'moe_w1': nrm((N_MOE, N_EXPERTS, D, D_FF), D ** -0.5),
        'moe_w3': nrm((N_MOE, N_EXPERTS, D, D_FF), D ** -0.5),
        'moe_w2': nrm((N_MOE, N_EXPERTS, D_FF, D), D_FF ** -0.5),
    }


def reference(x, c, ctx, c_ctx, w_mod, b_mod, norm_mix_g, norm_ffn_g, w_in, pool_w, pool_scale, shift_mu, decay_w0, decay_w2, iclr_a0, iclr_a2, key_kk, key_ka, bonus_rk, gn_g, gn_b, gate_g2, nat_qn_g, nat_kn_g, nat_rpb, w_branch, w_out, ffn_w1, ffn_w3, ffn_w2, router, moe_w1, moe_w3, moe_w2):
    xc = ctx
    for li in range(DEPTH):
        last = li == DEPTH - 1
        mod = jax.nn.silu(c) @ w_mod[li] + b_mod[li]
        mod_c = jax.nn.silu(c_ctx) @ w_mod[li] + b_mod[li]
        sh1, sc1, g1, sh2, sc2, g2 = jnp.split(mod[:, None, :], 6, axis=-1)
        sh1c, sc1c, g1c, sh2c, sc2c, g2c = jnp.split(mod_c, 6)
        h = rms_norm(x, norm_mix_g[li]) * (1 + sc1) + sh1
        hc = rms_norm(xc, norm_mix_g[li]) * (1 + sc1c) + sh1c
        y, yc = token_mixer(h, hc, w_in[li], pool_w[li], pool_scale[li], shift_mu[li], decay_w0[li], decay_w2[li], iclr_a0[li], iclr_a2[li], key_kk[li], key_ka[li], bonus_rk[li], gn_g[li], gn_b[li], gate_g2[li], nat_qn_g[li], nat_kn_g[li], nat_rpb[li], w_branch[li], w_out[li], not last)
        x = x + g1 * y
        h = rms_norm(x, norm_ffn_g[li]) * (1 + sc2) + sh2
        x = x + g2 * channel_mixer(h, li, ffn_w1, ffn_w3, ffn_w2, router, moe_w1, moe_w3, moe_w2)
        if not last:
            xc = xc + g1c * yc
            hc = rms_norm(xc, norm_ffn_g[li]) * (1 + sc2c) + sh2c
            xc = xc + g2c * channel_mixer(hc, li, ffn_w1, ffn_w3, ffn_w2, router, moe_w1, moe_w3, moe_w2)
    return x
```

```cpp
#include <hip/hip_runtime.h>
#include <cstdio>
#include <cstdint>

#ifndef MK_PER_PHASE
#define MK_PER_PHASE 0
#endif

#define GAS __attribute__((address_space(1)))
#define LAS __attribute__((address_space(3)))
typedef unsigned short bf16;
typedef unsigned v4u __attribute__((ext_vector_type(4)));
typedef unsigned v2u __attribute__((ext_vector_type(2)));
typedef float f32x4 __attribute__((ext_vector_type(4)));
typedef float f32x2 __attribute__((ext_vector_type(2)));
typedef short bf16x8 __attribute__((ext_vector_type(8)));
typedef GAS unsigned gu32;

constexpr int D = 1024, NB = 2, T = 8192, DEPTH = 4, CL = 256, GWID = 64, GROWS = 128;
constexpr int MLAT = NB * T, MCTX = NB * CL, M = MLAT + MCTX;
constexpr int BWID = 512, DFF = 2816, NEXP = 8;
constexpr int IN_TOTAL = 6880, NZ = 6912;
constexpr int ZP = 0, ZR = 512, ZK = 1024, ZV = 1536, ZWLO = 2048, ZQ = 2304, ZNK = 2816, ZNV = 3328, ZG = 3840;
constexpr int NLORA = 2560, KLORA = 256;
constexpr int NF1 = 2 * DFF;
constexpr int MAXPANELS = 140;

constexpr size_t MiB = 1u << 20;
constexpr size_t al(size_t x) { return (x + 4095) & ~(size_t)4095; }
constexpr size_t WS_CTL = 0, CTL_ZERO_BYTES = 1 * MiB;
constexpr size_t WS_MOD = WS_CTL + CTL_ZERO_BYTES;
constexpr size_t WS_XSC = al(WS_MOD + (size_t)DEPTH * 3 * 6 * D * 4);
constexpr size_t WS_RT = al(WS_XSC + (size_t)MCTX * D * 4);
constexpr size_t WS_KINV = al(WS_RT + (size_t)M * 32);
constexpr size_t WS_HB = al(WS_KINV + (size_t)M * 8 * 4);
constexpr size_t WS_Y = al(WS_HB + (size_t)M * D * 2);
constexpr int NZB = 3840, NZG = 3072;
static_assert(ZG == NZB && NZB + NZG == NZ, "gate columns");
constexpr size_t WS_WIN = al(WS_Y + (size_t)M * D * 2);
constexpr size_t WS_WING8 = al(WS_WIN + (size_t)DEPTH * NZB * D * 2);
constexpr size_t WS_HB8 = al(WS_WING8 + (size_t)DEPTH * NZG * D);
constexpr size_t WS_Y2 = al(WS_HB8 + (size_t)M * D);
constexpr size_t WS_WLORA = al(WS_Y2 + (size_t)MCTX * D * 2);
constexpr size_t WS_WBR = al(WS_WLORA + (size_t)DEPTH * NLORA * KLORA * 2);
constexpr size_t WS_WOUT = al(WS_WBR + (size_t)DEPTH * 3072 * 512 * 2);
constexpr size_t WS_W13 = al(WS_WOUT + (size_t)DEPTH * D * D * 2);
constexpr size_t WS_W2 = al(WS_W13 + (size_t)2 * NF1 * D * 2);
constexpr size_t WS_MW13 = al(WS_W2 + (size_t)2 * D * DFF * 2);
constexpr size_t WS_MW2 = al(WS_MW13 + (size_t)NEXP * NF1 * D * 2);
constexpr int NCHUNK = (CL + T) / 16;
constexpr int REC_BYTES = 10496, RO_KT = 0, RO_RT = 2048, RO_KA = 4096, RO_OA = 8192, RO_AK = 9216, RO_TT = 9728, RO_WC = 10240;
constexpr size_t WS_FRAG = al(WS_MW2 + (size_t)NEXP * D * DFF * 2);
constexpr size_t WS_ARENA = al(WS_FRAG + (size_t)32 * NCHUNK * REC_BYTES);
constexpr size_t AR_Z = 0;
constexpr size_t AR_BR = al(AR_Z + (size_t)M * NZ * 2);
constexpr size_t AR_LO = al(AR_BR + (size_t)M * 1536 * 2);
constexpr size_t AR_VT = AR_LO + (size_t)M * NLORA * 2;
constexpr size_t AR_P = AR_LO;
constexpr size_t AR_OFB = al(AR_VT + (size_t)M * 512 * 2);
constexpr size_t AR_END_MIX = al(AR_OFB + (size_t)2 * M * 512 * 2);
constexpr size_t AR_HP = 0;
constexpr size_t AR_ACT = al(AR_HP + (size_t)MAXPANELS * 256 * D * 2);
constexpr size_t AR_YP = al(AR_ACT + (size_t)MAXPANELS * 256 * DFF * 2);
constexpr size_t AR_END_FFN = al(AR_YP + (size_t)MAXPANELS * 256 * D * 2);
constexpr size_t ARENA_BYTES = AR_END_MIX > AR_END_FFN ? AR_END_MIX : AR_END_FFN;
constexpr size_t WS_END = WS_ARENA + ARENA_BYTES;
static_assert(AR_P + (size_t)M * 3072 * 2 <= AR_OFB, "P overlays LO+VT only");
static_assert(WS_END <= (size_t)948 * 1000 * 1000, "workspace budget");

constexpr int CW_BAR = 4096;
constexpr int CW_MOE = 16384;
constexpr int CW_BB = 32768;
constexpr int CW_SPM = 52224;
constexpr int CW_DEFB = 53248;
constexpr int CW_DEF = 49152;

constexpr int RING_BYTES = 131072;
constexpr int LDSCTL_OFF = RING_BYTES, MISC_OFF = LDSCTL_OFF + 320;
constexpr int LDS_BYTES = 147456;

#define RLX_AGENT __ATOMIC_RELAXED, __HIP_MEMORY_SCOPE_AGENT
#define LDS_WAIT() asm volatile("s_waitcnt lgkmcnt(0)" ::: "memory")
#define VM_WAIT() asm volatile("s_waitcnt vmcnt(0)" ::: "memory")
typedef __bf16 bf2_t __attribute__((ext_vector_type(2)));
__device__ __forceinline__ unsigned f2bf(float f) { const __bf16 b = (__bf16)f; return (unsigned)__builtin_bit_cast(unsigned short, b); }
__device__ __forceinline__ unsigned pk2(float lo, float hi) { const bf2_t v = __builtin_convertvector((f32x2){lo, hi}, bf2_t); return __builtin_bit_cast(unsigned, v); }
__device__ __forceinline__ float bflo(unsigned u) { return __builtin_bit_cast(float, u << 16); }
__device__ __forceinline__ float bfhi(unsigned u) { return __builtin_bit_cast(float, u & 0xffff0000u); }
__device__ __forceinline__ float bf1(bf16 b) { return __builtin_bit_cast(float, ((unsigned)b) << 16); }
__device__ __forceinline__ void unpack8(const v4u v, float (&o)[8]) { o[0] = bflo(v.x); o[1] = bfhi(v.x); o[2] = bflo(v.y); o[3] = bfhi(v.y); o[4] = bflo(v.z); o[5] = bfhi(v.z); o[6] = bflo(v.w); o[7] = bfhi(v.w); }
__device__ __forceinline__ v4u pack8(const float (&o)[8]) { v4u v; v.x = pk2(o[0], o[1]); v.y = pk2(o[2], o[3]); v.z = pk2(o[4], o[5]); v.w = pk2(o[6], o[7]); return v; }
__device__ __forceinline__ int lane_id() { return (int)__builtin_amdgcn_mbcnt_hi(~0u, __builtin_amdgcn_mbcnt_lo(~0u, 0u)); }
__device__ __forceinline__ float sigmoidf_(float x) { return 1.0f / (1.0f + __expf(-x)); }
__device__ __forceinline__ float sat8(float x) { return fminf(fmaxf(x, -448.0f), 448.0f); }
__device__ __forceinline__ float dppf(float x, const int ctrl_sel) {
    int xi = __builtin_bit_cast(int, x), r;
    if (ctrl_sel == 0) r = __builtin_amdgcn_mov_dpp(xi, 0xB1, 0xF, 0xF, true);
    else if (ctrl_sel == 1) r = __builtin_amdgcn_mov_dpp(xi, 0x4E, 0xF, 0xF, true);
    else r = __builtin_amdgcn_mov_dpp(xi, 0x141, 0xF, 0xF, true);
    return __builtin_bit_cast(float, r);
}
__device__ __forceinline__ float red8_dpp(float v) { v += dppf(v, 0); v += dppf(v, 1); v += dppf(v, 2); return v; }
__device__ __forceinline__ float red8(float v) { return red8_dpp(v); }
__device__ __forceinline__ float wave_sum(float v) {
    v = red8_dpp(v);
    v += __builtin_bit_cast(float, __builtin_amdgcn_mov_dpp(__builtin_bit_cast(int, v), 0x140, 0xF, 0xF, true));
    v += __builtin_bit_cast(float, __builtin_amdgcn_update_dpp(0, __builtin_bit_cast(int, v), 0x142, 0xA, 0xF, false));
    v += __builtin_bit_cast(float, __builtin_amdgcn_update_dpp(0, __builtin_bit_cast(int, v), 0x143, 0xC, 0xF, false));
    return __builtin_bit_cast(float, __builtin_amdgcn_readlane(__builtin_bit_cast(int, v), 63));
}

namespace pg8 {
#define PG8_LAS __attribute__((address_space(3)))
typedef unsigned short bf16_t;
typedef unsigned u32x4 __attribute__((ext_vector_type(4)));
constexpr int BM = 256, BK = 64, HALF = 128, HTB = HALF * BK * 2, STAGE_BYTES = 8 * HTB, NXCD = 8, WGM = 8;

__host__ __device__ __forceinline__ int lds_byte(int r, int c) { const int st = (r >> 4) * 2 + (c >> 5), rr = r & 15, cc = c & 31, ob = rr * 64 + cc * 2; return st * 1024 + (ob ^ (((ob >> 9) & 1) << 5)); }
__host__ __device__ __forceinline__ void stage_rc(int b, int& R, int& C) { const int st = b / 1024, sb = b % 1024, swz = sb ^ (((sb >> 9) & 1) << 5); R = (st >> 1) * 16 + swz / 64; C = (st & 1) * 32 + (swz % 64) / 2; }
__host__ __device__ __forceinline__ int perm32(int rho) { const int n = rho >> 4, i = rho & 15; return 8 * (i >> 2) + 4 * n + (i & 3); }

struct Unit { int pm, pn; const char* a; const char* b; };
struct Gemm { int lda, ldb, K; };

struct TileOrder {
    int nM, nN, nwg, G, c;
    __device__ __forceinline__ void init(int nM_, int nN_, int G_, int c_) { nM = nM_; nN = nN_; nwg = nM * nN; G = G_; c = c_; }
    __device__ __forceinline__ bool tile(int i, int& pm, int& pn) const {
        const long L = (long)i * G + c; if (L >= nwg) return false;
        int wgid = (int)L; { const int q = nwg / NXCD, r = nwg % NXCD, xcd = wgid % NXCD, off = wgid / NXCD; wgid = (xcd < r ? xcd * (q + 1) : r * (q + 1) + (xcd - r) * q) + off; }
        const int nig = WGM * nN, gid = wgid / nig, fm = gid * WGM, gsz = (nM - fm) < WGM ? (nM - fm) : WGM;
        pm = fm + ((wgid % nig) % gsz); pn = (wgid % nig) / gsz; return true;
    }
};

__device__ __forceinline__ unsigned cvt_pk_bf16(float lo, float hi) { unsigned r; asm volatile("v_cvt_pk_bf16_f32 %0, %1, %2" : "=v"(r) : "v"(lo), "v"(hi)); return r; }

template <class Epi, class Sched, bool FP8 = false, bool ALIGN_EPI = true>
__device__ __forceinline__ void gemm_phase(PG8_LAS unsigned char* lds, const Gemm g, const Sched& S, const Epi& E, int wave_id) {
    int tid_ = wave_id * 64 + lane_id(); asm volatile("" : "+v"(tid_));
    const int tid = tid_, wid = __builtin_amdgcn_readfirstlane(tid >> 6), lane = tid & 63, wr = wid >> 2, wc = wid & 3, fr = lane & 15, fq = lane >> 4;
    int K_ = g.K; asm volatile("" : "+s"(K_));
    const int K = K_, nt = K / BK;
    unsigned voffA[2], voffB[2];
#pragma unroll
    for (int i = 0; i < 2; ++i) { int R, C; stage_rc(tid * 16 + i * 8192, R, C); const int Rb = Epi::PERM ? ((R & ~31) + perm32(R & 31)) : R;
        voffA[i] = (unsigned)(R * g.lda + C) * 2u; voffB[i] = (unsigned)(Rb * g.ldb + C) * 2u; }
    const size_t kstep = (size_t)(BK * 2);
    const size_t hstepA = (size_t)HALF * g.lda * 2, hstepB = (size_t)HALF * g.ldb * 2;
    const unsigned ldsw = (unsigned)wid * 1024u;
    const int aoff = lds_byte(wr * 64 + fr, fq * 8), boff = lds_byte(wc * 32 + fr, fq * 8);
#define PG8_SA(b, h) (((b) * 2 + (h)) * HTB)
#define PG8_SB(b, h) ((4 + (b) * 2 + (h)) * HTB)
#define PG8_STAGE(bufoff, gbase, voff) do { _Pragma("unroll") for (int _i = 0; _i < 2; ++_i) \
        __builtin_amdgcn_global_load_lds((const unsigned*)((const char*)(gbase) + (voff)[_i]), (PG8_LAS unsigned*)(lds + (bufoff) + ldsw + _i * 8192), 16, 0, 0); } while (0)
#define PG8_LDA(dst, b, h) do { _Pragma("unroll") for (int m = 0; m < 4; ++m) _Pragma("unroll") for (int k = 0; k < 2; ++k) dst[m][k] = *(const PG8_LAS bf16x8*)(lds + PG8_SA(b, h) + aoff + m * 2048 + k * 1024); } while (0)
#define PG8_LDB(dst, b, h) do { _Pragma("unroll") for (int n = 0; n < 2; ++n) _Pragma("unroll") for (int k = 0; k < 2; ++k) dst[n][k] = *(const PG8_LAS bf16x8*)(lds + PG8_SB(b, h) + boff + n * 2048 + k * 1024); } while (0)
#define PG8_MMA(ai, bj, At, Bt) do { __builtin_amdgcn_s_setprio(1); _Pragma("unroll") for (int m = 0; m < 4; ++m) _Pragma("unroll") for (int n = 0; n < 2; ++n) { \
        if constexpr (FP8) { typedef int v8i_ __attribute__((ext_vector_type(8))); typedef int v4i_ __attribute__((ext_vector_type(4))); \
            const v4i_ b0_ = __builtin_bit_cast(v4i_, Bt[n][0]), b1_ = __builtin_bit_cast(v4i_, Bt[n][1]), a0_ = __builtin_bit_cast(v4i_, At[m][0]), a1_ = __builtin_bit_cast(v4i_, At[m][1]); \
            const v8i_ bo_ = {b0_[0], b0_[1], b0_[2], b0_[3], b1_[0], b1_[1], b1_[2], b1_[3]}, ao_ = {a0_[0], a0_[1], a0_[2], a0_[3], a1_[0], a1_[1], a1_[2], a1_[3]}; \
            asm volatile("v_mfma_scale_f32_16x16x128_f8f6f4 %0, %1, %2, %0, %3, %4 op_sel_hi:[0,0,0]" : "+v"(acc[ai][bj][m][n]) : "v"(bo_), "v"(ao_), "v"(0x7A7A7A7A), "v"(0x7D7D7D7D)); }   \
        else { _Pragma("unroll") for (int k = 0; k < 2; ++k) acc[ai][bj][m][n] = __builtin_amdgcn_mfma_f32_16x16x32_bf16(Bt[n][k], At[m][k], acc[ai][bj][m][n], 0, 0, 0); } } \
        __builtin_amdgcn_s_setprio(0); } while (0)
#define PG8_WAIT_V(n) asm volatile("s_waitcnt vmcnt(" #n ")" ::: "memory")
#define PG8_WAIT_L(n) asm volatile("s_waitcnt lgkmcnt(" #n ")" ::: "memory")
#define PG8_BAR __builtin_amdgcn_s_barrier()
#define PG8_SCHED __builtin_amdgcn_sched_barrier(0)
    Unit cur, nxt; int ui = 0;
    if (!S.next(0, cur)) return;
    f32x4 acc[2][2][4][2];
#pragma unroll
    for (int a = 0; a < 2; ++a)
#pragma unroll
        for (int b = 0; b < 2; ++b)
#pragma unroll
            for (int m = 0; m < 4; ++m)
#pragma unroll
                for (int n = 0; n < 2; ++n) acc[a][b][m][n] = (f32x4){0.f, 0.f, 0.f, 0.f};
    bf16x8 At[4][2], B0[2][2], B1[2][2];
    const char* cA = cur.a; const char* cB = cur.b;
    PG8_STAGE(PG8_SB(0, 0), cB, voffB); PG8_STAGE(PG8_SB(0, 1), cB + hstepB, voffB); PG8_STAGE(PG8_SA(0, 0), cA, voffA); PG8_STAGE(PG8_SA(0, 1), cA + hstepA, voffA);
    if (wr == 1) PG8_BAR;
    PG8_WAIT_V(2); PG8_BAR;
    PG8_STAGE(PG8_SB(1, 0), cB + kstep, voffB); PG8_STAGE(PG8_SA(1, 0), cA + kstep, voffA); PG8_STAGE(PG8_SB(1, 1), cB + hstepB + kstep, voffB);
    PG8_WAIT_V(6); PG8_BAR;
    for (;;) {
        const bool has_next = S.next(ui + 1, nxt);
        const char* nA = has_next ? nxt.a : cA; const char* nB = has_next ? nxt.b : cB;
        for (int t = 0; t < nt; t += 2) {
            const bool last = (t == nt - 2);
            const char* a1 = cA + (size_t)(t + 1) * kstep;
            const char* a2 = last ? nA : cA + (size_t)(t + 2) * kstep; const char* b2 = last ? nB : cB + (size_t)(t + 2) * kstep;
            const char* a3 = a2 + kstep; const char* b3 = b2 + kstep;
            PG8_LDB(B0, 0, 0); PG8_LDB(B1, 0, 1); PG8_SCHED; PG8_LDA(At, 0, 0); PG8_STAGE(PG8_SA(1, 1), a1 + hstepA, voffA);
            PG8_WAIT_V(8); PG8_WAIT_L(0); PG8_BAR; PG8_MMA(0, 0, At, B0); PG8_MMA(0, 1, At, B1); PG8_BAR; PG8_SCHED;
            PG8_LDA(At, 0, 1); PG8_STAGE(PG8_SB(0, 0), b2, voffB); PG8_STAGE(PG8_SB(0, 1), b2 + hstepB, voffB); PG8_STAGE(PG8_SA(0, 0), a2, voffA);
            PG8_WAIT_V(8); PG8_WAIT_L(0); PG8_BAR; PG8_MMA(1, 0, At, B0); PG8_MMA(1, 1, At, B1); PG8_BAR; PG8_SCHED;
            PG8_LDB(B0, 1, 0); PG8_LDB(B1, 1, 1); PG8_SCHED; PG8_LDA(At, 1, 0); PG8_STAGE(PG8_SA(0, 1), a2 + hstepA, voffA);
            PG8_WAIT_V(8); PG8_WAIT_L(0); PG8_BAR; PG8_MMA(0, 0, At, B0); PG8_MMA(0, 1, At, B1); PG8_BAR; PG8_SCHED;
            PG8_LDA(At, 1, 1); PG8_STAGE(PG8_SB(1, 0), b3, voffB); PG8_STAGE(PG8_SB(1, 1), b3 + hstepB, voffB); PG8_STAGE(PG8_SA(1, 0), a3, voffA);
            PG8_WAIT_V(8); PG8_WAIT_L(0); PG8_BAR; PG8_MMA(1, 0, At, B0); PG8_MMA(1, 1, At, B1); PG8_BAR; PG8_SCHED;
        }
        if constexpr (ALIGN_EPI) { if (wr == 0) PG8_BAR; }
        if constexpr (FP8) asm volatile("s_nop 15\n\ts_nop 15" ::: "memory");
        E(acc, cur, wr, wc, fr, fq);
        if (!has_next) break;
#pragma unroll
        for (int a = 0; a < 2; ++a)
#pragma unroll
            for (int b = 0; b < 2; ++b)
#pragma unroll
                for (int m = 0; m < 4; ++m)
#pragma unroll
                    for (int n = 0; n < 2; ++n) acc[a][b][m][n] = (f32x4){0.f, 0.f, 0.f, 0.f};
        cur = nxt; cA = nA; cB = nB; ++ui;
        if constexpr (ALIGN_EPI) { if (wr == 1) PG8_BAR; }
    }
    PG8_WAIT_V(0);
    if constexpr (!ALIGN_EPI) { if (wr == 0) PG8_BAR; }
    PG8_BAR;
#undef PG8_SA
#undef PG8_SB
#undef PG8_STAGE
#undef PG8_LDA
#undef PG8_LDB
#undef PG8_MMA
#undef PG8_WAIT_V
#undef PG8_WAIT_L
#undef PG8_BAR
#undef PG8_SCHED
}

struct DenseSched {
    TileOrder to; const char* A; const char* Bt; size_t a_tile, b_tile; int acol_div; size_t acol_step;
    __device__ __forceinline__ bool next(int i, Unit& u) const {
        int pm, pn; if (!to.tile(i, pm, pn)) return false;
        u.pm = pm; u.pn = pn; u.a = A + (size_t)pm * a_tile + (size_t)(pn / acol_div) * acol_step; u.b = Bt + (size_t)pn * b_tile; return true;
    }
};
struct GroupSched {
    TileOrder to; const char* A; const char* Bt; size_t a_tile, b_tile, b_exp; int pe[9];
    __device__ __forceinline__ bool next(int i, Unit& u) const {
        int pm, pn; if (!to.tile(i, pm, pn)) return false;
        int e = 0;
#pragma unroll
        for (int j = 1; j < 8; ++j) e += (pm >= pe[j]) ? 1 : 0;
        u.pm = pm; u.pn = pn; u.a = A + (size_t)pm * a_tile; u.b = Bt + (size_t)e * b_exp + (size_t)pn * b_tile; return true;
    }
};

struct SingleSched {
    int pm, pn; const char* a; const char* b;
    __device__ __forceinline__ bool next(int i, Unit& u) const { if (i != 0) return false; u.pm = pm; u.pn = pn; u.a = a; u.b = b; return true; }
};
struct EpiBf16 {
    static constexpr bool PERM = true;
    bf16_t* O; int ldc;
    __device__ __forceinline__ void operator()(const f32x4 (&acc)[2][2][4][2], const Unit& u, int wr, int wc, int fr, int fq) const {
        const int row0 = u.pm * BM + wr * 64 + fr, col0 = u.pn * BM + wc * 32 + 8 * fq;
#pragma unroll
        for (int ai = 0; ai < 2; ++ai)
#pragma unroll
            for (int m = 0; m < 4; ++m) { bf16_t* rowp = O + (size_t)(row0 + ai * HALF + m * 16) * ldc + col0;
#pragma unroll
                for (int bj = 0; bj < 2; ++bj) { const f32x4 v0 = acc[ai][bj][m][0], v1 = acc[ai][bj][m][1];
                    u32x4 w; w.x = cvt_pk_bf16(v0[0], v0[1]); w.y = cvt_pk_bf16(v0[2], v0[3]); w.z = cvt_pk_bf16(v1[0], v1[1]); w.w = cvt_pk_bf16(v1[2], v1[3]);
                    *(u32x4*)(rowp + bj * HALF) = w; } }
    }
};
struct EpiGate {
    static constexpr bool PERM = true;
    bf16_t* O; const bf16_t* zg;
    __device__ __forceinline__ void operator()(const f32x4 (&acc)[2][2][4][2], const Unit& u, int wr, int wc, int fr, int fq) const {
        const int row0 = u.pm * BM + wr * 64 + fr, col0 = u.pn * BM + wc * 32 + 8 * fq;
        u32x4 gz[2][4][2];
#pragma unroll
        for (int ai = 0; ai < 2; ++ai)
#pragma unroll
            for (int m = 0; m < 4; ++m)
#pragma unroll
                for (int bj = 0; bj < 2; ++bj) gz[ai][m][bj] = *(const u32x4*)(zg + (size_t)(row0 + ai * HALF + m * 16) * NZ + col0 + bj * HALF);
        asm volatile("" ::: "memory"); __builtin_amdgcn_sched_barrier(0);
#pragma unroll
        for (int ai = 0; ai < 2; ++ai) {
#pragma unroll
            for (int m = 0; m < 4; ++m) { const size_t row = (size_t)(row0 + ai * HALF + m * 16); bf16_t* rowp = O + row * 3072 + col0;
#pragma unroll
                for (int bj = 0; bj < 2; ++bj) { const f32x4 v0 = acc[ai][bj][m][0], v1 = acc[ai][bj][m][1];
                    float gq[8]; unpack8(gz[ai][m][bj], gq);
                    u32x4 w; w.x = cvt_pk_bf16(v0[0] * sigmoidf_(gq[0]), v0[1] * sigmoidf_(gq[1])); w.y = cvt_pk_bf16(v0[2] * sigmoidf_(gq[2]), v0[3] * sigmoidf_(gq[3]));
                    w.z = cvt_pk_bf16(v1[0] * sigmoidf_(gq[4]), v1[1] * sigmoidf_(gq[5])); w.w = cvt_pk_bf16(v1[2] * sigmoidf_(gq[6]), v1[3] * sigmoidf_(gq[7]));
                    *(u32x4*)(rowp + bj * HALF) = w; } }
        }
    }
};
struct EpiLora {
    static constexpr bool PERM = true;
    bf16_t* O; const float* w0; const float* a0;
    __device__ __forceinline__ void operator()(const f32x4 (&acc)[2][2][4][2], const Unit& u, int wr, int wc, int fr, int fq) const {
        const int row0 = u.pm * BM + wr * 64 + fr, col0 = u.pn * BM + wc * 32 + 8 * fq;
        const int seg = u.pn >> 1;
        const float* bias = seg < 2 ? w0 + seg * 512 : a0 + (seg - 2) * 512;
        const int cc = col0 & 511;
        f32x4 bv[2][2];
#pragma unroll
        for (int bj = 0; bj < 2; ++bj) { bv[bj][0] = *(const f32x4*)(bias + cc + bj * HALF); bv[bj][1] = *(const f32x4*)(bias + cc + bj * HALF + 4); }
        asm volatile("" ::: "memory"); __builtin_amdgcn_sched_barrier(0);
#pragma unroll
        for (int ai = 0; ai < 2; ++ai)
#pragma unroll
            for (int m = 0; m < 4; ++m) { bf16_t* rowp = O + (size_t)(row0 + ai * HALF + m * 16) * NLORA + col0;
#pragma unroll
                for (int bj = 0; bj < 2; ++bj) { f32x4 v0 = acc[ai][bj][m][0], v1 = acc[ai][bj][m][1];
                    if (seg < 4) { const f32x4 b0 = bv[bj][0], b1 = bv[bj][1];
                        const float sc = seg < 2 ? -0.60653066f : 1.0f;
#pragma unroll
                        for (int j = 0; j < 4; ++j) { v0[j] = sc * sigmoidf_(v0[j] + b0[j]); v1[j] = sc * sigmoidf_(v1[j] + b1[j]); } }
                    u32x4 w; w.x = cvt_pk_bf16(v0[0], v0[1]); w.y = cvt_pk_bf16(v0[2], v0[3]); w.z = cvt_pk_bf16(v1[0], v1[1]); w.w = cvt_pk_bf16(v1[2], v1[3]);
                    *(u32x4*)(rowp + bj * HALF) = w; } }
    }
};
struct EpiSwiglu8 {
    static constexpr bool PERM = false;
    unsigned char* O;
    __device__ __forceinline__ void operator()(const f32x4 (&acc)[2][2][4][2], const Unit& u, int wr, int wc, int fr, int fq) const {
        const int row0 = u.pm * BM + wr * 64 + fr, col0 = u.pn * 128 + wc * 16 + 4 * fq;
#pragma unroll
        for (int ai = 0; ai < 2; ++ai)
#pragma unroll
            for (int m = 0; m < 4; ++m) { unsigned char* rowp = O + (size_t)(row0 + ai * HALF + m * 16) * DFF + col0;
#pragma unroll
                for (int bj = 0; bj < 2; ++bj) { const f32x4 a = acc[ai][bj][m][0], b = acc[ai][bj][m][1]; float o[4];
#pragma unroll
                    for (int j = 0; j < 4; ++j) o[j] = sat8(4.0f * a[j] * sigmoidf_(a[j]) * b[j]);
                    unsigned w = 0u; w = __builtin_amdgcn_cvt_pk_fp8_f32(o[0], o[1], w, false); w = __builtin_amdgcn_cvt_pk_fp8_f32(o[2], o[3], w, true);
                    *(unsigned*)(rowp + bj * 64) = w; } }
    }
};
struct EpiSwiglu {
    static constexpr bool PERM = false;
    bf16_t* O;
    __device__ __forceinline__ void operator()(const f32x4 (&acc)[2][2][4][2], const Unit& u, int wr, int wc, int fr, int fq) const {
        const int row0 = u.pm * BM + wr * 64 + fr, col0 = u.pn * 128 + wc * 16 + 4 * fq;
#pragma unroll
        for (int ai = 0; ai < 2; ++ai)
#pragma unroll
            for (int m = 0; m < 4; ++m) { bf16_t* rowp = O + (size_t)(row0 + ai * HALF + m * 16) * DFF + col0;
#pragma unroll
                for (int bj = 0; bj < 2; ++bj) { const f32x4 a = acc[ai][bj][m][0], b = acc[ai][bj][m][1]; float o[4];
#pragma unroll
                    for (int j = 0; j < 4; ++j) o[j] = a[j] * sigmoidf_(a[j]) * b[j];
                    v2u w; w.x = cvt_pk_bf16(o[0], o[1]); w.y = cvt_pk_bf16(o[2], o[3]);
                    *(v2u*)(rowp + bj * 64) = w; } }
    }
};
}

#define XB_TMO      128
#define XB_XCNT(j)  (256  + 64 * (j))
#define XB_XSUB(j)  (1280 + 64 * (j))
#define XB_XGEN(j)  (2304 + 64 * (j))
#define XB_TOP      3328
#define XB_TOPGEN   3392
#define XCD_BAR_WORDS 3456
#define XB_SPIN_CAP (1u << 18)
__device__ __forceinline__ unsigned xb_ld(unsigned* p)              { return __hip_atomic_load(p, __ATOMIC_RELAXED, __HIP_MEMORY_SCOPE_AGENT); }
__device__ __forceinline__ unsigned xb_add(unsigned* p, unsigned v) { return __hip_atomic_fetch_add(p, v, __ATOMIC_RELAXED, __HIP_MEMORY_SCOPE_AGENT); }
__device__ __forceinline__ unsigned xb_xcc_id() { return (unsigned)__builtin_amdgcn_s_getreg((3 << 11) | 20) & 0xFu; }
#define XB_SPIN(cond, bar) do { unsigned _sp = 0; while (cond) { __builtin_amdgcn_s_sleep(1); \
    if ((++_sp & 255u) == 0u) { if (xb_ld(&(bar)[XB_TMO])) break; if (_sp > XB_SPIN_CAP) { atomicAdd(&(bar)[XB_TMO], 1u); break; } } } } while (0)
struct XcdBarrier { unsigned* bar; unsigned x; volatile LAS unsigned* st; };
__device__ __forceinline__ XcdBarrier xcd_barrier_post(unsigned* bar, volatile LAS unsigned* st) {
    XcdBarrier b; b.bar = bar; b.x = xb_xcc_id(); b.st = st;
    if (threadIdx.x == 0) (void)xb_add(&bar[XB_XCNT(b.x)], 1u);
    return b;
}
__device__ __forceinline__ void xcd_barrier_complete(unsigned* bar, unsigned x, unsigned& nloc, unsigned& nx) {
    const unsigned G = gridDim.x * gridDim.y * gridDim.z;
    unsigned sum, cnt, mine, sp = 0u;
    for (;;) {
        sum = 0u; cnt = 0u; mine = 0u;
#pragma unroll
        for (unsigned j = 0; j < 16; ++j) { const unsigned c = xb_ld(&bar[XB_XCNT(j)]); sum += c; cnt += (c > 0u) ? 1u : 0u; mine = (j == x) ? c : mine; }
        if (sum == G) break;
        __builtin_amdgcn_s_sleep(1);
        if ((++sp & 255u) == 0u) { if (xb_ld(&bar[XB_TMO])) break; if (sp > XB_SPIN_CAP) { atomicAdd(&bar[XB_TMO], 1u); break; } }
    }
    nloc = mine > 0u ? mine : 1u; nx = cnt > 0u ? cnt : 1u;
}
__device__ __forceinline__ void xcd_barrier(const XcdBarrier& b, int wave_id) {
    asm volatile("s_waitcnt vmcnt(0)" ::: "memory");
    __syncthreads();
    if (wave_id == 0 && lane_id() == 0) {
        unsigned* bar = b.bar;
        __builtin_amdgcn_s_waitcnt(0);
        unsigned nloc = b.st[0], nx = b.st[1];
        if (nloc == 0u) { xcd_barrier_complete(bar, b.x, nloc, nx); b.st[0] = nloc; b.st[1] = nx; }
        const unsigned old = xb_add(&bar[XB_XSUB(b.x)], 1u);
        const unsigned gen = old / nloc;
        if (old + 1u == (gen + 1u) * nloc) {
            __builtin_amdgcn_fence(__ATOMIC_RELEASE, "agent");
            asm volatile("s_waitcnt vmcnt(0)" ::: "memory");
            const unsigned og = xb_add(&bar[XB_TOP], 1u);
            const unsigned tg = og / nx;
            asm volatile("buffer_inv sc1" ::: "memory");
            if (og + 1u == (tg + 1u) * nx) xb_add(&bar[XB_TOPGEN], 1u);
            else XB_SPIN(xb_ld(&bar[XB_TOPGEN]) == tg, bar);
            xb_add(&bar[XB_XGEN(b.x)], 1u);
            asm volatile("s_waitcnt vmcnt(0)" ::: "memory");
        } else {
            asm volatile("buffer_inv sc1" ::: "memory");
            XB_SPIN(xb_ld(&bar[XB_XGEN(b.x)]) == gen, bar);
            asm volatile("s_waitcnt vmcnt(0)" ::: "memory");
        }
    }
    __syncthreads();
}

struct Args { const float* in[34]; float* out; unsigned char* ws; int ph_lo, ph_hi; };
typedef const __attribute__((address_space(4))) Args* KArgs;
#define KIN(ka, i) ((const float*)(const GAS float*)(ka)->in[i])
__device__ __forceinline__ KArgs kargs() { KArgs p = (KArgs)__builtin_amdgcn_kernarg_segment_ptr(); asm volatile("" : "+s"(p)); return p; }
enum { I_X = 0, I_C, I_CTX, I_CCTX, I_WMOD, I_BMOD, I_NMG, I_NFG, I_WIN, I_POOLW, I_POOLS, I_SHMU, I_DW0, I_DW2, I_A0, I_A2, I_KKK, I_KKA, I_BONUS, I_GNG, I_GNB, I_GG2,
       I_QNG, I_KNG, I_RPB, I_WBR, I_WOUT, I_F1, I_F3, I_F2, I_ROUTER, I_M1, I_M3, I_M2 };

struct Frame {
    LAS unsigned char* lds;
    unsigned char* ws;
    int tid, lane, wave, vcu, G;
};
__device__ __forceinline__ void frame_refresh(Frame& F) {
    int w_ = __builtin_amdgcn_readfirstlane(F.wave); asm volatile("" : "+s"(w_));
    int t = w_ * 64 + lane_id(); asm volatile("" : "+v"(t));
    F.tid = t; F.lane = t & 63; F.wave = w_;
    unsigned long long w = (unsigned long long)F.ws; { const unsigned lo_ = __builtin_amdgcn_readfirstlane((unsigned)w), hi_ = __builtin_amdgcn_readfirstlane((unsigned)(w >> 32)); w = ((unsigned long long)hi_ << 32) | lo_; }
    asm volatile("" : "+s"(w)); F.ws = (unsigned char*)(GAS unsigned char*)w;
}

struct MapPlain { int off; __device__ __forceinline__ int operator()(int n) const { return n + off; } };
struct MapWin { __device__ __forceinline__ int operator()(int n) const { return n < 2272 ? n : n + 32; } };
struct MapF13 { int add; __device__ __forceinline__ int operator()(int n) const { return 32 * (n >> 4) + (n & 15) + add; } };
template <class RowMap>
__device__ __forceinline__ void tr_item(const float* W, int ldw, int k0, int n0, bf16* WT, int ldt, const RowMap rm, LAS float* scr, int lane) {
    float tv[32];
#pragma unroll
    for (int i = 0; i < 32; ++i) { const int kk = 2 * i + (lane >> 5); tv[i] = W[(size_t)(k0 + kk) * ldw + n0 + (lane & 31)]; }
#pragma unroll
    for (int i = 0; i < 32; ++i) { const int kk = 2 * i + (lane >> 5); scr[kk * 33 + (lane & 31)] = tv[i]; }
    LDS_WAIT(); asm volatile("" ::: "memory");
    const int c = lane & 7;
#pragma unroll
    for (int j = 0; j < 4; ++j) { const int n = (lane >> 3) + 8 * j; const LAS float* s = scr + (8 * c) * 33 + n;
        v4u o; o.x = pk2(s[0 * 33], s[1 * 33]); o.y = pk2(s[2 * 33], s[3 * 33]); o.z = pk2(s[4 * 33], s[5 * 33]); o.w = pk2(s[6 * 33], s[7 * 33]);
        *(GAS v4u*)(WT + (size_t)rm(n0 + n) * ldt + k0 + 8 * c) = o; }
    LDS_WAIT(); asm volatile("" ::: "memory");
}


template <class RowMap>
__device__ __forceinline__ void tr_item8(const float* W, int ldw, int k0, int n0, unsigned char* WT, int ldt, const RowMap rm, LAS float* scr, int lane) {
    float tv[32];
#pragma unroll
    for (int i = 0; i < 32; ++i) { const int kk = 2 * i + (lane >> 5); tv[i] = W[(size_t)(k0 + kk) * ldw + n0 + (lane & 31)]; }
#pragma unroll
    for (int i = 0; i < 32; ++i) { const int kk = 2 * i + (lane >> 5); scr[kk * 33 + (lane & 31)] = tv[i]; }
    LDS_WAIT(); asm volatile("" ::: "memory");
    const int c = lane & 3;
#pragma unroll
    for (int j = 0; j < 2; ++j) { const int n = (lane >> 2) + 16 * j; const LAS float* s = scr + (16 * c) * 33 + n; unsigned w[4];
#pragma unroll
        for (int q = 0; q < 4; ++q) { unsigned x = 0u; x = __builtin_amdgcn_cvt_pk_fp8_f32(sat8(32.f * s[(4 * q) * 33]), sat8(32.f * s[(4 * q + 1) * 33]), x, false); x = __builtin_amdgcn_cvt_pk_fp8_f32(sat8(32.f * s[(4 * q + 2) * 33]), sat8(32.f * s[(4 * q + 3) * 33]), x, true); w[q] = x; }
        *(GAS v4u*)(WT + (size_t)rm(n0 + n) * ldt + k0 + 16 * c) = (v4u){w[0], w[1], w[2], w[3]}; }
    LDS_WAIT(); asm volatile("" ::: "memory");
}
__device__ __forceinline__ void moe_convert(Frame& F, const Args& args, int j) {
    frame_refresh(F); KArgs KA = kargs();
    unsigned char* ws = F.ws;
    const int gw = F.vcu * 8 + F.wave, NGW = F.G * 8, lane = F.lane;
    LAS float* scr = (LAS float*)(F.lds + F.wave * 16384);
    constexpr int IT_F13 = 16 * 88, IT_F2 = 44 * 32, H0 = 16 * IT_F13, H1 = H0 + 8 * IT_F2;
    for (int it = gw; it < H1; it += NGW) {
        if (it < H0) { const int job = it / IT_F13, r = it % IT_F13, kb = r / 88, nb = r % 88; const int e = job >> 1, w3 = job & 1;
            tr_item8(KIN(KA, w3 ? I_M3 : I_M1) + (size_t)(j * NEXP + e) * D * DFF, DFF, kb * 64, nb * 32, ws + WS_MW13 + (size_t)e * NF1 * D, D, MapF13{w3 * 16}, scr, lane); }
        else { const int q = it - H0, e = q / IT_F2, r = q % IT_F2, kb = r / 32, nb = r % 32;
            tr_item8(KIN(KA, I_M2) + (size_t)(j * NEXP + e) * DFF * D, D, kb * 64, nb * 32, ws + WS_MW2 + (size_t)e * D * DFF, DFF, MapPlain{0}, scr, lane); }
    }
}

__device__ __forceinline__ void p0_prologue(Frame& F, const Args& args) {
    frame_refresh(F); KArgs KA = kargs();
    unsigned char* ws = F.ws;
    const int gw = F.vcu * 8 + F.wave, NGW = F.G * 8, lane = F.lane;
    {
        LAS float* scr = (LAS float*)(F.lds + F.wave * 16384);
        constexpr int IT_WIN = 16 * 199, IT_BR = 8 * 32, IT_OUT = 16 * 32, IT_F13 = 16 * 88, IT_F2 = 44 * 32;
        constexpr int G0 = 4 * IT_WIN, G1 = G0 + 12 * IT_BR, G2 = G1 + 4 * IT_OUT, G3 = G2 + 4 * IT_F13, G4 = G3 + 2 * IT_F2;
        for (int it = gw; it < G4; it += NGW) {
            if (it < G0) { const int job = it / IT_WIN, r = it % IT_WIN, kb = r / 199, nb = r % 199;
                if (nb < 103) tr_item(KIN(KA, I_WIN) + (size_t)job * D * IN_TOTAL, IN_TOTAL, kb * 64, 512 + nb * 32, (bf16*)(ws + WS_WIN) + (size_t)job * NZB * D, D, MapWin{}, scr, lane);
                else tr_item8(KIN(KA, I_WIN) + (size_t)job * D * IN_TOTAL, IN_TOTAL, kb * 64, 512 + nb * 32, ws + WS_WING8 + (size_t)job * NZG * D, D, MapPlain{-3808}, scr, lane); }
            else if (it < G1) { const int q = it - G0, job = q / IT_BR, r = q % IT_BR, kb = r / 32, nb = r % 32;
                const int l = job / 3, n = job % 3;
                tr_item(KIN(KA, I_WBR) + (size_t)job * 512 * D, D, kb * 64, nb * 32, (bf16*)(ws + WS_WBR) + (size_t)l * 3072 * 512, 512, MapPlain{n * 1024}, scr, lane); }
            else if (it < G2) { const int q = it - G1, job = q / IT_OUT, r = q % IT_OUT, kb = r / 32, nb = r % 32;
                tr_item(KIN(KA, I_WOUT) + (size_t)job * D * D, D, kb * 64, nb * 32, (bf16*)(ws + WS_WOUT) + (size_t)job * D * D, D, MapPlain{0}, scr, lane); }
            else if (it < G3) { const int q = it - G2, job = q / IT_F13, r = q % IT_F13, kb = r / 88, nb = r % 88;
                const int j = job >> 1, w3 = job & 1;
                tr_item(KIN(KA, w3 ? I_F3 : I_F1) + (size_t)j * D * DFF, DFF, kb * 64, nb * 32, (bf16*)(ws + WS_W13) + (size_t)j * NF1 * D, D, MapF13{w3 * 16}, scr, lane); }
            else { const int q = it - G3, job = q / IT_F2, r = q % IT_F2, kb = r / 32, nb = r % 32;
                tr_item(KIN(KA, I_F2) + (size_t)job * DFF * D, D, kb * 64, nb * 32, (bf16*)(ws + WS_W2) + (size_t)job * D * DFF, DFF, MapPlain{0}, scr, lane); }
        }
    }
    moe_convert(F, args, 0);
    for (int u = F.vcu; u < DEPTH * D; u += F.G) {
        const int l = u >> 10, k = u & 1023, gd = F.tid, g = gd >> 7, d = gd & 127;
        const float* wi = KIN(KA, I_WIN) + ((size_t)l * D + k) * IN_TOTAL + g * 128;
        const float* pw = KIN(KA, I_POOLW) + ((size_t)(l * 4 + g) * 128) * 128 + d;
        float s = 0.f;
#pragma unroll 8
        for (int c = 0; c < 128; ++c) s += wi[c] * pw[(size_t)c * 128];
        s *= KIN(KA, I_POOLS)[l * 512 + gd];
        ((bf16*)(ws + WS_WIN))[((size_t)l * NZB + gd) * D + k] = (bf16)f2bf(s);
    }
    for (size_t i = (size_t)blockIdx.x * 512 + F.tid; i < (size_t)DEPTH * NLORA * KLORA; i += (size_t)F.G * 512) {
        const int kk = (int)(i & 255), n = (int)((i >> 8) % NLORA), l = (int)(i / ((size_t)NLORA * KLORA));
        const int seg = n >> 9, c = n & 511; float v = 0.f;
        if (seg < 2) { if ((kk >> 5) == seg) v = KIN(KA, I_DW2)[(((size_t)l * 2 + seg) * 32 + (kk & 31)) * 512 + c]; }
        else if (seg < 4) { if ((kk >> 5) == seg) v = KIN(KA, I_A2)[(((size_t)l * 2 + (seg - 2)) * 32 + (kk & 31)) * 512 + c]; }
        else { if (kk >= 128 && kk < 224) v = KIN(KA, I_GG2)[((size_t)l * 96 + (kk - 128)) * 512 + c]; }
        ((bf16*)(ws + WS_WLORA))[i] = (bf16)f2bf(v);
    }
    {
        __syncthreads();
        LAS float* sc = (LAS float*)F.lds;
        LAS float* red = (LAS float*)(F.lds + 16384);
        for (int i = F.tid; i < 3 * D; i += 512) { const int s = i >> 10, k = i & 1023; const float c = s < 2 ? KIN(KA, I_C)[s * D + k] : KIN(KA, I_CCTX)[k]; sc[i] = c * sigmoidf_(c); }
        __syncthreads();
        const int kq = F.tid >> 6, nl = F.tid & 63;
        for (int u = F.vcu; u < DEPTH * 96; u += F.G) {
            const int l = u / 96, n = (u % 96) * 64 + nl;
            const float* wm = KIN(KA, I_WMOD) + (size_t)l * D * 6 * D + n;
            float s0 = 0.f, s1 = 0.f, s2 = 0.f;
#pragma unroll 32
            for (int k = kq * 128; k < kq * 128 + 128; ++k) { const float w = wm[(size_t)k * 6 * D]; s0 += sc[k] * w; s1 += sc[D + k] * w; s2 += sc[2 * D + k] * w; }
            red[(kq * 64 + nl) * 3 + 0] = s0; red[(kq * 64 + nl) * 3 + 1] = s1; red[(kq * 64 + nl) * 3 + 2] = s2;
            __syncthreads();
            if (F.tid < 192) { const int s = F.tid >> 6; float a = KIN(KA, I_BMOD)[l * 6 * D + n];
#pragma unroll
                for (int q = 0; q < 8; ++q) a += red[(q * 64 + nl) * 3 + s];
                ((float*)(ws + WS_MOD))[((size_t)l * 3 + s) * 6 * D + n] = a; }
            __syncthreads();
        }
    }
}

__device__ __forceinline__ void norm_phase(Frame& F, const Args& args, const float* xlat_in, const float* xctx_in, int ymode, const float* gate_mod  ,
                                           const float* gn, const float* sc_mod, const float* sh_mod, bool moe_route, const float* router, int moe_j, int rblk, int rnb, int rbase, int rcount  ,
                                           unsigned char* hb8 = nullptr  ,
                                           int rbase2 = 0, int rcount2 = 0, int ymode2 = 0, unsigned* wcnt = nullptr, unsigned wneed = 0  ) {
    frame_refresh(F); KArgs KA = kargs();
    unsigned char* ws = F.ws;
    const int gw = rblk * 8 + F.wave, NGW = rnb * 8, lane = F.lane;
    float* xs_lat = ((float*)(GAS float*)KA->out); float* xs_ctx = (float*)(ws + WS_XSC);
    bf16* HB = (bf16*)(ws + WS_HB); const bf16* Y = (const bf16*)(ws + WS_Y); const bf16* Y2 = (const bf16*)(ws + WS_Y2); const bf16* YP = (const bf16*)(ws + WS_ARENA + AR_YP);
    unsigned* RT = (unsigned*)(ws + WS_RT);
    LAS float* rl = (LAS float*)F.lds;
    LAS unsigned* lcnt = (LAS unsigned*)(F.lds + 32768);
    if (moe_route) {
        __syncthreads();
        for (int i = F.tid; i < D * 8; i += 512) rl[i] = router[i];
        if (F.tid < 8) lcnt[F.tid] = 0u;
        __syncthreads();
    }
    struct NormIn { f32x4 x[4]; v2u ya[4], yb[4]; float w0, w1; unsigned r0, r1; };
#define NORM_RT(mm, R) do { R.w0 = 0.f; R.w1 = 0.f; R.r0 = 0u; R.r1 = 0u; \
        if (ymode == 2) { const v4u rt = *(const v4u*)(RT + (size_t)(mm) * 8); const v4u rt2 = *(const v4u*)(RT + (size_t)(mm) * 8 + 4); R.w0 = __uint_as_float(rt.z); R.w1 = __uint_as_float(rt.w); R.r0 = rt2.x; R.r1 = rt2.y; } } while (0)
#define NORM_LOAD(mm, R) do { const bool lat_ = (mm) < MLAT; const float* xin_ = lat_ ? xlat_in + (size_t)(mm) * D : xctx_in + (size_t)((mm) - MLAT) * D; \
        _Pragma("unroll") for (int j = 0; j < 4; ++j) { const int col = 4 * lane + 256 * j; R.x[j] = *(const f32x4*)(xin_ + col); R.ya[j] = (v2u){0u, 0u}; R.yb[j] = (v2u){0u, 0u}; \
            if (ymode == 1 || ymode == 3) R.ya[j] = *(const v2u*)(Y + (size_t)(mm) * D + col); \
            if (ymode == 3) R.yb[j] = *(const v2u*)(Y2 + (size_t)((mm) - MLAT) * D + col);     \
            if (ymode == 2) { R.ya[j] = *(const v2u*)(YP + (size_t)R.r0 * D + col); R.yb[j] = *(const v2u*)(YP + (size_t)R.r1 * D + col); } } } while (0)
#define NORM_COMPUTE(mm, R) do { const int m = (mm); const bool lat = m < MLAT; const int srow = lat ? (m >> 13) : 2; \
        float* xo = lat ? xs_lat + (size_t)m * D : xs_ctx + (size_t)(m - MLAT) * D; \
        f32x4 v[4]; float ss = 0.f; \
        _Pragma("unroll") for (int j = 0; j < 4; ++j) { const int col = 4 * lane + 256 * j; v[j] = R.x[j]; \
            if (ymode != 0) { f32x4 yv; const v2u ya = R.ya[j], yb = R.yb[j]; \
                if (ymode == 1) yv = (f32x4){bflo(ya.x), bfhi(ya.x), bflo(ya.y), bfhi(ya.y)}; \
                else if (ymode == 3) yv = (f32x4){bflo(ya.x) + bflo(yb.x), bfhi(ya.x) + bfhi(yb.x), bflo(ya.y) + bflo(yb.y), bfhi(ya.y) + bfhi(yb.y)}; \
                else yv = (f32x4){R.w0 * bflo(ya.x) + R.w1 * bflo(yb.x), R.w0 * bfhi(ya.x) + R.w1 * bfhi(yb.x), R.w0 * bflo(ya.y) + R.w1 * bflo(yb.y), R.w0 * bfhi(ya.y) + R.w1 * bfhi(yb.y)}; \
                const f32x4 gt = *(const f32x4*)(gate_mod + (size_t)srow * 6 * D + col); v[j] = v[j] + gt * yv; } \
            *(f32x4*)(xo + col) = v[j]; ss += (v[j].x * v[j].x + v[j].y * v[j].y) + (v[j].z * v[j].z + v[j].w * v[j].w); } \
        const float rinv = 1.0f / sqrtf(wave_sum(ss) * (1.f / D) + 1e-6f); \
        float lg[8]; _Pragma("unroll") for (int e = 0; e < 8; ++e) lg[e] = 0.f; \
        _Pragma("unroll") for (int j = 0; j < 4; ++j) { const int col = 4 * lane + 256 * j; \
            const f32x4 g4 = *(const f32x4*)(gn + col), s4 = *(const f32x4*)(sc_mod + (size_t)srow * 6 * D + col), h4 = *(const f32x4*)(sh_mod + (size_t)srow * 6 * D + col); \
            const f32x4 h = v[j] * rinv * g4 * (s4 + 1.0f) + h4; \
            if (moe_route) { unsigned w8 = 0u; w8 = __builtin_amdgcn_cvt_pk_fp8_f32(sat8(4.f * h.x), sat8(4.f * h.y), w8, false); w8 = __builtin_amdgcn_cvt_pk_fp8_f32(sat8(4.f * h.z), sat8(4.f * h.w), w8, true); \
                *(unsigned*)((unsigned char*)HB + (size_t)m * D + col) = w8; }     \
            else { v2u o; o.x = pk2(h.x, h.y); o.y = pk2(h.z, h.w); *(v2u*)(HB + (size_t)m * D + col) = o; \
                if (hb8) { unsigned w8 = 0u; w8 = __builtin_amdgcn_cvt_pk_fp8_f32(sat8(4.f * h.x), sat8(4.f * h.y), w8, false); w8 = __builtin_amdgcn_cvt_pk_fp8_f32(sat8(4.f * h.z), sat8(4.f * h.w), w8, true); \
                    *(unsigned*)(hb8 + (size_t)m * D + col) = w8; } } \
            if (moe_route) { _Pragma("unroll") for (int q = 0; q < 4; ++q) { const f32x4 ra = *(const LAS f32x4*)(rl + (col + q) * 8), rb = *(const LAS f32x4*)(rl + (col + q) * 8 + 4); const float hv = h[q]; \
                lg[0] += hv * ra.x; lg[1] += hv * ra.y; lg[2] += hv * ra.z; lg[3] += hv * ra.w; lg[4] += hv * rb.x; lg[5] += hv * rb.y; lg[6] += hv * rb.z; lg[7] += hv * rb.w; } } } \
        if (moe_route) { _Pragma("unroll") for (int e = 0; e < 8; ++e) lg[e] = wave_sum(lg[e]); \
            int i0 = 0; float b0 = lg[0]; _Pragma("unroll") for (int e = 1; e < 8; ++e) if (lg[e] > b0) { b0 = lg[e]; i0 = e; } \
            int i1 = -1; float b1 = -3.0e38f; _Pragma("unroll") for (int e = 0; e < 8; ++e) if (e != i0 && lg[e] > b1) { b1 = lg[e]; i1 = e; } \
            const float p0 = 1.0f / (1.0f + __expf(b1 - b0)), p1 = 1.0f - p0; \
            if (lane == 0) { const unsigned q0 = __hip_atomic_fetch_add(&lcnt[i0], 1u, __ATOMIC_RELAXED, __HIP_MEMORY_SCOPE_WORKGROUP), q1 = __hip_atomic_fetch_add(&lcnt[i1], 1u, __ATOMIC_RELAXED, __HIP_MEMORY_SCOPE_WORKGROUP); \
                v4u a; a.x = (unsigned)i0; a.y = (unsigned)i1; a.z = __builtin_bit_cast(unsigned, p0); a.w = __builtin_bit_cast(unsigned, p1); v4u b; b.x = q0; b.y = q1; b.z = (unsigned)F.vcu; b.w = 0u;     \
                *(v4u*)(RT + (size_t)m * 8) = a; *(v4u*)(RT + (size_t)m * 8 + 4) = b; } } } while (0)
#pragma unroll 1
    for (int pass = 0; pass < (rcount2 > 0 ? 2 : 1); ++pass) {
    if (pass == 1) {
        rbase = rbase2; rcount = rcount2; ymode = ymode2;
        if (F.tid == 0) { unsigned sp = 0; while ((__hip_atomic_load(wcnt, RLX_AGENT) < wneed || __hip_atomic_load(wcnt + 64, RLX_AGENT) < wneed) && ++sp < (1u << 21)) __builtin_amdgcn_s_sleep(2);
            __builtin_amdgcn_fence(__ATOMIC_ACQUIRE, "agent"); asm volatile("s_waitcnt vmcnt(0)" ::: "memory"); }
        __syncthreads(); }
    for (int i0 = gw; i0 < rcount; i0 += 4 * NGW) {
        const int m0 = rbase + i0, m1 = m0 + NGW, m2 = m1 + NGW, m3 = m2 + NGW; const bool h1 = i0 + NGW < rcount, h2 = i0 + 2 * NGW < rcount, h3 = i0 + 3 * NGW < rcount;
        NormIn RA, RB, RC, RD;
        NORM_RT(m0, RA); if (h1) NORM_RT(m1, RB); if (h2) NORM_RT(m2, RC); if (h3) NORM_RT(m3, RD);
        NORM_LOAD(m0, RA); if (h1) NORM_LOAD(m1, RB); if (h2) NORM_LOAD(m2, RC); if (h3) NORM_LOAD(m3, RD);
        NORM_COMPUTE(m0, RA);
        if (h1) NORM_COMPUTE(m1, RB);
        if (h2) NORM_COMPUTE(m2, RC);
        if (h3) NORM_COMPUTE(m3, RD);
    }
    }
#undef NORM_RT
#undef NORM_LOAD
#undef NORM_COMPUTE
    if (moe_route) {
        __syncthreads();
        if (F.tid < 8) { unsigned* ctl = (unsigned*)(ws + WS_CTL);
            const unsigned base = __hip_atomic_fetch_add(ctl + CW_MOE + moe_j * 64 + F.tid, lcnt[F.tid], RLX_AGENT);
            ctl[CW_BB + (moe_j * 256 + F.vcu) * 8 + F.tid] = base; }
    }
}

__device__ __forceinline__ void moe_prefix(const unsigned* cnt, int (&pe)[9]) {
    pe[0] = 0;
#pragma unroll
    for (int e = 0; e < 8; ++e) pe[e + 1] = pe[e] + (int)((cnt[e] + 255u) >> 8);
}
__device__ __forceinline__ void moe_perm_phase(Frame& F, int moe_j, int mrows) {
    frame_refresh(F);
    unsigned char* ws = F.ws;
    const int gw = F.vcu * 8 + F.wave, NGW = F.G * 8, lane = F.lane;
    const unsigned* ctl = (const unsigned*)(ws + WS_CTL);
    unsigned cnt[8];
#pragma unroll
    for (int e = 0; e < 8; ++e) cnt[e] = ctl[CW_MOE + moe_j * 64 + e];
    int pe[9]; moe_prefix(cnt, pe);
    unsigned* RT = (unsigned*)(ws + WS_RT); const unsigned char* HB = ws + WS_HB; unsigned char* HP = ws + WS_ARENA + AR_HP;
    for (int m = gw; m < mrows; m += NGW) {
        const v4u a = *(const v4u*)(RT + (size_t)m * 8); const v4u b = *(const v4u*)(RT + (size_t)m * 8 + 4);
        const int blk = (int)b.z;
        const int e0 = (int)a.x, e1 = (int)a.y;
        int p0 = 0, p1 = 0;
#pragma unroll
        for (int e = 0; e < 8; ++e) { if (e == e0) p0 = pe[e] * 256; if (e == e1) p1 = pe[e] * 256; }
        p0 += (int)ctl[CW_BB + (moe_j * 256 + blk) * 8 + e0] + (int)b.x;
        p1 += (int)ctl[CW_BB + (moe_j * 256 + blk) * 8 + e1] + (int)b.y;
        const v4u* src = (const v4u*)(HB + (size_t)m * D);
        v4u* d0 = (v4u*)(HP + (size_t)p0 * D); v4u* d1 = (v4u*)(HP + (size_t)p1 * D);
        const v4u x0 = src[lane];
        d0[lane] = x0; d1[lane] = x0;
        if (lane == 0) { v4u nb; nb.x = (unsigned)p0; nb.y = (unsigned)p1; nb.z = 0u; nb.w = 0u; *(v4u*)(RT + (size_t)m * 8 + 4) = nb; }
    }
}

__device__ __forceinline__ void seq_of_row(int m, int& seq0, int& t, int& Tn) {
    if (m < MLAT) { seq0 = m & ~(T - 1); t = m & (T - 1); Tn = T; } else { const int mc = m - MLAT; seq0 = MLAT + (mc & ~(CL - 1)); t = mc & (CL - 1); Tn = CL; }
}
struct Sh8 { v4u c, p, n; bool hp, hn; };
__device__ __forceinline__ void sh8_load(Sh8& s, const bf16* Z, int m, int t, int Tn, int col) {
    s.hp = t > 0; s.hn = t < Tn - 1;
    s.c = *(const v4u*)(Z + (size_t)m * NZ + col); s.p = *(const v4u*)(Z + (size_t)(s.hp ? m - 1 : m) * NZ + col); s.n = *(const v4u*)(Z + (size_t)(s.hn ? m + 1 : m) * NZ + col);
}
__device__ __forceinline__ void sh8_eval(const Sh8& s, const float* mup, const float* mun, float (&o)[8]) {
    float c[8], p[8], n[8]; unpack8(s.c, c); unpack8(s.p, p); unpack8(s.n, n);
    const f32x4 mp0 = *(const f32x4*)mup, mp1 = *(const f32x4*)(mup + 4), mn0 = *(const f32x4*)mun, mn1 = *(const f32x4*)(mun + 4);
#pragma unroll
    for (int j = 0; j < 8; ++j) { const float a = j < 4 ? mp0[j & 3] : mp1[j & 3], b = j < 4 ? mn0[j & 3] : mn1[j & 3]; const float pj = s.hp ? p[j] : 0.f, nj = s.hn ? n[j] : 0.f; o[j] = c[j] + a * (pj - c[j]) + b * (nj - c[j]); }
}
__device__ __forceinline__ void prep_phase(Frame& F, const Args& args, int l) {
    frame_refresh(F); KArgs KA = kargs();
    unsigned char* ws = F.ws;
    const int gw = F.vcu * 8 + F.wave, NGW = F.G * 8, lane = F.lane;
    const bf16* Z = (const bf16*)(ws + WS_ARENA + AR_Z);
    bf16* BR = (bf16*)(ws + WS_ARENA + AR_BR); bf16* LA = (bf16*)(ws + WS_HB); float* KINV = (float*)(ws + WS_KINV);
    bf16* QN = (bf16*)(ws + WS_Y); bf16* KN = QN + (size_t)M * 512;
    const float* mu0 = KIN(KA, I_SHMU) + (size_t)l * 2 * 1760; const float* mu1 = mu0 + 1760;
    const float* kkw = KIN(KA, I_KKK) + l * 512; const float* qng = KIN(KA, I_QNG) + l * 64; const float* kng = KIN(KA, I_KNG) + l * 64;
    const int mbeg = (int)(((long)gw * M) / NGW), mend = (int)(((long)(gw + 1) * M) / NGW);
    float S[8];
#pragma unroll
    for (int j = 0; j < 8; ++j) S[j] = 0.f;
    for (int m = mbeg; m < mend; ++m) {
        int seq0, t, Tn; seq_of_row(m, seq0, t, Tn);
        const int g = lane >> 4, half = 1 << g; const int lo = t - half < 0 ? 0 : t - half, hi = t + half > Tn ? Tn : t + half;
        const bool ent = t + half < Tn, lev = t - half >= 0;
        const v4u zc = *(const v4u*)(Z + (size_t)(seq0 + t) * NZ + ZP + lane * 8);
        const v4u ze = *(const v4u*)(Z + (size_t)(seq0 + (ent ? t + half : t)) * NZ + ZP + lane * 8), zl = *(const v4u*)(Z + (size_t)(seq0 + (lev ? t - half : t)) * NZ + ZP + lane * 8);
        Sh8 sk, sl; sh8_load(sk, Z, m, t, Tn, ZK + lane * 8); sh8_load(sl, Z, m, t, Tn, ZWLO + (lane < 28 ? lane : 0) * 8);
        const v4u zq = *(const v4u*)(Z + (size_t)m * NZ + ZQ + lane * 8), zk = *(const v4u*)(Z + (size_t)m * NZ + ZNK + lane * 8);
        if (m == mbeg || t == 0) {
            v4u ptap[16];
#pragma unroll
            for (int o = -8; o < 8; ++o) { const int s_ = t + o; const bool in = s_ >= lo && s_ < hi; ptap[o + 8] = *(const v4u*)(Z + (size_t)(seq0 + (in ? s_ : t)) * NZ + ZP + lane * 8); }
#pragma unroll
            for (int j = 0; j < 8; ++j) S[j] = 0.f;
#pragma unroll
            for (int o = -8; o < 8; ++o) { const int s_ = t + o; const float wgt = (s_ >= lo && s_ < hi) ? 1.f : 0.f; float q[8]; unpack8(ptap[o + 8], q);
#pragma unroll
                for (int j = 0; j < 8; ++j) S[j] += wgt * q[j]; }
        }
        asm volatile("" ::: "memory"); __builtin_amdgcn_sched_barrier(0);
        { float q[8], qe[8], ql[8], acc[8]; unpack8(zc, q); unpack8(ze, qe); unpack8(zl, ql);
          const float inv = 1.0f / (float)(hi - lo), we = ent ? 1.f : 0.f, wl = lev ? 1.f : 0.f;
#pragma unroll
          for (int j = 0; j < 8; ++j) { acc[j] = S[j] * inv - q[j]; S[j] += we * qe[j] - wl * ql[j]; }
          *(v4u*)(BR + (size_t)m * 1536 + lane * 8) = pack8(acc); }
        { float ks[8]; sh8_eval(sk, mu0 + 512 + lane * 8, mu1 + 512 + lane * 8, ks);
          float ss = 0.f;
#pragma unroll
          for (int j = 0; j < 8; ++j) { const float q = ks[j] * kkw[lane * 8 + j]; ss += q * q; }
          ss = red8(ss);
          if ((lane & 7) == 0) KINV[(size_t)m * 8 + (lane >> 3)] = 1.0f / fmaxf(sqrtf(ss), 1e-12f); }
        if (lane < 32) { float o[8];
          if (lane < 28) { sh8_eval(sl, mu0 + 1536 + lane * 8, mu1 + 1536 + lane * 8, o);
#pragma unroll
              for (int j = 0; j < 8; ++j) { if (lane < 8) o[j] = tanhf(o[j]); else if (lane >= 16) o[j] = sigmoidf_(o[j]); } }
          else {
#pragma unroll
              for (int j = 0; j < 8; ++j) o[j] = 0.f; }
          *(v4u*)(LA + (size_t)m * KLORA + lane * 8) = pack8(o); }
        { float q[8], k[8]; unpack8(zq, q); unpack8(zk, k); float sq = 0.f, sk2 = 0.f;
#pragma unroll
          for (int j = 0; j < 8; ++j) { sq += q[j] * q[j]; sk2 += k[j] * k[j]; }
          sq = red8(sq); sk2 = red8(sk2);
          const float rq = (0.125f * 1.4426950408889634f) / sqrtf(sq * (1.f / 64.f) + 1e-6f), rk = 1.0f / sqrtf(sk2 * (1.f / 64.f) + 1e-6f);
#pragma unroll
          for (int j = 0; j < 8; ++j) { q[j] = q[j] * rq * qng[(lane & 7) * 8 + j]; k[j] = k[j] * rk * kng[(lane & 7) * 8 + j]; }
          *(v4u*)(QN + (size_t)m * 512 + lane * 8) = pack8(q); *(v4u*)(KN + (size_t)m * 512 + lane * 8) = pack8(k); }
    }
    {
        bf16* VT = (bf16*)(ws + WS_ARENA + AR_VT); bf16* VTC = VT + (size_t)NB * 8 * 64 * T;
        LAS unsigned char* tile = F.lds;
        for (int u = F.vcu; u < M / 64; u += F.G) {
            const int m0 = u * 64;
            __syncthreads();
#pragma unroll
            for (int i = 0; i < 8; ++i) { const int id = F.tid + 512 * i, row = id >> 6, ch = id & 63;
                *(LAS v4u*)(tile + row * 1040 + ch * 16) = *(const v4u*)(Z + (size_t)(m0 + row) * NZ + ZNV + ch * 8); }
            __syncthreads();
            const int c = F.tid, h = c >> 6, dim = c & 63;
            bf16* dst; if (m0 < MLAT) { const int b = m0 >> 13, t0 = m0 & (T - 1); dst = VT + ((size_t)(b * 8 + h) * 64 + dim) * T + t0; }
            else { const int mc = m0 - MLAT, b = mc >> 8, t0 = mc & (CL - 1); dst = VTC + ((size_t)(b * 8 + h) * 64 + dim) * CL + t0; }
#pragma unroll
            for (int tg = 0; tg < 8; ++tg) { unsigned short e[8];
#pragma unroll
                for (int j = 0; j < 8; ++j) e[j] = *(const LAS unsigned short*)(tile + (tg * 8 + j) * 1040 + c * 2);
                v4u o; o.x = e[0] | ((unsigned)e[1] << 16); o.y = e[2] | ((unsigned)e[3] << 16); o.z = e[4] | ((unsigned)e[5] << 16); o.w = e[6] | ((unsigned)e[7] << 16);
                *(v4u*)(dst + tg * 8) = o; }
        }
        __syncthreads();
    }
}

__device__ __forceinline__ f32x4 mfma16(const v4u a, const v4u b, const f32x4 c) {
    return __builtin_amdgcn_mfma_f32_16x16x32_bf16(__builtin_bit_cast(bf16x8, a), __builtin_bit_cast(bf16x8, b), c, 0, 0, 0);
}
#define WAVE_LDS_SYNC() do { asm volatile("s_waitcnt lgkmcnt(0)" ::: "memory"); __builtin_amdgcn_wave_barrier(); asm volatile("" ::: "memory"); } while (0)
constexpr int SP_MID0 = 264, SP_NMID = 16;
__device__ __forceinline__ void scanpre_phase(Frame& F, const Args& args, int l, int mid) {
    frame_refresh(F); KArgs KA = kargs();
    unsigned char* ws = F.ws;
    const int gw = F.vcu * 8 + F.wave, NGW = F.G * 8, lane = F.lane, fr = lane & 15, fq = lane >> 4;
    const bf16* Z = (const bf16*)(ws + WS_ARENA + AR_Z); const bf16* LO = (const bf16*)(ws + WS_ARENA + AR_LO); const float* KINV = (const float*)(ws + WS_KINV);
    unsigned char* FR = ws + WS_FRAG; v2u* VFR = (v2u*)(ws + WS_HB);
    LAS unsigned char* wl = F.lds + F.wave * 16384;
    LAS unsigned char* XK = wl; LAS unsigned char* XR = wl + 2304; LAS unsigned char* XH = wl + 4608; LAS unsigned char* XA = wl + 6912;
    LAS unsigned char* VTt = wl + 9216; LAS unsigned char* KWT = wl + 11264; LAS unsigned char* AWT = wl + 13312;
    LAS float* At = (LAS float*)(wl + 15360);
    const float* mu0 = KIN(KA, I_SHMU) + (size_t)l * 2 * 1760; const float* mu1 = mu0 + 1760;
#define SP_DIR(DIRV, SH1, SH2, SH4, SH8, SHT, LOPTR, RECID) do { int ln__ = lane; asm volatile("" : "+v"(ln__)); const int tf = ln__ & 15, cq = ln__ >> 4, ch0 = h * 64 + cq * 16; \
        const int taud = (DIRV) ? 15 - tf : tf; \
        const v4u ldh_[2] = {*(const v4u*)((LOPTR) + ch0), *(const v4u*)((LOPTR) + ch0 + 8)}, avh_[2] = {*(const v4u*)((LOPTR) + 1024 + ch0), *(const v4u*)((LOPTR) + 1024 + ch0 + 8)};     \
        _Pragma("unroll") for (int hh = 0; hh < 2; ++hh) { unsigned xk[4], xr[4], xh[4], xa[4]; float ldv[8], avv[8]; unpack8(ldh_[hh], ldv); unpack8(avh_[hh], avv); \
            int zo = 0; asm volatile("" : "+v"(zo)); \
            const f32x4 ka0 = *(const f32x4*)(KIN(KA, I_KKA) + l * 512 + ch0 + hh * 8 + zo), ka1 = *(const f32x4*)(KIN(KA, I_KKA) + l * 512 + ch0 + hh * 8 + 4 + zo); \
            _Pragma("unroll") for (int j = 0; j < 8; ++j) { const int c = hh * 8 + j; \
                float Lc = ldv[j];     \
                Lc += __builtin_bit_cast(float, __builtin_amdgcn_update_dpp(0, __builtin_bit_cast(int, Lc), SH1, 0xF, 0xF, true)); \
                Lc += __builtin_bit_cast(float, __builtin_amdgcn_update_dpp(0, __builtin_bit_cast(int, Lc), SH2, 0xF, 0xF, true)); \
                Lc += __builtin_bit_cast(float, __builtin_amdgcn_update_dpp(0, __builtin_bit_cast(int, Lc), SH4, 0xF, 0xF, true)); \
                Lc += __builtin_bit_cast(float, __builtin_amdgcn_update_dpp(0, __builtin_bit_cast(int, Lc), SH8, 0xF, 0xF, true)); \
                const float L15 = __builtin_bit_cast(float, __builtin_amdgcn_update_dpp(0, __builtin_bit_cast(int, Lc), SHT, 0xF, 0xF, true)); \
                const float kaw = j < 4 ? ka0[j & 3] : ka1[j & 3]; \
                const float rs_c = (c & 1) ? bfhi(rsp[c >> 1]) : bflo(rsp[c >> 1]), ks_c = (c & 1) ? bfhi(ksp[c >> 1]) : bflo(ksp[c >> 1]), vs_c = (c & 1) ? bfhi(vsp[c >> 1]) : bflo(vsp[c >> 1]), kk_c = (c & 1) ? bfhi(kkp[c >> 1]) : bflo(kkp[c >> 1]); \
                const float kd = ks_c * (1.0f + (avv[j] - 1.0f) * kaw), kka = avv[j] * kk_c; \
                const float eW = __expf(Lc), ePrev = __expf(Lc - ldv[j]), eInv = __expf(-Lc), eEnd = __expf(L15 - Lc); \
                const unsigned bk = f2bf(kk_c * ePrev), br = f2bf(rs_c * eW), bh = f2bf(kd * eInv), ba = f2bf(kka * eInv); \
                if (j & 1) { xk[j >> 1] |= bk << 16; xr[j >> 1] |= br << 16; xh[j >> 1] |= bh << 16; xa[j >> 1] |= ba << 16; } else { xk[j >> 1] = bk; xr[j >> 1] = br; xh[j >> 1] = bh; xa[j >> 1] = ba; } \
                *(LAS unsigned short*)(VTt + (cq * 16 + c) * 32 + taud * 2) = (unsigned short)f2bf(vs_c); \
                *(LAS unsigned short*)(KWT + (cq * 16 + c) * 32 + taud * 2) = (unsigned short)f2bf(kd * eEnd); \
                *(LAS unsigned short*)(AWT + (cq * 16 + c) * 32 + taud * 2) = (unsigned short)f2bf(-kka * eEnd); \
                if (taud == 15) *(float*)(FR + (size_t)(RECID) * REC_BYTES + RO_WC + (cq * 16 + c) * 4) = __expf(Lc); } \
            *(LAS v4u*)(XK + taud * 144 + cq * 32 + hh * 16) = (v4u){xk[0], xk[1], xk[2], xk[3]}; *(LAS v4u*)(XR + taud * 144 + cq * 32 + hh * 16) = (v4u){xr[0], xr[1], xr[2], xr[3]}; \
            *(LAS v4u*)(XH + taud * 144 + cq * 32 + hh * 16) = (v4u){xh[0], xh[1], xh[2], xh[3]}; *(LAS v4u*)(XA + taud * 144 + cq * 32 + hh * 16) = (v4u){xa[0], xa[1], xa[2], xa[3]}; \
            __builtin_amdgcn_sched_barrier(0); } } while (0)
#define SP_STAGE2(RECID) do { \
        WAVE_LDS_SYNC(); \
        int ln__ = lane; asm volatile("" : "+v"(ln__)); const int lane_ = ln__, fr = ln__ & 15, fq = ln__ >> 4;     \
        v4u kf[2], rf[2], hf[2], af[2]; \
        _Pragma("unroll") for (int s = 0; s < 2; ++s) { kf[s] = *(const LAS v4u*)(XK + fr * 144 + 64 * s + 16 * fq); rf[s] = *(const LAS v4u*)(XR + fr * 144 + 64 * s + 16 * fq); \
            hf[s] = *(const LAS v4u*)(XH + fr * 144 + 64 * s + 16 * fq); af[s] = *(const LAS v4u*)(XA + fr * 144 + 64 * s + 16 * fq); } \
        const f32x4 z4 = (f32x4){0.f, 0.f, 0.f, 0.f}; \
        f32x4 Akk = mfma16(hf[0], kf[0], z4); Akk = mfma16(hf[1], kf[1], Akk); \
        f32x4 Aka = mfma16(af[0], kf[0], z4); Aka = mfma16(af[1], kf[1], Aka); \
        f32x4 Ark = mfma16(hf[0], rf[0], z4); Ark = mfma16(hf[1], rf[1], Ark); \
        f32x4 Ara = mfma16(af[0], rf[0], z4); Ara = mfma16(af[1], rf[1], Ara); \
        _Pragma("unroll") for (int j = 0; j < 4; ++j) { const int tp = 4 * fq + j; const bool lt = tp < fr, le = tp <= fr; \
            Akk[j] = lt ? Akk[j] : 0.f; Aka[j] = lt ? Aka[j] : 0.f; Ark[j] = le ? Ark[j] : 0.f; Ara[j] = le ? Ara[j] : 0.f; \
            At[(4 * fq + j) * 16 + fr] = Aka[j]; } \
        WAVE_LDS_SYNC(); \
        float Tr[16]; \
        _Pragma("unroll") for (int s = 0; s < 16; ++s) Tr[s] = (s == fr) ? 1.f : 0.f; \
        _Pragma("unroll") for (int c = 14; c >= 0; --c) { float arow[16]; \
            _Pragma("unroll") for (int g = 0; g < 4; ++g) { const f32x4 a4 = *(const LAS f32x4*)(At + c * 16 + 4 * g); arow[4 * g] = a4.x; arow[4 * g + 1] = a4.y; arow[4 * g + 2] = a4.z; arow[4 * g + 3] = a4.w; } \
            float acc = 0.f; \
            _Pragma("unroll") for (int s = c + 1; s < 16; ++s) acc += Tr[s] * arow[s]; \
            Tr[c] = (c < fr) ? -acc : Tr[c]; \
            if ((c & 1) == 0) __builtin_amdgcn_sched_barrier(0); } \
        float T4[4]; \
        _Pragma("unroll") for (int j = 0; j < 4; ++j) T4[j] = fq == 0 ? Tr[j] : (fq == 1 ? Tr[4 + j] : (fq == 2 ? Tr[8 + j] : Tr[12 + j])); \
        unsigned char* rec = FR + (size_t)(RECID) * REC_BYTES; \
        _Pragma("unroll") for (int s = 0; s < 2; ++s) { \
            const v2u klo = *(const LAS v2u*)(XK + fr * 144 + (32 * s + 4 * fq) * 2), khi = *(const LAS v2u*)(XK + fr * 144 + (32 * s + 16 + 4 * fq) * 2); \
            const v2u rlo = *(const LAS v2u*)(XR + fr * 144 + (32 * s + 4 * fq) * 2), rhi = *(const LAS v2u*)(XR + fr * 144 + (32 * s + 16 + 4 * fq) * 2); \
            *(v4u*)(rec + RO_KT + s * 1024 + lane_ * 16) = (v4u){klo.x, klo.y, khi.x, khi.y}; \
            *(v4u*)(rec + RO_RT + s * 1024 + lane_ * 16) = (v4u){rlo.x, rlo.y, rhi.x, rhi.y}; } \
        _Pragma("unroll") for (int kt = 0; kt < 4; ++kt) { const v2u kwv = *(const LAS v2u*)(KWT + (16 * kt + fr) * 32 + 8 * fq), awv = *(const LAS v2u*)(AWT + (16 * kt + fr) * 32 + 8 * fq); \
            *(v4u*)(rec + RO_KA + kt * 1024 + lane_ * 16) = (v4u){kwv.x, kwv.y, awv.x, awv.y}; } \
        *(v4u*)(rec + RO_OA + lane_ * 16) = (v4u){pk2(Ark[0], Ark[1]), pk2(Ark[2], Ark[3]), pk2(-Ara[0], -Ara[1]), pk2(-Ara[2], -Ara[3])}; \
        *(v2u*)(rec + RO_AK + lane_ * 8) = (v2u){pk2(Akk[0], Akk[1]), pk2(Akk[2], Akk[3])}; \
        *(v2u*)(rec + RO_TT + lane_ * 8) = (v2u){pk2(T4[0], T4[1]), pk2(T4[2], T4[3])}; \
        _Pragma("unroll") for (int w = 0; w < 4; ++w) VFR[((size_t)(RECID) * 4 + w) * 64 + lane_] = *(const LAS v2u*)(VTt + (16 * w + fr) * 32 + 8 * fq); \
        WAVE_LDS_SYNC(); } while (0)
    int t0_ = gw, tstep = NGW, tend = 16 * (NCHUNK - SP_NMID);
    if (mid) { const int nw = ((int)blockIdx.x - 32) * 8 + F.wave; tstep = 1 << 20; tend = 16 * SP_NMID; t0_ = (nw % 7 == 0) ? nw / 7 : tend; }
    for (int tk = t0_; tk < tend; tk += tstep) {
        int bh, blk;
        if (mid) { bh = tk >> 4; blk = SP_MID0 + (tk & 15); } else { bh = tk >> 9; const int j_ = tk & 511; blk = j_ < SP_MID0 ? j_ : j_ + SP_NMID; }
        static_assert(NCHUNK - SP_NMID == 512, "task decode");
        const int h = bh & 7, b = bh >> 3;
        int m0, t0, Tn;
        if (blk < CL / 16) { t0 = 16 * blk; Tn = CL; m0 = MLAT + b * CL + t0; } else { t0 = 16 * (blk - CL / 16); Tn = T; m0 = b * T + t0; }
        const int recF = ((b << 4) | (h << 1) | 0) * NCHUNK + blk;
        const int recB = ((b << 4) | (h << 1) | 1) * NCHUNK + (blk < CL / 16 ? CL / 16 - 1 - blk : NCHUNK - 1 - (blk - CL / 16));
        int lnt_ = lane; asm volatile("" : "+v"(lnt_)); const int tf_ = lnt_ & 15, cq_ = lnt_ >> 4;
        const int fr = tf_, fq = cq_;
        const int tf = tf_, cq = cq_, ch0 = h * 64 + cq * 16;
        const int tt = t0 + tf; const int m = m0 + tf;
        const bool okP = tt > 0, okN = tt < Tn - 1;
        const bf16* zc = Z + (size_t)m * NZ + ch0; const bf16* zp = Z + (size_t)(okP ? m - 1 : m) * NZ + ch0; const bf16* zn = Z + (size_t)(okN ? m + 1 : m) * NZ + ch0;
        const float kinv = KINV[(size_t)m * 8 + h];
        unsigned rsp[8], ksp[8], vsp[8], kkp[8];
#pragma unroll
        for (int hh = 0; hh < 2; ++hh) {
            int zo = 0; asm volatile("" : "+v"(zo));
            v4u raw[3][3];
#pragma unroll
            for (int tn = 0; tn < 3; ++tn) { raw[tn][0] = *(const v4u*)(zc + ZR + tn * 512 + hh * 8 + zo); raw[tn][1] = *(const v4u*)(zp + ZR + tn * 512 + hh * 8 + zo); raw[tn][2] = *(const v4u*)(zn + ZR + tn * 512 + hh * 8 + zo); }
            const f32x4 kw0 = *(const f32x4*)(KIN(KA, I_KKK) + l * 512 + ch0 + hh * 8 + zo), kw1 = *(const f32x4*)(KIN(KA, I_KKK) + l * 512 + ch0 + hh * 8 + 4 + zo);
            float xs_[3][8];
#pragma unroll
            for (int tn = 0; tn < 3; ++tn) { float c[8], p[8], n[8]; unpack8(raw[tn][0], c); unpack8(raw[tn][1], p); unpack8(raw[tn][2], n);
                const f32x4 mp0 = *(const f32x4*)(mu0 + tn * 512 + ch0 + hh * 8 + zo), mp1 = *(const f32x4*)(mu0 + tn * 512 + ch0 + hh * 8 + 4 + zo), mn0 = *(const f32x4*)(mu1 + tn * 512 + ch0 + hh * 8 + zo), mn1 = *(const f32x4*)(mu1 + tn * 512 + ch0 + hh * 8 + 4 + zo);
#pragma unroll
                for (int j = 0; j < 8; ++j) { const float wp = j < 4 ? mp0[j & 3] : mp1[j & 3], wn = j < 4 ? mn0[j & 3] : mn1[j & 3]; const float pv = okP ? p[j] : 0.f, nv = okN ? n[j] : 0.f;
                    const float x = c[j] + wp * (pv - c[j]) + wn * (nv - c[j]);
                    xs_[tn][j] = x; } }
#pragma unroll
            for (int j = 0; j < 8; j += 2) { const int q = hh * 4 + (j >> 1);
                rsp[q] = pk2(xs_[0][j], xs_[0][j + 1]); ksp[q] = pk2(xs_[1][j], xs_[1][j + 1]); vsp[q] = pk2(xs_[2][j], xs_[2][j + 1]);
                kkp[q] = pk2(xs_[1][j] * (j < 4 ? kw0[j & 3] : kw1[j & 3]) * kinv, xs_[1][j + 1] * (j + 1 < 4 ? kw0[(j + 1) & 3] : kw1[(j + 1) & 3]) * kinv); }
            __builtin_amdgcn_sched_barrier(0);
        }
        SP_DIR(0, 0x111, 0x112, 0x114, 0x118, 0x15F, LO + (size_t)m * NLORA, recF);
        SP_STAGE2(recF);
        SP_DIR(1, 0x101, 0x102, 0x104, 0x108, 0x150, LO + (size_t)m * NLORA + 512, recB);
        SP_STAGE2(recB);
    }
#undef SP_DIR
#undef SP_STAGE2
}
struct ScanRec { v4u kt[2], rt[2], ka[4], oa; v2u ak, tt, v; f32x4 wc[4]; };
constexpr int SC_OROW = 136, SC_OTILE = 16 * SC_OROW;
__device__ __forceinline__ void scan_step(const ScanRec& R, f32x4 (&Hk)[4], f32x4& oprev, LAS unsigned short* otp  , bool wr) {
    const f32x4 z4 = (f32x4){0.f, 0.f, 0.f, 0.f};
    if (wr) {
#pragma unroll
        for (int j = 0; j < 4; ++j) otp[j * (SC_OROW / 2)] = (unsigned short)f2bf(oprev[j]);
    }
    const v4u Hb0 = (v4u){pk2(Hk[0][0], Hk[0][1]), pk2(Hk[0][2], Hk[0][3]), pk2(Hk[1][0], Hk[1][1]), pk2(Hk[1][2], Hk[1][3])};
    const v4u Hb1 = (v4u){pk2(Hk[2][0], Hk[2][1]), pk2(Hk[2][2], Hk[2][3]), pk2(Hk[3][0], Hk[3][1]), pk2(Hk[3][2], Hk[3][3])};
    f32x4 U = mfma16(R.kt[0], Hb0, z4); U = mfma16(R.kt[1], Hb1, U);
    U = mfma16((v4u){R.ak.x, R.ak.y, 0u, 0u}, (v4u){R.v.x, R.v.y, 0u, 0u}, U);
    const f32x4 sa = mfma16((v4u){R.tt.x, R.tt.y, 0u, 0u}, (v4u){pk2(U[0], U[1]), pk2(U[2], U[3]), 0u, 0u}, z4);
    const v4u VS = (v4u){R.v.x, R.v.y, pk2(sa[0], sa[1]), pk2(sa[2], sa[3])};
    f32x4 o = mfma16(R.rt[0], Hb0, z4); o = mfma16(R.rt[1], Hb1, o); o = mfma16(R.oa, VS, o);
#pragma unroll
    for (int kt = 0; kt < 4; ++kt) Hk[kt] = mfma16(R.ka[kt], VS, Hk[kt] * R.wc[kt]);
    oprev = o;
}
constexpr int SC_SLOT = 12544, SC_R = 10, SC_D = 8, SC_V0 = 10496;
static_assert(SC_R * SC_SLOT + 2 * SC_OTILE <= LDSCTL_OFF, "scan ring + output tiles");
__device__ __forceinline__ void scan_load_lds(ScanRec& R, const LAS unsigned char* slot, int w, int lane, int fq) {
    R.kt[0] = *(const LAS v4u*)(slot + RO_KT + lane * 16); R.kt[1] = *(const LAS v4u*)(slot + RO_KT + 1024 + lane * 16);
    R.rt[0] = *(const LAS v4u*)(slot + RO_RT + lane * 16); R.rt[1] = *(const LAS v4u*)(slot + RO_RT + 1024 + lane * 16);
#pragma unroll
    for (int kt = 0; kt < 4; ++kt) { R.ka[kt] = *(const LAS v4u*)(slot + RO_KA + kt * 1024 + lane * 16); R.wc[kt] = *(const LAS f32x4*)(slot + RO_WC + (16 * kt + 4 * fq) * 4); }
    R.oa = *(const LAS v4u*)(slot + RO_OA + lane * 16); R.ak = *(const LAS v2u*)(slot + RO_AK + lane * 8); R.tt = *(const LAS v2u*)(slot + RO_TT + lane * 8);
    R.v = *(const LAS v2u*)(slot + SC_V0 + w * 512 + lane * 8);
}
__device__ __forceinline__ void scan3_block(Frame& F, int chain, unsigned* spcnt  ) {
    unsigned char* ws = F.ws;
    const int lane = F.lane, fr = lane & 15, fq = lane >> 4, wave = F.wave;
    const int d = chain & 1, h = (chain >> 1) & 7, b = chain >> 4;
    const unsigned char* FR = ws + WS_FRAG + (size_t)chain * NCHUNK * REC_BYTES; const unsigned char* VF = ws + WS_HB + (size_t)chain * NCHUNK * 2048;
    LAS unsigned char* ring = F.lds;
    if (wave >= 6) {
        const int k = wave - 6, sgn = d ? -1 : 1;
        const long rbc = d ? (long)MLAT + b * CL + CL - 1 : (long)MLAT + b * CL, rbl = (d ? (long)b * T + T - 1 : (long)b * T) - (long)sgn * CL;
        bf16* OFBK = (bf16*)(ws + WS_ARENA + AR_OFB) + (size_t)d * M * 512 + h * 64 + 4 * fr + (long)sgn * (8 * k + fq) * 512;
        const LAS unsigned char* otrk = ring + SC_R * SC_SLOT + (8 * k + fq) * SC_OROW + fr * 8;
#define SC_FLUSHK(c_) do { const int c__ = (c_); const LAS unsigned char* tp_ = otrk + (c__ & 1) * SC_OTILE; const v2u ova_ = *(const LAS v2u*)tp_, ovb_ = *(const LAS v2u*)(tp_ + 4 * SC_OROW); \
        const long rb_ = (c__ < CL / 16 ? rbc : rbl) + (long)sgn * 16 * c__; *(v2u*)(OFBK + rb_ * 512) = ova_; *(v2u*)(OFBK + (rb_ + 4 * sgn) * 512) = ovb_; asm volatile("s_waitcnt lgkmcnt(0)" ::: "memory"); } while (0)
        __builtin_amdgcn_s_barrier();
        for (int c = 0; c < NCHUNK; ++c) {
            if (c >= 3) SC_FLUSHK(c - 3);
            __builtin_amdgcn_s_barrier();
        }
        SC_FLUSHK(NCHUNK - 3);
        __builtin_amdgcn_s_barrier();
        SC_FLUSHK(NCHUNK - 2);
        __builtin_amdgcn_s_barrier();
        SC_FLUSHK(NCHUNK - 1);
        asm volatile("s_waitcnt vmcnt(0)" ::: "memory");
#undef SC_FLUSHK
    } else if (wave >= 4) {
        const int k = wave - 4;
#define SC_DMA16(g_, l_) __builtin_amdgcn_global_load_lds((const unsigned*)((g_) + lane * 16), (LAS unsigned*)(l_), 16, 0, 2)
#define SC_ISSUE(cc, slotidx) do { const unsigned char* rec_ = FR + (size_t)(cc) * REC_BYTES; const unsigned char* vf_ = VF + (size_t)(cc) * 2048; LAS unsigned char* sb_ = ring + (slotidx) * SC_SLOT; \
        if (k == 0) { _Pragma("unroll") for (int p_ = 0; p_ < 7; ++p_) SC_DMA16(rec_ + p_ * 1024, sb_ + p_ * 1024); } \
        else { _Pragma("unroll") for (int p_ = 7; p_ < 10; ++p_) SC_DMA16(rec_ + p_ * 1024, sb_ + p_ * 1024); \
            __builtin_amdgcn_global_load_lds((const unsigned*)(rec_ + RO_WC + lane * 4), (LAS unsigned*)(sb_ + RO_WC), 4, 0, 2); SC_DMA16(vf_, sb_ + SC_V0); SC_DMA16(vf_ + 1024, sb_ + SC_V0 + 1024); } } while (0)
#define SC_WAIT() do { if (k == 0) asm volatile("s_waitcnt vmcnt(56)" ::: "memory"); else asm volatile("s_waitcnt vmcnt(48)" ::: "memory"); } while (0)
        for (int c = 0; c <= SC_D; ++c) SC_ISSUE(c, c);
        SC_WAIT();
        __builtin_amdgcn_s_barrier();
        for (int c = 0; c < NCHUNK; ++c) {
            const int cc = c + SC_D + 1, ccl = cc < NCHUNK ? cc : NCHUNK - 1;
            if (cc == SP_MID0) {
                unsigned sp_ = 0; while (__hip_atomic_load(spcnt, RLX_AGENT) < (unsigned)(16 * SP_NMID) && ++sp_ < (1u << 20)) __builtin_amdgcn_s_sleep(4);
                __builtin_amdgcn_fence(__ATOMIC_ACQUIRE, "agent"); }
            SC_ISSUE(ccl, cc % SC_R);
            SC_WAIT();
            __builtin_amdgcn_s_barrier();
        }
        __builtin_amdgcn_s_barrier();
        __builtin_amdgcn_s_barrier();
        asm volatile("s_waitcnt vmcnt(0)" ::: "memory");
#undef SC_ISSUE
#undef SC_WAIT
#undef SC_DMA16
    } else {
        const int w = wave;
        LAS unsigned char* otile = ring + SC_R * SC_SLOT;
        LAS unsigned short* otw = (LAS unsigned short*)(otile + (4 * fq) * SC_OROW + (16 * w + fr) * 2);
        f32x4 Hk[4];
#pragma unroll
        for (int kt = 0; kt < 4; ++kt) Hk[kt] = (f32x4){0.f, 0.f, 0.f, 0.f};
        ScanRec RA, RB;
        __builtin_amdgcn_s_barrier();
        scan_load_lds(RA, ring, w, lane, fq);
        f32x4 oprev = (f32x4){0.f, 0.f, 0.f, 0.f};
        for (int ch = 0; ch < NCHUNK; ch += 2) {
            asm volatile("s_waitcnt lgkmcnt(0)" ::: "memory"); __builtin_amdgcn_s_barrier();
            scan_load_lds(RB, ring + ((ch + 1) % SC_R) * SC_SLOT, w, lane, fq);
            scan_step(RA, Hk, oprev, otw + SC_OTILE / 2, ch > 0);
            asm volatile("s_waitcnt lgkmcnt(0)" ::: "memory"); __builtin_amdgcn_s_barrier();
            if (ch + 2 < NCHUNK) scan_load_lds(RA, ring + ((ch + 2) % SC_R) * SC_SLOT, w, lane, fq);
            scan_step(RB, Hk, oprev, otw, true);
        }
        asm volatile("s_waitcnt lgkmcnt(0)" ::: "memory"); __builtin_amdgcn_s_barrier();
#pragma unroll
        for (int j = 0; j < 4; ++j) (otw + SC_OTILE / 2)[j * (SC_OROW / 2)] = (unsigned short)f2bf(oprev[j]);
        asm volatile("s_waitcnt lgkmcnt(0)" ::: "memory"); __builtin_amdgcn_s_barrier();
    }
}

__device__ __forceinline__ void nat_phase(Frame& F, const Args& args, int l, int nblk, int NW, bool ctxq) {
    frame_refresh(F); KArgs KA = kargs(); const int nwave = nblk * 8 + F.wave;
    unsigned char* ws = F.ws;
    const int lane = F.lane, fr = lane & 15, fq = lane >> 4;
    const bf16* QN = (const bf16*)(ws + WS_Y); const bf16* KN = QN + (size_t)M * 512;
    const bf16* VT = (const bf16*)(ws + WS_ARENA + AR_VT); const bf16* VTC = VT + (size_t)NB * 8 * 64 * T;
    bf16* BR = (bf16*)(ws + WS_ARENA + AR_BR);
    LAS float* rpb = (LAS float*)F.lds;
    LAS unsigned* bmax = (LAS unsigned*)(F.lds + 16384);
    if (F.tid == 0) *bmax = 0u;
    __syncthreads();
    { float mb = 0.f; for (int i = F.tid; i < 8 * 15 * 32; i += 512) { const int rw = i >> 5, co = i & 31; float v = 0.f; if (co < 31) { v = KIN(KA, I_RPB)[(size_t)l * 8 * 15 * 31 + rw * 31 + co]; mb = fmaxf(mb, fabsf(v)); } rpb[i] = v; }
      __hip_atomic_fetch_max(bmax, __float_as_uint(mb), __ATOMIC_RELAXED, __HIP_MEMORY_SCOPE_WORKGROUP); }
    __syncthreads();
    float mfix2;
    { float gq = 0.f, gk = 0.f;
#pragma unroll 8
      for (int i = 0; i < 64; ++i) { gq = fmaxf(gq, fabsf(KIN(KA, I_QNG)[l * 64 + i])); gk = fmaxf(gk, fabsf(KIN(KA, I_KNG)[l * 64 + i])); }
      mfix2 = (1.03f * 8.0f * gq * gk + __uint_as_float(*bmax) + 0.25f) * 1.4426950408889634f; }
    for (int i = F.tid; i < 8 * 15 * 32; i += 512) rpb[i] = (i & 31) < 31 ? rpb[i] * 1.4426950408889634f - mfix2 : -__builtin_inff();
    __syncthreads();
    constexpr int NWX = (256 - 32);
    const int xcd = (int)blockIdx.x & 7, wx = (nblk >> 3) * 8 + F.wave;
    {
        unsigned sink = 0u;
#pragma unroll 1
        for (int pp = 0; pp < 2; ++pp) { const int pair = 2 * xcd + pp, hh = pair & 7, bb = pair >> 3;
            const bf16* vt0 = VT + (size_t)(bb * 8 + hh) * 64 * T; const bf16* vc0 = VTC + (size_t)(bb * 8 + hh) * 64 * CL;
#pragma unroll 1
            for (int i = wx * 64 + lane; i < T + CL; i += NWX * 64) {
                const size_t row = i < T ? (size_t)bb * T + i : (size_t)MLAT + bb * CL + (i - T);
                sink ^= *(const unsigned*)(KN + row * 512 + hh * 64);
                sink ^= *(const unsigned*)(i < T ? vt0 + (size_t)i * 64 : vc0 + (size_t)(i - T) * 64); } }
        asm volatile("" :: "v"(sink));
    }
    constexpr int NLT = 512, NCT = 16;
    for (int task = wx; task < NLT + (ctxq ? NCT : 0); task += NWX) {
        const bool isl = task < NLT;
        int gp, h, r, b, rs = 0, cb0 = 0; int qm[2];
        unsigned boff[2][3][4];
        if (isl) { const int pair = 2 * xcd + (task >> 8); gp = task & 1; r = (task >> 1) & 127; h = pair & 7; b = pair >> 3;
            rs = r - 4 < 0 ? 0 : (r - 4 > GROWS - 8 ? GROWS - 8 : r - 4); cb0 = gp;
            const unsigned rowbase = (unsigned)((h * 15 + (rs - r + 7)) * 128);
#pragma unroll
            for (int t = 0; t < 2; ++t) { const int g = 2 * gp + t, c = 16 * g + fr, cs = c - 8 < 0 ? 0 : (c - 8 > 48 ? 48 : c - 8); qm[t] = b * T + r * 64 + c;
#pragma unroll
                for (int br = 0; br < 3; ++br)
#pragma unroll
                    for (int j = 0; j < 4; ++j) { const int kc = (cb0 + br) * 16 + 4 * fq + j; const bool ok = (unsigned)(kc - cs) < 16u; boff[t][br][j] = rowbase + (unsigned)(ok ? (kc - c + 15) * 4 : 31 * 4); } } }
        else { const int q = task - NLT, pair = 2 * xcd + (q >> 3); gp = q & 7; h = pair & 7; b = pair >> 3; r = 0;
#pragma unroll
            for (int t = 0; t < 2; ++t) { qm[t] = MLAT + b * CL + 16 * (2 * gp + t) + fr;
#pragma unroll
                for (int br = 0; br < 3; ++br)
#pragma unroll
                    for (int j = 0; j < 4; ++j) boff[t][br][j] = 0u; } }
        v4u q0[2], q1[2];
#pragma unroll
        for (int t = 0; t < 2; ++t) { q0[t] = *(const v4u*)(QN + (size_t)qm[t] * 512 + h * 64 + 8 * fq); q1[t] = *(const v4u*)(QN + (size_t)qm[t] * 512 + h * 64 + 32 + 8 * fq); }
        float lpart[2] = {0.f, 0.f};
        f32x4 O[2][4];
#pragma unroll
        for (int t = 0; t < 2; ++t)
#pragma unroll
            for (int dt = 0; dt < 4; ++dt) O[t][dt] = (f32x4){0.f, 0.f, 0.f, 0.f};
        const bf16* vt_lat = VT + ((size_t)(b * 8 + h) * 64 + fr) * T;
        const bf16* vt_ctx = VTC + ((size_t)(b * 8 + h) * 64 + fr) * CL;
        struct NatOps { v4u ka0, ka1, kb0, kb1; v2u va[4], vb[4]; };
#define NAT_LOAD(ks_, OP) do { const int ks__ = (ks_); const bool loc_ = isl && ks__ < 12; int tokA_, tokB_; const bf16* vA_; const bf16* vB_; size_t vst_; \
            if (loc_) { const int br_ = ks__ >> 2, i_ = ks__ & 3; const int ta_ = (rs + 2 * i_) * 64 + (cb0 + br_) * 16, tb_ = ta_ + 64; \
                tokA_ = b * T + ta_; tokB_ = b * T + tb_; vA_ = vt_lat + ta_ + 4 * fq; vB_ = vt_lat + tb_ + 4 * fq; vst_ = (size_t)16 * T; } \
            else { const int kc_ = isl ? ks__ - 12 : ks__; const int ta_ = 32 * kc_, tb_ = 32 * kc_ + 16; \
                tokA_ = MLAT + b * CL + ta_; tokB_ = MLAT + b * CL + tb_; vA_ = vt_ctx + ta_ + 4 * fq; vB_ = vt_ctx + tb_ + 4 * fq; vst_ = (size_t)16 * CL; } \
            const bf16* ka_ = KN + (size_t)(tokA_ + fr) * 512 + h * 64 + 8 * fq; const bf16* kb_ = KN + (size_t)(tokB_ + fr) * 512 + h * 64 + 8 * fq; \
            OP.ka0 = *(const v4u*)ka_; OP.ka1 = *(const v4u*)(ka_ + 32); OP.kb0 = *(const v4u*)kb_; OP.kb1 = *(const v4u*)(kb_ + 32); \
            _Pragma("unroll") for (int dt = 0; dt < 4; ++dt) { OP.va[dt] = *(const v2u*)(vA_ + dt * vst_); OP.vb[dt] = *(const v2u*)(vB_ + dt * vst_); } } while (0)
#define NAT_COMPUTE(LOCAL, br_, i_, OP) do { \
            _Pragma("unroll") for (int t = 0; t < 2; ++t) { \
                f32x4 sA = mfma16(OP.ka0, q0[t], (f32x4){0.f, 0.f, 0.f, 0.f}); sA = mfma16(OP.ka1, q1[t], sA); \
                f32x4 sB = mfma16(OP.kb0, q0[t], (f32x4){0.f, 0.f, 0.f, 0.f}); sB = mfma16(OP.kb1, q1[t], sB); \
                float ps = 0.f; f32x4 pA, pB; \
                if (LOCAL) { const unsigned ra_ = (unsigned)(2 * (i_)) * 128u; \
                    _Pragma("unroll") for (int j = 0; j < 4; ++j) { const LAS unsigned char* bp_ = (const LAS unsigned char*)rpb + (boff[t][br_][j] + ra_); \
                        pA[j] = __builtin_amdgcn_exp2f(sA[j] + *(const LAS float*)bp_); pB[j] = __builtin_amdgcn_exp2f(sB[j] + *(const LAS float*)(bp_ + 128)); ps += pA[j] + pB[j]; } } \
                else { _Pragma("unroll") for (int j = 0; j < 4; ++j) { pA[j] = __builtin_amdgcn_exp2f(sA[j] - mfix2); pB[j] = __builtin_amdgcn_exp2f(sB[j] - mfix2); ps += pA[j] + pB[j]; } } \
                lpart[t] += ps; \
                v4u pf; pf.x = pk2(pA[0], pA[1]); pf.y = pk2(pA[2], pA[3]); pf.z = pk2(pB[0], pB[1]); pf.w = pk2(pB[2], pB[3]); \
                _Pragma("unroll") for (int dt = 0; dt < 4; ++dt) { v4u vf; vf.x = OP.va[dt].x; vf.y = OP.va[dt].y; vf.z = OP.vb[dt].x; vf.w = OP.vb[dt].y; \
                    O[t][dt] = mfma16(vf, pf, O[t][dt]); } } } while (0)
        NatOps PA, PB;
        NAT_LOAD(0, PA);
        if (isl) {
#pragma unroll
            for (int br = 0; br < 3; ++br) {
#pragma unroll 1
                for (int i = 0; i < 4; i += 2) { const int ks = 4 * br + i;
                    NAT_LOAD(ks + 1, PB);
                    NAT_COMPUTE(true, br, i, PA);
                    NAT_LOAD(ks + 2, PA);
                    NAT_COMPUTE(true, br, i + 1, PB); } }
        }
        { const int k0 = isl ? 12 : 0;
#pragma unroll 1
          for (int kc = 0; kc < 8; kc += 2) {
              NAT_LOAD(k0 + kc + 1, PB);
              NAT_COMPUTE(false, 0, 0, PA);
              if (kc + 2 < 8) NAT_LOAD(k0 + kc + 2, PA);
              NAT_COMPUTE(false, 0, 0, PB); } }
#undef NAT_LOAD
#undef NAT_COMPUTE
#pragma unroll
        for (int t = 0; t < 2; ++t) {
            float lsum = lpart[t];
            lsum += __builtin_bit_cast(float, __builtin_amdgcn_ds_bpermute((lane ^ 16) << 2, __builtin_bit_cast(int, lsum)));
            lsum += __builtin_bit_cast(float, __builtin_amdgcn_ds_bpermute((lane ^ 32) << 2, __builtin_bit_cast(int, lsum)));
            const float inv = 1.0f / lsum;
#pragma unroll
            for (int dt = 0; dt < 4; ++dt) { v2u o; o.x = pk2(O[t][dt][0] * inv, O[t][dt][1] * inv); o.y = pk2(O[t][dt][2] * inv, O[t][dt][3] * inv);
                *(v2u*)(BR + (size_t)qm[t] * 1536 + 1024 + h * 64 + 16 * dt + 4 * fq) = o; } }
    }
}

__device__ __forceinline__ void readout_phase(Frame& F, const Args& args, int l, int mrows) {
    frame_refresh(F); KArgs KA = kargs();
    unsigned char* ws = F.ws;
    const int gw = F.vcu * 8 + F.wave, NGW = F.G * 8, lane = F.lane;
    const bf16* Z = (const bf16*)(ws + WS_ARENA + AR_Z); const bf16* LO = (const bf16*)(ws + WS_ARENA + AR_LO);
    const bf16* O0 = (const bf16*)(ws + WS_ARENA + AR_OFB); const bf16* O1 = O0 + (size_t)M * 512;
    bf16* BR = (bf16*)(ws + WS_ARENA + AR_BR);
    const float* mu0 = KIN(KA, I_SHMU) + (size_t)l * 2 * 1760; const float* mu1 = mu0 + 1760;
    const int ch = lane * 8;
    float kaw[8], brk[8], gg[8], gb[8];
#pragma unroll
    for (int j = 0; j < 8; ++j) { kaw[j] = KIN(KA, I_KKA)[l * 512 + ch + j]; brk[j] = KIN(KA, I_BONUS)[l * 512 + ch + j]; gg[j] = KIN(KA, I_GNG)[l * 512 + ch + j]; gb[j] = KIN(KA, I_GNB)[l * 512 + ch + j]; }
    for (int m = gw; m < mrows; m += NGW) {
        int seq0, t, Tn; seq_of_row(m, seq0, t, Tn);
        const v4u vo0 = *(const v4u*)(O0 + (size_t)m * 512 + ch), vo1 = *(const v4u*)(O1 + (size_t)m * 512 + ch);
        Sh8 sr, sk, sv; sh8_load(sr, Z, m, t, Tn, ZR + ch); sh8_load(sk, Z, m, t, Tn, ZK + ch); sh8_load(sv, Z, m, t, Tn, ZV + ch);
        const v4u va0 = *(const v4u*)(LO + (size_t)m * NLORA + 1024 + ch), va1 = *(const v4u*)(LO + (size_t)m * NLORA + 1536 + ch), vgt = *(const v4u*)(LO + (size_t)m * NLORA + 2048 + ch);
        asm volatile("" ::: "memory"); __builtin_amdgcn_sched_barrier(0);
        float o0[8], o1[8]; unpack8(vo0, o0); unpack8(vo1, o1);
        float s = 0.f;
#pragma unroll
        for (int j = 0; j < 8; ++j) { o0[j] += o1[j]; s += o0[j]; }
        const float mean = red8(s) * (1.f / 64.f); float q = 0.f;
#pragma unroll
        for (int j = 0; j < 8; ++j) { o0[j] -= mean; q += o0[j] * o0[j]; }
        const float rstd = 1.0f / sqrtf(red8(q) * (1.f / 64.f) + 64e-5f);
        float rs_[8], ks_[8], vs_[8];
        sh8_eval(sr, mu0 + ch, mu1 + ch, rs_);
        sh8_eval(sk, mu0 + 512 + ch, mu1 + 512 + ch, ks_);
        sh8_eval(sv, mu0 + 1024 + ch, mu1 + 1024 + ch, vs_);
        float a0[8], a1[8], gt[8];
        unpack8(va0, a0); unpack8(va1, a1); unpack8(vgt, gt);
        float bs = 0.f;
#pragma unroll
        for (int j = 0; j < 8; ++j) { const float kd = ks_[j] * ((1.0f + (a0[j] - 1.0f) * kaw[j]) + (1.0f + (a1[j] - 1.0f) * kaw[j])); bs += rs_[j] * kd * brk[j]; }
        bs = red8(bs);
        float out[8];
#pragma unroll
        for (int j = 0; j < 8; ++j) out[j] = (o0[j] * rstd * gg[j] + gb[j] + bs * vs_[j]) * gt[j];
        *(v4u*)(BR + (size_t)m * 1536 + 512 + ch) = pack8(out);
    }
}

__device__ __forceinline__ void sum_phase(Frame& F, int rbase, int rcount, int rblk, int rnb  ) {
    frame_refresh(F);
    rbase = __builtin_amdgcn_readfirstlane(rbase); rcount = __builtin_amdgcn_readfirstlane(rcount); rblk = __builtin_amdgcn_readfirstlane(rblk); rnb = __builtin_amdgcn_readfirstlane(rnb);
    asm volatile("" : "+s"(rbase), "+s"(rcount), "+s"(rblk), "+s"(rnb));
    unsigned char* ws = F.ws;
    const v4u* P = (const v4u*)(ws + WS_ARENA + AR_P) + (size_t)rbase * 384; v4u* U = (v4u*)(ws + WS_HB) + (size_t)rbase * 128;
    for (size_t i = (size_t)rblk * 512 + F.tid; i < (size_t)rcount * 128; i += (size_t)rnb * 512) {
        const size_t row = i >> 7, c = i & 127;
        float a[8], b[8], d[8]; unpack8(P[row * 384 + c], a); unpack8(P[row * 384 + 128 + c], b); unpack8(P[row * 384 + 256 + c], d);
#pragma unroll
        for (int j = 0; j < 8; ++j) a[j] += b[j] + d[j];
        U[i] = pack8(a);
    }
}

__device__ __forceinline__ void final_phase(Frame& F, const Args& args, int ymode, const float* gate_mod) {
    frame_refresh(F); KArgs KA = kargs();
    unsigned char* ws = F.ws;
    const int gw = F.vcu * 8 + F.wave, NGW = F.G * 8, lane = F.lane;
    const bf16* Y = (const bf16*)(ws + WS_Y); const bf16* YP = (const bf16*)(ws + WS_ARENA + AR_YP); const unsigned* RT = (const unsigned*)(ws + WS_RT);
    for (int m = gw; m < MLAT; m += NGW) {
        const int srow = m >> 13; float* xo = ((float*)(GAS float*)KA->out) + (size_t)m * D;
        unsigned r0 = 0, r1 = 0; float w0 = 0.f, w1 = 0.f;
        if (ymode == 2) { const v4u rt = *(const v4u*)(RT + (size_t)m * 8); const v4u rt2 = *(const v4u*)(RT + (size_t)m * 8 + 4); w0 = __uint_as_float(rt.z); w1 = __uint_as_float(rt.w); r0 = rt2.x; r1 = rt2.y; }
#pragma unroll
        for (int j = 0; j < 4; ++j) {
            const int col = 4 * lane + 256 * j; f32x4 v = *(const f32x4*)(xo + col); f32x4 yv;
            if (ymode == 1) { const v2u yy = *(const v2u*)(Y + (size_t)m * D + col); yv = (f32x4){bflo(yy.x), bfhi(yy.x), bflo(yy.y), bfhi(yy.y)}; }
            else { const v2u ya = *(const v2u*)(YP + (size_t)r0 * D + col), yb = *(const v2u*)(YP + (size_t)r1 * D + col);
                yv = (f32x4){w0 * bflo(ya.x) + w1 * bflo(yb.x), w0 * bfhi(ya.x) + w1 * bfhi(yb.x), w0 * bflo(ya.y) + w1 * bflo(yb.y), w0 * bfhi(ya.y) + w1 * bfhi(yb.y)}; }
            const f32x4 gt = *(const f32x4*)(gate_mod + (size_t)srow * 6 * D + col);
            *(f32x4*)(xo + col) = v + gt * yv;
        }
    }
}

template <bool FFN>
__device__ __forceinline__ void deferred_ctx_tile(Frame& F, const Args& args, int l  ) {
    frame_refresh(F);
    unsigned char* ws = F.ws; unsigned* ctl = (unsigned*)(ws + WS_CTL);
    const int bx = (int)blockIdx.x, khalf = FFN ? bx >> 3 : 0, tl = FFN ? bx & 7 : bx, panel = tl >> 2, pn = tl & 3;
    pg8::SingleSched S; S.pm = MLAT / 256 + panel; S.pn = pn;
    if (FFN) { const int j = l >> 1; S.a = (const char*)(ws + WS_ARENA + AR_ACT) + (size_t)S.pm * 256 * DFF * 2 + (size_t)khalf * (DFF / 2) * 2; S.b = (const char*)(ws + WS_W2) + (size_t)j * D * DFF * 2 + (size_t)pn * 256 * DFF * 2 + (size_t)khalf * (DFF / 2) * 2; }
    else { S.a = (const char*)(ws + WS_HB) + (size_t)S.pm * 256 * D * 2; S.b = (const char*)(ws + WS_WOUT) + (size_t)l * D * D * 2 + (size_t)pn * 256 * D * 2; }
    pg8::EpiBf16 E{khalf ? (bf16*)(ws + WS_Y2) - (size_t)MLAT * D : (bf16*)(ws + WS_Y), D};
    if (FFN) pg8::gemm_phase(F.lds, pg8::Gemm{DFF, DFF, DFF / 2}, S, E, F.wave); else pg8::gemm_phase(F.lds, pg8::Gemm{D, D, D}, S, E, F.wave);
    asm volatile("s_waitcnt vmcnt(0)" ::: "memory"); __syncthreads();
    frame_refresh(F);
    if (F.tid == 0) { unsigned* cnt = ctl + CW_DEF + ((l * 2 + (FFN ? 1 : 0)) * 2 + panel) * 64;
        __builtin_amdgcn_fence(__ATOMIC_RELEASE, "agent"); asm volatile("s_waitcnt vmcnt(0)" ::: "memory");
        __hip_atomic_fetch_add(cnt, 1u, RLX_AGENT); }
    __syncthreads();
}

__device__ __forceinline__ void deferred_ctx_branch(Frame& F, const Args& args, int l, bf16* Zb) {
    frame_refresh(F);
    unsigned char* ws = F.ws; unsigned* ctl = (unsigned*)(ws + WS_CTL);
    const int bx = (int)blockIdx.x, panel = bx / 12, pn = bx % 12;
    pg8::SingleSched S; S.pm = MLAT / 256 + panel; S.pn = pn;
    S.a = (const char*)(ws + WS_ARENA + AR_BR) + (size_t)S.pm * 256 * 1536 * 2 + (size_t)(pn / 4) * 512 * 2; S.b = (const char*)(ws + WS_WBR) + (size_t)l * 3072 * 512 * 2 + (size_t)pn * 256 * 512 * 2;
    pg8::EpiGate E{(bf16*)(ws + WS_ARENA + AR_P), Zb + ZG};
    pg8::gemm_phase(F.lds, pg8::Gemm{1536, 512, 512}, S, E, F.wave);
    asm volatile("s_waitcnt vmcnt(0)" ::: "memory"); __syncthreads();
    frame_refresh(F);
    if (F.tid == 0) { unsigned* cnt = ctl + CW_DEFB + (l * 2 + panel) * 64;
        __builtin_amdgcn_fence(__ATOMIC_RELEASE, "agent"); asm volatile("s_waitcnt vmcnt(0)" ::: "memory");
        __hip_atomic_fetch_add(cnt, 1u, RLX_AGENT);
        unsigned sp = 0; while (__hip_atomic_load(cnt, RLX_AGENT) < 12u && ++sp < (1u << 21)) __builtin_amdgcn_s_sleep(2);
        __builtin_amdgcn_fence(__ATOMIC_ACQUIRE, "agent"); asm volatile("s_waitcnt vmcnt(0)" ::: "memory"); }
    __syncthreads();
}

constexpr int NPH_LAYER = 14, PH_FINAL = 1 + DEPTH * NPH_LAYER, NPHASES = PH_FINAL + 1;
__global__ void __launch_bounds__(512, 2) mk_fwd(Args args) {
    extern __shared__ __attribute__((aligned(16))) unsigned char lds[];
    Frame F;
    F.lds = (LAS unsigned char*)lds; F.ws = args.ws;
    F.tid = threadIdx.x; F.lane = F.tid & 63; F.wave = __builtin_amdgcn_readfirstlane(F.tid >> 6);
    F.G = gridDim.x; { const int bx = blockIdx.x; F.vcu = (F.G % 8 == 0) ? (bx % 8) * (F.G / 8) + bx / 8 : bx; }
    volatile LAS unsigned* MISC = (volatile LAS unsigned*)(F.lds + MISC_OFF);
    unsigned char* ws = args.ws;
    unsigned* ctl = (unsigned*)(ws + WS_CTL);
    for (int u = F.tid; u < (LDS_BYTES - LDSCTL_OFF) / 4; u += 512) ((LAS unsigned*)(F.lds + LDSCTL_OFF))[u] = 0u;
    __syncthreads();
    XcdBarrier bar; bar.bar = ctl + CW_BAR; bar.x = 0; bar.st = nullptr;
    if (!MK_PER_PHASE) bar = xcd_barrier_post(ctl + CW_BAR, MISC + 8);
    const int lo = args.ph_lo, hi = args.ph_hi;
#define IN(k) (lo <= (k) && (k) < hi)
#define SEAM(k) do { if (!MK_PER_PHASE && IN((k) + 1)) xcd_barrier(bar, F.wave); } while (0)

    if (IN(0)) { p0_prologue(F, args); SEAM(0); }

    const float* MOD = (const float*)(ws + WS_MOD);
    bf16* Zb = (bf16*)(ws + WS_ARENA + AR_Z);
    for (int l = 0; l < DEPTH; ++l) {
        KArgs KA = kargs(); { unsigned long long w_ = (unsigned long long)ws; asm volatile("" : "+s"(w_)); ws = (unsigned char*)(GAS unsigned char*)w_; }
        const int pb = 1 + l * NPH_LAYER;
        const bool moe = (l & 1) != 0; const int j2 = l >> 1;
        const int mrows = l + 1 < DEPTH ? M : MLAT;
        const float* modl = MOD + (size_t)l * 3 * 6 * D;
        if (IN(pb + 0)) {
            const float* modp = MOD + (size_t)(l - 1) * 3 * 6 * D;
            const float* xl = l == 0 ? KIN(KA, I_X) : ((float*)(GAS float*)KA->out); const float* xc = l == 0 ? KIN(KA, I_CTX) : (const float*)(ws + WS_XSC);
            const int ymode = l == 0 ? 0 : (((l - 1) & 1) ? 2 : 1);
            if (l >= 1 && ((l - 1) & 1) == 0) {
                if (blockIdx.x < 16) deferred_ctx_tile<true>(F, args, l - 1);
                else norm_phase(F, args, xl, xc, ymode, modp + 5 * D, KIN(KA, I_NMG) + l * D, modl + 1 * D, modl + 0 * D, false, nullptr, 0, (int)blockIdx.x - 16, F.G - 16, 0, MLAT, ws + WS_HB8,
                                MLAT, MCTX, 3, ctl + CW_DEF + (((l - 1) * 2 + 1) * 2) * 64, 8u);
            } else norm_phase(F, args, xl, xc, ymode, l == 0 ? nullptr : modp + 5 * D, KIN(KA, I_NMG) + l * D, modl + 1 * D, modl + 0 * D, false, nullptr, 0, F.vcu, F.G, 0, M, ws + WS_HB8);
            SEAM(pb + 0);
        }
        if (IN(pb + 1)) {
            { pg8::DenseSched S; S.to.init(M / 256, NZB / 256, F.G, (int)blockIdx.x); S.A = (const char*)(ws + WS_HB); S.Bt = (const char*)(ws + WS_WIN) + (size_t)l * NZB * D * 2;
              S.a_tile = (size_t)256 * D * 2; S.b_tile = (size_t)256 * D * 2; S.acol_div = 1 << 20; S.acol_step = 0;
              pg8::EpiBf16 E{Zb, NZ};
              pg8::gemm_phase(F.lds, pg8::Gemm{D, D, D}, S, E, F.wave); }
            { pg8::DenseSched S; S.to.init(M / 256, NZG / 256, F.G, ((int)blockIdx.x + 32) % F.G); S.A = (const char*)(ws + WS_HB8); S.Bt = (const char*)(ws + WS_WING8) + (size_t)l * NZG * D;
              S.a_tile = (size_t)256 * D; S.b_tile = (size_t)256 * D; S.acol_div = 1 << 20; S.acol_step = 0;
              pg8::EpiBf16 E{Zb + ZG, NZ};
              pg8::gemm_phase<pg8::EpiBf16, pg8::DenseSched, true>(F.lds, pg8::Gemm{D / 2, D / 2, D / 2}, S, E, F.wave); }
            SEAM(pb + 1);
        }
        if (IN(pb + 2)) { prep_phase(F, args, l); SEAM(pb + 2); }
        if (IN(pb + 3)) {
            pg8::DenseSched S; S.to.init(M / 256, NLORA / 256, F.G, (int)blockIdx.x); S.A = (const char*)(ws + WS_HB); S.Bt = (const char*)(ws + WS_WLORA) + (size_t)l * NLORA * KLORA * 2;
            S.a_tile = (size_t)256 * KLORA * 2; S.b_tile = (size_t)256 * KLORA * 2; S.acol_div = 1 << 20; S.acol_step = 0;
            pg8::EpiLora E{(bf16*)(ws + WS_ARENA + AR_LO), KIN(KA, I_DW0) + l * 1024, KIN(KA, I_A0) + l * 1024};
            pg8::gemm_phase(F.lds, pg8::Gemm{KLORA, KLORA, KLORA}, S, E, F.wave);
            SEAM(pb + 3);
        }
#pragma unroll 1
        for (int sp = 0; sp < 2; ++sp) {
            if (sp == 0 ? IN(pb + 4) : (IN(pb + 5) && blockIdx.x >= 32)) scanpre_phase(F, args, l, sp);
            if (sp == 0) { if (IN(pb + 4)) SEAM(pb + 4); }
            else if (IN(pb + 5)) {
                unsigned* spcnt = ctl + CW_SPM + l * 64;
                if (blockIdx.x < 32) { frame_refresh(F); scan3_block(F, (int)blockIdx.x, spcnt); }
                else {
                    { const int nw = ((int)blockIdx.x - 32) * 8 + F.wave;
                      if (nw % 7 == 0 && nw / 7 < 16 * SP_NMID) { asm volatile("s_waitcnt vmcnt(0)" ::: "memory"); __builtin_amdgcn_fence(__ATOMIC_RELEASE, "agent"); asm volatile("s_waitcnt vmcnt(0)" ::: "memory");
                          if (F.lane == 0) __hip_atomic_fetch_add(spcnt, 1u, RLX_AGENT); } }
                    __syncthreads();
                    nat_phase(F, args, l, (int)blockIdx.x - 32, (F.G - 32) * 8, l + 1 < DEPTH);
                }
                SEAM(pb + 5);
            }
        }
        if (IN(pb + 6)) { readout_phase(F, args, l, mrows); if (l == 2) moe_convert(F, args, 1); SEAM(pb + 6); }
        if (IN(pb + 7)) {
            pg8::DenseSched S; S.to.init(MLAT / 256, 12, F.G, (int)blockIdx.x); S.A = (const char*)(ws + WS_ARENA + AR_BR); S.Bt = (const char*)(ws + WS_WBR) + (size_t)l * 3072 * 512 * 2;
            S.a_tile = (size_t)256 * 1536 * 2; S.b_tile = (size_t)256 * 512 * 2; S.acol_div = 4; S.acol_step = 512 * 2;
            pg8::EpiGate E{(bf16*)(ws + WS_ARENA + AR_P), Zb + ZG};
            pg8::gemm_phase(F.lds, pg8::Gemm{1536, 512, 512}, S, E, F.wave);
            SEAM(pb + 7);
        }
        if (IN(pb + 8)) {
            if (l + 1 < DEPTH) {
                if (blockIdx.x < 24) { deferred_ctx_branch(F, args, l, Zb); sum_phase(F, MLAT + ((int)blockIdx.x / 12) * 256, 256, (int)blockIdx.x % 12, 12); }
                else sum_phase(F, 0, MLAT, (int)blockIdx.x - 24, F.G - 24);
            } else sum_phase(F, 0, MLAT, (int)blockIdx.x, F.G);
            SEAM(pb + 8);
        }
        if (IN(pb + 9)) {
            pg8::DenseSched S; S.to.init(MLAT / 256, D / 256, F.G, (int)blockIdx.x); S.A = (const char*)(ws + WS_HB); S.Bt = (const char*)(ws + WS_WOUT) + (size_t)l * D * D * 2;
            S.a_tile = (size_t)256 * D * 2; S.b_tile = (size_t)256 * D * 2; S.acol_div = 1 << 20; S.acol_step = 0;
            pg8::EpiBf16 E{(bf16*)(ws + WS_Y), D};
            pg8::gemm_phase(F.lds, pg8::Gemm{D, D, D}, S, E, F.wave);
            SEAM(pb + 9);
        }
        if (IN(pb + 10)) {
            if (l + 1 < DEPTH) {
                if (blockIdx.x < 8) deferred_ctx_tile<false>(F, args, l);
                else norm_phase(F, args, ((float*)(GAS float*)KA->out), (const float*)(ws + WS_XSC), 1, modl + 2 * D, KIN(KA, I_NFG) + l * D, modl + 4 * D, modl + 3 * D, moe, KIN(KA, I_ROUTER) + (size_t)j2 * D * 8, j2, (int)blockIdx.x - 8, F.G - 8, 0, MLAT, nullptr,
                                MLAT, MCTX, 1, ctl + CW_DEF + ((l * 2 + 0) * 2) * 64, 4u);
            } else norm_phase(F, args, ((float*)(GAS float*)KA->out), (const float*)(ws + WS_XSC), 1, modl + 2 * D, KIN(KA, I_NFG) + l * D, modl + 4 * D, modl + 3 * D, moe, KIN(KA, I_ROUTER) + (size_t)j2 * D * 8, j2, F.vcu, F.G, 0, MLAT);
            SEAM(pb + 10);
        }
        if (IN(pb + 11)) { if (moe) { moe_perm_phase(F, j2, mrows); SEAM(pb + 11); } }
        if (IN(pb + 12)) {
            if (moe) {
                pg8::GroupSched S; S.a_tile = (size_t)256 * D; S.b_tile = (size_t)256 * D; S.b_exp = (size_t)NF1 * D;
                unsigned cnt[8];
#pragma unroll
                for (int e = 0; e < 8; ++e) cnt[e] = ctl[CW_MOE + j2 * 64 + e];
                moe_prefix(cnt, S.pe); S.A = (const char*)(ws + WS_ARENA + AR_HP); S.Bt = (const char*)(ws + WS_MW13); S.to.init(S.pe[8], NF1 / 256, F.G, (int)blockIdx.x);
                pg8::EpiSwiglu8 E{ws + WS_ARENA + AR_ACT};
                pg8::gemm_phase<pg8::EpiSwiglu8, pg8::GroupSched, true>(F.lds, pg8::Gemm{D / 2, D / 2, D / 2}, S, E, F.wave);
            } else {
                pg8::GroupSched S; S.a_tile = (size_t)256 * D * 2; S.b_tile = (size_t)256 * D * 2; S.b_exp = (size_t)NF1 * D * 2;
#pragma unroll
                for (int e = 0; e < 9; ++e) S.pe[e] = e == 0 ? 0 : M / 256;
                S.A = (const char*)(ws + WS_HB); S.Bt = (const char*)(ws + WS_W13) + (size_t)j2 * NF1 * D * 2; S.to.init(M / 256, NF1 / 256, F.G, (int)blockIdx.x);
                pg8::EpiSwiglu E{(bf16*)(ws + WS_ARENA + AR_ACT)};
                pg8::gemm_phase(F.lds, pg8::Gemm{D, D, D}, S, E, F.wave);
            }
            SEAM(pb + 12);
        }
        if (IN(pb + 13)) {
            if (moe) {
                pg8::GroupSched S; S.a_tile = (size_t)256 * DFF; S.b_tile = (size_t)256 * DFF; S.b_exp = (size_t)D * DFF;
                unsigned cnt[8];
#pragma unroll
                for (int e = 0; e < 8; ++e) cnt[e] = ctl[CW_MOE + j2 * 64 + e];
                moe_prefix(cnt, S.pe); S.A = (const char*)(ws + WS_ARENA + AR_ACT); S.Bt = (const char*)(ws + WS_MW2); S.to.init(S.pe[8], D / 256, F.G, (int)blockIdx.x);
                pg8::EpiBf16 E{(bf16*)(ws + WS_ARENA + AR_YP), D};
                pg8::gemm_phase<pg8::EpiBf16, pg8::GroupSched, true>(F.lds, pg8::Gemm{DFF / 2, DFF / 2, DFF / 2}, S, E, F.wave);
            } else {
                pg8::GroupSched S; S.a_tile = (size_t)256 * DFF * 2; S.b_tile = (size_t)256 * DFF * 2; S.b_exp = (size_t)D * DFF * 2;
#pragma unroll
                for (int e = 0; e < 9; ++e) S.pe[e] = e == 0 ? 0 : M / 256;
                S.A = (const char*)(ws + WS_ARENA + AR_ACT); S.Bt = (const char*)(ws + WS_W2) + (size_t)j2 * D * DFF * 2; S.to.init(MLAT / 256, D / 256, F.G, (int)blockIdx.x);
                pg8::EpiBf16 E{(bf16*)(ws + WS_Y), D};
                pg8::gemm_phase(F.lds, pg8::Gemm{DFF, DFF, DFF}, S, E, F.wave);
            }
            SEAM(pb + 13);
        }
    }
    if (IN(PH_FINAL)) { final_phase(F, args, ((DEPTH - 1) & 1) ? 2 : 1, MOD + (size_t)(DEPTH - 1) * 3 * 6 * D + 5 * D); }
#undef IN
#undef SEAM
}

extern "C" void kernel_launch(void* const* d_in, const int* in_sizes, int n_in, void* d_out, int out_size, void* d_ws, size_t ws_size, hipStream_t stream) {
    static int grid = 0;
    if (grid == 0) {
        if (n_in != 34 || out_size != MLAT * D || ws_size < WS_END) { fprintf(stderr, "kernel_launch: unexpected shapes (n_in %d, out %d, ws %zu < %zu)\n", n_in, out_size, ws_size, (size_t)WS_END); grid = -1; return; }
        int dev = 0, cus = 0, per_cu = 0;
        if (hipGetDevice(&dev) != hipSuccess || hipDeviceGetAttribute(&cus, hipDeviceAttributeMultiprocessorCount, dev) != hipSuccess) { grid = -1; return; }
        if (hipFuncSetAttribute((const void*)mk_fwd, hipFuncAttributeMaxDynamicSharedMemorySize, LDS_BYTES) != hipSuccess) { fprintf(stderr, "kernel_launch: hipFuncSetAttribute failed\n"); grid = -1; return; }
        if (hipOccupancyMaxActiveBlocksPerMultiprocessor(&per_cu, (const void*)mk_fwd, 512, LDS_BYTES) != hipSuccess || per_cu < 1) fprintf(stderr, "kernel_launch: occupancy query says %d\n", per_cu);
        (void)hipGetLastError();
        if (cus != 256) { fprintf(stderr, "kernel_launch: this kernel is laid out for 256 CUs (found %d)\n", cus); grid = -1; return; }
        grid = cus;
    }
    if (grid < 0) return;
    if (hipMemsetAsync((char*)d_ws + WS_CTL, 0, CTL_ZERO_BYTES, stream) != hipSuccess) return;
    Args a{};
    for (int i = 0; i < 34; ++i) a.in[i] = (const float*)d_in[i];
    a.out = (float*)d_out; a.ws = (unsigned char*)d_ws;
#if MK_PER_PHASE
    for (int p = 0; p < NPHASES; ++p) { a.ph_lo = p; a.ph_hi = p + 1; hipLaunchKernelGGL(mk_fwd, dim3(grid), dim3(512), LDS_BYTES, stream, a); }
#else
    a.ph_lo = 0; a.ph_hi = NPHASES;
    hipLaunchKernelGGL(mk_fwd, dim3(grid), dim3(512), LDS_BYTES, stream, a);
#endif
}
```

```cpp
#include <hip/hip_runtime.h>
#include <cstdio>
#include <cstdint>

#ifndef MK_PER_PHASE
#define MK_PER_PHASE 0
#endif

#define GAS __attribute__((address_space(1)))
#define LAS __attribute__((address_space(3)))
typedef unsigned short bf16;
typedef unsigned v4u __attribute__((ext_vector_type(4)));
typedef unsigned v2u __attribute__((ext_vector_type(2)));
typedef float f32x4 __attribute__((ext_vector_type(4)));
typedef float f32x2 __attribute__((ext_vector_type(2)));
typedef short bf16x8 __attribute__((ext_vector_type(8)));
typedef GAS unsigned gu32;

constexpr int D = 1024, NB = 2, T = 8192, DEPTH = 4, CL = 256, GWID = 64, GROWS = 128;
constexpr int MLAT = NB * T, MCTX = NB * CL, M = MLAT + MCTX;
constexpr int BWID = 512, DFF = 2816, NEXP = 8;
constexpr int IN_TOTAL = 6880, NZ = 6912;
constexpr int ZP = 0, ZR = 512, ZK = 1024, ZV = 1536, ZWLO = 2048, ZQ = 2304, ZNK = 2816, ZNV = 3328, ZG = 3840;
constexpr int NLORA = 2560, KLORA = 256;
constexpr int NF1 = 2 * DFF;
constexpr int MAXPANELS = 140;

constexpr size_t MiB = 1u << 20;
constexpr size_t al(size_t x) { return (x + 4095) & ~(size_t)4095; }
constexpr size_t WS_CTL = 0, CTL_ZERO_BYTES = 1 * MiB;
constexpr size_t WS_MOD = WS_CTL + CTL_ZERO_BYTES;
constexpr size_t WS_XSC = al(WS_MOD + (size_t)DEPTH * 3 * 6 * D * 4);
constexpr size_t WS_RT = al(WS_XSC + (size_t)MCTX * D * 4);
constexpr size_t WS_KINV = al(WS_RT + (size_t)M * 32);
constexpr size_t WS_HB = al(WS_KINV + (size_t)M * 8 * 4);
constexpr size_t WS_Y = al(WS_HB + (size_t)M * D * 2);
constexpr int NZB = 3840, NZG = 3072;
static_assert(ZG == NZB && NZB + NZG == NZ, "gate columns");
constexpr size_t WS_WIN = al(WS_Y + (size_t)M * D * 2);
constexpr size_t WS_WING8 = al(WS_WIN + (size_t)DEPTH * NZB * D * 2);
constexpr size_t WS_HB8 = al(WS_WING8 + (size_t)DEPTH * NZG * D);
constexpr size_t WS_Y2 = al(WS_HB8 + (size_t)M * D);
constexpr size_t WS_WLORA = al(WS_Y2 + (size_t)MCTX * D * 2);
constexpr size_t WS_WBR = al(WS_WLORA + (size_t)DEPTH * NLORA * KLORA * 2);
constexpr size_t WS_WOUT = al(WS_WBR + (size_t)DEPTH * 3072 * 512 * 2);
constexpr size_t WS_W13 = al(WS_WOUT + (size_t)DEPTH * D * D * 2);
constexpr size_t WS_W2 = al(WS_W13 + (size_t)2 * NF1 * D * 2);
constexpr size_t WS_MW13 = al(WS_W2 + (size_t)2 * D * DFF * 2);
constexpr size_t WS_MW2 = al(WS_MW13 + (size_t)NEXP * NF1 * D * 2);
constexpr int NCHUNK = (CL + T) / 16;
constexpr int REC_BYTES = 10496, RO_KT = 0, RO_RT = 2048, RO_KA = 4096, RO_OA = 8192, RO_AK = 9216, RO_TT = 9728, RO_WC = 10240;
constexpr size_t WS_FRAG = al(WS_MW2 + (size_t)NEXP * D * DFF * 2);
constexpr size_t WS_ARENA = al(WS_FRAG + (size_t)32 * NCHUNK * REC_BYTES);
constexpr size_t AR_Z = 0;
constexpr size_t AR_BR = al(AR_Z + (size_t)M * NZ * 2);
constexpr size_t AR_LO = al(AR_BR + (size_t)M * 1536 * 2);
constexpr size_t AR_VT = AR_LO + (size_t)M * NLORA * 2;
constexpr size_t AR_P = AR_LO;
constexpr size_t AR_OFB = al(AR_VT + (size_t)M * 512 * 2);
constexpr size_t AR_END_MIX = al(AR_OFB + (size_t)2 * M * 512 * 2);
constexpr size_t AR_HP = 0;
constexpr size_t AR_ACT = al(AR_HP + (size_t)MAXPANELS * 256 * D * 2);
constexpr size_t AR_YP = al(AR_ACT + (size_t)MAXPANELS * 256 * DFF * 2);
constexpr size_t AR_END_FFN = al(AR_YP + (size_t)MAXPANELS * 256 * D * 2);
constexpr size_t ARENA_BYTES = AR_END_MIX > AR_END_FFN ? AR_END_MIX : AR_END_FFN;
constexpr size_t WS_END = WS_ARENA + ARENA_BYTES;
static_assert(AR_P + (size_t)M * 3072 * 2 <= AR_OFB, "P overlays LO+VT only");
static_assert(WS_END <= (size_t)948 * 1000 * 1000, "workspace budget");

constexpr int CW_BAR = 4096;
constexpr int CW_MOE = 16384;
constexpr int CW_BB = 32768;
constexpr int CW_SPM = 52224;
constexpr int CW_DEFB = 53248;
constexpr int CW_DEF = 49152;

constexpr int RING_BYTES = 131072;
constexpr int LDSCTL_OFF = RING_BYTES, MISC_OFF = LDSCTL_OFF + 320;
constexpr int LDS_BYTES = 147456;

#define RLX_AGENT __ATOMIC_RELAXED, __HIP_MEMORY_SCOPE_AGENT
#define LDS_WAIT() asm volatile("s_waitcnt lgkmcnt(0)" ::: "memory")
#define VM_WAIT() asm volatile("s_waitcnt vmcnt(0)" ::: "memory")
typedef __bf16 bf2_t __attribute__((ext_vector_type(2)));
__device__ __forceinline__ unsigned f2bf(float f) { const __bf16 b = (__bf16)f; return (unsigned)__builtin_bit_cast(unsigned short, b); }
__device__ __forceinline__ unsigned pk2(float lo, float hi) { const bf2_t v = __builtin_convertvector((f32x2){lo, hi}, bf2_t); return __builtin_bit_cast(unsigned, v); }
__device__ __forceinline__ float bflo(unsigned u) { return __builtin_bit_cast(float, u << 16); }
__device__ __forceinline__ float bfhi(unsigned u) { return __builtin_bit_cast(float, u & 0xffff0000u); }
__device__ __forceinline__ float bf1(bf16 b) { return __builtin_bit_cast(float, ((unsigned)b) << 16); }
__device__ __forceinline__ void unpack8(const v4u v, float (&o)[8]) { o[0] = bflo(v.x); o[1] = bfhi(v.x); o[2] = bflo(v.y); o[3] = bfhi(v.y); o[4] = bflo(v.z); o[5] = bfhi(v.z); o[6] = bflo(v.w); o[7] = bfhi(v.w); }
__device__ __forceinline__ v4u pack8(const float (&o)[8]) { v4u v; v.x = pk2(o[0], o[1]); v.y = pk2(o[2], o[3]); v.z = pk2(o[4], o[5]); v.w = pk2(o[6], o[7]); return v; }
__device__ __forceinline__ int lane_id() { return (int)__builtin_amdgcn_mbcnt_hi(~0u, __builtin_amdgcn_mbcnt_lo(~0u, 0u)); }
__device__ __forceinline__ float sigmoidf_(float x) { return 1.0f / (1.0f + __expf(-x)); }
__device__ __forceinline__ float sat8(float x) { return fminf(fmaxf(x, -448.0f), 448.0f); }
__device__ __forceinline__ float dppf(float x, const int ctrl_sel) {
    int xi = __builtin_bit_cast(int, x), r;
    if (ctrl_sel == 0) r = __builtin_amdgcn_mov_dpp(xi, 0xB1, 0xF, 0xF, true);
    else if (ctrl_sel == 1) r = __builtin_amdgcn_mov_dpp(xi, 0x4E, 0xF, 0xF, true);
    else r = __builtin_amdgcn_mov_dpp(xi, 0x141, 0xF, 0xF, true);
    return __builtin_bit_cast(float, r);
}
__device__ __forceinline__ float red8_dpp(float v) { v += dppf(v, 0); v += dppf(v, 1); v += dppf(v, 2); return v; }
__device__ __forceinline__ float red8(float v) { return red8_dpp(v); }
__device__ __forceinline__ float wave_sum(float v) {
    v = red8_dpp(v);
    v += __builtin_bit_cast(float, __builtin_amdgcn_mov_dpp(__builtin_bit_cast(int, v), 0x140, 0xF, 0xF, true));
    v += __builtin_bit_cast(float, __builtin_amdgcn_update_dpp(0, __builtin_bit_cast(int, v), 0x142, 0xA, 0xF, false));
    v += __builtin_bit_cast(float, __builtin_amdgcn_update_dpp(0, __builtin_bit_cast(int, v), 0x143, 0xC, 0xF, false));
    return __builtin_bit_cast(float, __builtin_amdgcn_readlane(__builtin_bit_cast(int, v), 63));
}

namespace pg8 {
#define PG8_LAS __attribute__((address_space(3)))
typedef unsigned short bf16_t;
typedef unsigned u32x4 __attribute__((ext_vector_type(4)));
constexpr int BM = 256, BK = 64, HALF = 128, HTB = HALF * BK * 2, STAGE_BYTES = 8 * HTB, NXCD = 8, WGM = 8;

__host__ __device__ __forceinline__ int lds_byte(int r, int c) { const int st = (r >> 4) * 2 + (c >> 5), rr = r & 15, cc = c & 31, ob = rr * 64 + cc * 2; return st * 1024 + (ob ^ (((ob >> 9) & 1) << 5)); }
__host__ __device__ __forceinline__ void stage_rc(int b, int& R, int& C) { const int st = b / 1024, sb = b % 1024, swz = sb ^ (((sb >> 9) & 1) << 5); R = (st >> 1) * 16 + swz / 64; C = (st & 1) * 32 + (swz % 64) / 2; }
__host__ __device__ __forceinline__ int perm32(int rho) { const int n = rho >> 4, i = rho & 15; return 8 * (i >> 2) + 4 * n + (i & 3); }

struct Unit { int pm, pn; const char* a; const char* b; };
struct Gemm { int lda, ldb, K; };

struct TileOrder {
    int nM, nN, nwg, G, c;
    __device__ __forceinline__ void init(int nM_, int nN_, int G_, int c_) { nM = nM_; nN = nN_; nwg = nM * nN; G = G_; c = c_; }
    __device__ __forceinline__ bool tile(int i, int& pm, int& pn) const {
        const long L = (long)i * G + c; if (L >= nwg) return false;
        int wgid = (int)L; { const int q = nwg / NXCD, r = nwg % NXCD, xcd = wgid % NXCD, off = wgid / NXCD; wgid = (xcd < r ? xcd * (q + 1) : r * (q + 1) + (xcd - r) * q) + off; }
        const int nig = WGM * nN, gid = wgid / nig, fm = gid * WGM, gsz = (nM - fm) < WGM ? (nM - fm) : WGM;
        pm = fm + ((wgid % nig) % gsz); pn = (wgid % nig) / gsz; return true;
    }
};

__device__ __forceinline__ unsigned cvt_pk_bf16(float lo, float hi) { unsigned r; asm volatile("v_cvt_pk_bf16_f32 %0, %1, %2" : "=v"(r) : "v"(lo), "v"(hi)); return r; }

template <class Epi, class Sched, bool FP8 = false, bool ALIGN_EPI = true>
__device__ __forceinline__ void gemm_phase(PG8_LAS unsigned char* lds, const Gemm g, const Sched& S, const Epi& E, int wave_id) {
    int tid_ = wave_id * 64 + lane_id(); asm volatile("" : "+v"(tid_));
    const int tid = tid_, wid = __builtin_amdgcn_readfirstlane(tid >> 6), lane = tid & 63, wr = wid >> 2, wc = wid & 3, fr = lane & 15, fq = lane >> 4;
    int K_ = g.K; asm volatile("" : "+s"(K_));
    const int K = K_, nt = K / BK;
    unsigned voffA[2], voffB[2];
#pragma unroll
    for (int i = 0; i < 2; ++i) { int R, C; stage_rc(tid * 16 + i * 8192, R, C); const int Rb = Epi::PERM ? ((R & ~31) + perm32(R & 31)) : R;
        voffA[i] = (unsigned)(R * g.lda + C) * 2u; voffB[i] = (unsigned)(Rb * g.ldb + C) * 2u; }
    const size_t kstep = (size_t)(BK * 2);
    const size_t hstepA = (size_t)HALF * g.lda * 2, hstepB = (size_t)HALF * g.ldb * 2;
    const unsigned ldsw = (unsigned)wid * 1024u;
    const int aoff = lds_byte(wr * 64 + fr, fq * 8), boff = lds_byte(wc * 32 + fr, fq * 8);
#define PG8_SA(b, h) (((b) * 2 + (h)) * HTB)
#define PG8_SB(b, h) ((4 + (b) * 2 + (h)) * HTB)
#define PG8_STAGE(bufoff, gbase, voff) do { _Pragma("unroll") for (int _i = 0; _i < 2; ++_i) \
        __builtin_amdgcn_global_load_lds((const unsigned*)((const char*)(gbase) + (voff)[_i]), (PG8_LAS unsigned*)(lds + (bufoff) + ldsw + _i * 8192), 16, 0, 0); } while (0)
#define PG8_LDA(dst, b, h) do { _Pragma("unroll") for (int m = 0; m < 4; ++m) _Pragma("unroll") for (int k = 0; k < 2; ++k) dst[m][k] = *(const PG8_LAS bf16x8*)(lds + PG8_SA(b, h) + aoff + m * 2048 + k * 1024); } while (0)
#define PG8_LDB(dst, b, h) do { _Pragma("unroll") for (int n = 0; n < 2; ++n) _Pragma("unroll") for (int k = 0; k < 2; ++k) dst[n][k] = *(const PG8_LAS bf16x8*)(lds + PG8_SB(b, h) + boff + n * 2048 + k * 1024); } while (0)
#define PG8_MMA(ai, bj, At, Bt) do { __builtin_amdgcn_s_setprio(1); _Pragma("unroll") for (int m = 0; m < 4; ++m) _Pragma("unroll") for (int n = 0; n < 2; ++n) { \
        if constexpr (FP8) { typedef int v8i_ __attribute__((ext_vector_type(8))); typedef int v4i_ __attribute__((ext_vector_type(4))); \
            const v4i_ b0_ = __builtin_bit_cast(v4i_, Bt[n][0]), b1_ = __builtin_bit_cast(v4i_, Bt[n][1]), a0_ = __builtin_bit_cast(v4i_, At[m][0]), a1_ = __builtin_bit_cast(v4i_, At[m][1]); \
            const v8i_ bo_ = {b0_[0], b0_[1], b0_[2], b0_[3], b1_[0], b1_[1], b1_[2], b1_[3]}, ao_ = {a0_[0], a0_[1], a0_[2], a0_[3], a1_[0], a1_[1], a1_[2], a1_[3]}; \
            asm volatile("v_mfma_scale_f32_16x16x128_f8f6f4 %0, %1, %2, %0, %3, %4 op_sel_hi:[0,0,0]" : "+v"(acc[ai][bj][m][n]) : "v"(bo_), "v"(ao_), "v"(0x7A7A7A7A), "v"(0x7D7D7D7D)); }   \
        else { _Pragma("unroll") for (int k = 0; k < 2; ++k) acc[ai][bj][m][n] = __builtin_amdgcn_mfma_f32_16x16x32_bf16(Bt[n][k], At[m][k], acc[ai][bj][m][n], 0, 0, 0); } } \
        __builtin_amdgcn_s_setprio(0); } while (0)
#define PG8_WAIT_V(n) asm volatile("s_waitcnt vmcnt(" #n ")" ::: "memory")
#define PG8_WAIT_L(n) asm volatile("s_waitcnt lgkmcnt(" #n ")" ::: "memory")
#define PG8_BAR __builtin_amdgcn_s_barrier()
#define PG8_SCHED __builtin_amdgcn_sched_barrier(0)
    Unit cur, nxt; int ui = 0;
    if (!S.next(0, cur)) return;
    f32x4 acc[2][2][4][2];
#pragma unroll
    for (int a = 0; a < 2; ++a)
#pragma unroll
        for (int b = 0; b < 2; ++b)
#pragma unroll
            for (int m = 0; m < 4; ++m)
#pragma unroll
                for (int n = 0; n < 2; ++n) acc[a][b][m][n] = (f32x4){0.f, 0.f, 0.f, 0.f};
    bf16x8 At[4][2], B0[2][2], B1[2][2];
    const char* cA = cur.a; const char* cB = cur.b;
    PG8_STAGE(PG8_SB(0, 0), cB, voffB); PG8_STAGE(PG8_SB(0, 1), cB + hstepB, voffB); PG8_STAGE(PG8_SA(0, 0), cA, voffA); PG8_STAGE(PG8_SA(0, 1), cA + hstepA, voffA);
    if (wr == 1) PG8_BAR;
    PG8_WAIT_V(2); PG8_BAR;
    PG8_STAGE(PG8_SB(1, 0), cB + kstep, voffB); PG8_STAGE(PG8_SA(1, 0), cA + kstep, voffA); PG8_STAGE(PG8_SB(1, 1), cB + hstepB + kstep, voffB);
    PG8_WAIT_V(6); PG8_BAR;
    for (;;) {
        const bool has_next = S.next(ui + 1, nxt);
        const char* nA = has_next ? nxt.a : cA; const char* nB = has_next ? nxt.b : cB;
        for (int t = 0; t < nt; t += 2) {
            const bool last = (t == nt - 2);
            const char* a1 = cA + (size_t)(t + 1) * kstep;
            const char* a2 = last ? nA : cA + (size_t)(t + 2) * kstep; const char* b2 = last ? nB : cB + (size_t)(t + 2) * kstep;
            const char* a3 = a2 + kstep; const char* b3 = b2 + kstep;
            PG8_LDB(B0, 0, 0); PG8_LDB(B1, 0, 1); PG8_SCHED; PG8_LDA(At, 0, 0); PG8_STAGE(PG8_SA(1, 1), a1 + hstepA, voffA);
            PG8_WAIT_V(8); PG8_WAIT_L(0); PG8_BAR; PG8_MMA(0, 0, At, B0); PG8_MMA(0, 1, At, B1); PG8_BAR; PG8_SCHED;
            PG8_LDA(At, 0, 1); PG8_STAGE(PG8_SB(0, 0), b2, voffB); PG8_STAGE(PG8_SB(0, 1), b2 + hstepB, voffB); PG8_STAGE(PG8_SA(0, 0), a2, voffA);
            PG8_WAIT_V(8); PG8_WAIT_L(0); PG8_BAR; PG8_MMA(1, 0, At, B0); PG8_MMA(1, 1, At, B1); PG8_BAR; PG8_SCHED;
            PG8_LDB(B0, 1, 0); PG8_LDB(B1, 1, 1); PG8_SCHED; PG8_LDA(At, 1, 0); PG8_STAGE(PG8_SA(0, 1), a2 + hstepA, voffA);
            PG8_WAIT_V(8); PG8_WAIT_L(0); PG8_BAR; PG8_MMA(0, 0, At, B0); PG8_MMA(0, 1, At, B1); PG8_BAR; PG8_SCHED;
            PG8_LDA(At, 1, 1); PG8_STAGE(PG8_SB(1, 0), b3, voffB); PG8_STAGE(PG8_SB(1, 1), b3 + hstepB, voffB); PG8_STAGE(PG8_SA(1, 0), a3, voffA);
            PG8_WAIT_V(8); PG8_WAIT_L(0); PG8_BAR; PG8_MMA(1, 0, At, B0); PG8_MMA(1, 1, At, B1); PG8_BAR; PG8_SCHED;
        }
        if constexpr (ALIGN_EPI) { if (wr == 0) PG8_BAR; }
        if constexpr (FP8) asm volatile("s_nop 15\n\ts_nop 15" ::: "memory");
        E(acc, cur, wr, wc, fr, fq);
        if (!has_next) break;
#pragma unroll
        for (int a = 0; a < 2; ++a)
#pragma unroll
            for (int b = 0; b < 2; ++b)
#pragma unroll
                for (int m = 0; m < 4; ++m)
#pragma unroll
                    for (int n = 0; n < 2; ++n) acc[a][b][m][n] = (f32x4){0.f, 0.f, 0.f, 0.f};
        cur = nxt; cA = nA; cB = nB; ++ui;
        if constexpr (ALIGN_EPI) { if (wr == 1) PG8_BAR; }
    }
    PG8_WAIT_V(0);
    if constexpr (!ALIGN_EPI) { if (wr == 0) PG8_BAR; }
    PG8_BAR;
#undef PG8_SA
#undef PG8_SB
#undef PG8_STAGE
#undef PG8_LDA
#undef PG8_LDB
#undef PG8_MMA
#undef PG8_WAIT_V
#undef PG8_WAIT_L
#undef PG8_BAR
#undef PG8_SCHED
}

struct DenseSched {
    TileOrder to; const char* A; const char* Bt; size_t a_tile, b_tile; int acol_div; size_t acol_step;
    __device__ __forceinline__ bool next(int i, Unit& u) const {
        int pm, pn; if (!to.tile(i, pm, pn)) return false;
        u.pm = pm; u.pn = pn; u.a = A + (size_t)pm * a_tile + (size_t)(pn / acol_div) * acol_step; u.b = Bt + (size_t)pn * b_tile; return true;
    }
};
struct GroupSched {
    TileOrder to; const char* A; const char* Bt; size_t a_tile, b_tile, b_exp; int pe[9];
    __device__ __forceinline__ bool next(int i, Unit& u) const {
        int pm, pn; if (!to.tile(i, pm, pn)) return false;
        int e = 0;
#pragma unroll
        for (int j = 1; j < 8; ++j) e += (pm >= pe[j]) ? 1 : 0;
        u.pm = pm; u.pn = pn; u.a = A + (size_t)pm * a_tile; u.b = Bt + (size_t)e * b_exp + (size_t)pn * b_tile; return true;
    }
};

struct SingleSched {
    int pm, pn; const char* a; const char* b;
    __device__ __forceinline__ bool next(int i, Unit& u) const { if (i != 0) return false; u.pm = pm; u.pn = pn; u.a = a; u.b = b; return true; }
};
struct EpiBf16 {
    static constexpr bool PERM = true;
    bf16_t* O; int ldc;
    __device__ __forceinline__ void operator()(const f32x4 (&acc)[2][2][4][2], const Unit& u, int wr, int wc, int fr, int fq) const {
        const int row0 = u.pm * BM + wr * 64 + fr, col0 = u.pn * BM + wc * 32 + 8 * fq;
#pragma unroll
        for (int ai = 0; ai < 2; ++ai)
#pragma unroll
            for (int m = 0; m < 4; ++m) { bf16_t* rowp = O + (size_t)(row0 + ai * HALF + m * 16) * ldc + col0;
#pragma unroll
                for (int bj = 0; bj < 2; ++bj) { const f32x4 v0 = acc[ai][bj][m][0], v1 = acc[ai][bj][m][1];
                    u32x4 w; w.x = cvt_pk_bf16(v0[0], v0[1]); w.y = cvt_pk_bf16(v0[2], v0[3]); w.z = cvt_pk_bf16(v1[0], v1[1]); w.w = cvt_pk_bf16(v1[2], v1[3]);
                    *(u32x4*)(rowp + bj * HALF) = w; } }
    }
};
struct EpiGate {
    static constexpr bool PERM = true;
    bf16_t* O; const bf16_t* zg;
    __device__ __forceinline__ void operator()(const f32x4 (&acc)[2][2][4][2], const Unit& u, int wr, int wc, int fr, int fq) const {
        const int row0 = u.pm * BM + wr * 64 + fr, col0 = u.pn * BM + wc * 32 + 8 * fq;
#pragma unroll
        for (int ai = 0; ai < 2; ++ai) {
            u32x4 gz[4][2];
#pragma unroll
            for (int m = 0; m < 4; ++m)
#pragma unroll
                for (int bj = 0; bj < 2; ++bj) gz[m][bj] = *(const u32x4*)(zg + (size_t)(row0 + ai * HALF + m * 16) * NZ + col0 + bj * HALF);
            asm volatile("" ::: "memory"); __builtin_amdgcn_sched_barrier(0);
#pragma unroll
            for (int m = 0; m < 4; ++m) { const size_t row = (size_t)(row0 + ai * HALF + m * 16); bf16_t* rowp = O + row * 3072 + col0;
#pragma unroll
                for (int bj = 0; bj < 2; ++bj) { const f32x4 v0 = acc[ai][bj][m][0], v1 = acc[ai][bj][m][1];
                    float gq[8]; unpack8(gz[m][bj], gq);
                    u32x4 w; w.x = cvt_pk_bf16(v0[0] * sigmoidf_(gq[0]), v0[1] * sigmoidf_(gq[1])); w.y = cvt_pk_bf16(v0[2] * sigmoidf_(gq[2]), v0[3] * sigmoidf_(gq[3]));
                    w.z = cvt_pk_bf16(v1[0] * sigmoidf_(gq[4]), v1[1] * sigmoidf_(gq[5])); w.w = cvt_pk_bf16(v1[2] * sigmoidf_(gq[6]), v1[3] * sigmoidf_(gq[7]));
                    *(u32x4*)(rowp + bj * HALF) = w; } }
        }
    }
};
struct EpiLora {
    static constexpr bool PERM = true;
    bf16_t* O; const float* w0; const float* a0;
    __device__ __forceinline__ void operator()(const f32x4 (&acc)[2][2][4][2], const Unit& u, int wr, int wc, int fr, int fq) const {
        const int row0 = u.pm * BM + wr * 64 + fr, col0 = u.pn * BM + wc * 32 + 8 * fq;
        const int seg = u.pn >> 1;
        const float* bias = seg < 2 ? w0 + seg * 512 : a0 + (seg - 2) * 512;
        const int cc = col0 & 511;
        f32x4 bv[2][2];
#pragma unroll
        for (int bj = 0; bj < 2; ++bj) { bv[bj][0] = *(const f32x4*)(bias + cc + bj * HALF); bv[bj][1] = *(const f32x4*)(bias + cc + bj * HALF + 4); }
        asm volatile("" ::: "memory"); __builtin_amdgcn_sched_barrier(0);
#pragma unroll
        for (int ai = 0; ai < 2; ++ai)
#pragma unroll
            for (int m = 0; m < 4; ++m) { bf16_t* rowp = O + (size_t)(row0 + ai * HALF + m * 16) * NLORA + col0;
#pragma unroll
                for (int bj = 0; bj < 2; ++bj) { f32x4 v0 = acc[ai][bj][m][0], v1 = acc[ai][bj][m][1];
                    if (seg < 4) { const f32x4 b0 = bv[bj][0], b1 = bv[bj][1];
                        const float sc = seg < 2 ? -0.60653066f : 1.0f;
#pragma unroll
                        for (int j = 0; j < 4; ++j) { v0[j] = sc * sigmoidf_(v0[j] + b0[j]); v1[j] = sc * sigmoidf_(v1[j] + b1[j]); } }
                    u32x4 w; w.x = cvt_pk_bf16(v0[0], v0[1]); w.y = cvt_pk_bf16(v0[2], v0[3]); w.z = cvt_pk_bf16(v1[0], v1[1]); w.w = cvt_pk_bf16(v1[2], v1[3]);
                    *(u32x4*)(rowp + bj * HALF) = w; } }
    }
};
struct EpiSwiglu8 {
    static constexpr bool PERM = false;
    unsigned char* O;
    __device__ __forceinline__ void operator()(const f32x4 (&acc)[2][2][4][2], const Unit& u, int wr, int wc, int fr, int fq) const {
        const int row0 = u.pm * BM + wr * 64 + fr, col0 = u.pn * 128 + wc * 16 + 4 * fq;
#pragma unroll
        for (int ai = 0; ai < 2; ++ai)
#pragma unroll
            for (int m = 0; m < 4; ++m) { unsigned char* rowp = O + (size_t)(row0 + ai * HALF + m * 16) * DFF + col0;
#pragma unroll
                for (int bj = 0; bj < 2; ++bj) { const f32x4 a = acc[ai][bj][m][0], b = acc[ai][bj][m][1]; float o[4];
#pragma unroll
                    for (int j = 0; j < 4; ++j) o[j] = sat8(4.0f * a[j] * sigmoidf_(a[j]) * b[j]);
                    unsigned w = 0u; w = __builtin_amdgcn_cvt_pk_fp8_f32(o[0], o[1], w, false); w = __builtin_amdgcn_cvt_pk_fp8_f32(o[2], o[3], w, true);
                    *(unsigned*)(rowp + bj * 64) = w; } }
    }
};
struct EpiSwiglu {
    static constexpr bool PERM = false;
    bf16_t* O;
    __device__ __forceinline__ void operator()(const f32x4 (&acc)[2][2][4][2], const Unit& u, int wr, int wc, int fr, int fq) const {
        const int row0 = u.pm * BM + wr * 64 + fr, col0 = u.pn * 128 + wc * 16 + 4 * fq;
#pragma unroll
        for (int ai = 0; ai < 2; ++ai)
#pragma unroll
            for (int m = 0; m < 4; ++m) { bf16_t* rowp = O + (size_t)(row0 + ai * HALF + m * 16) * DFF + col0;
#pragma unroll
                for (int bj = 0; bj < 2; ++bj) { const f32x4 a = acc[ai][bj][m][0], b = acc[ai][bj][m][1]; float o[4];
#pragma unroll
                    for (int j = 0; j < 4; ++j) o[j] = a[j] * sigmoidf_(a[j]) * b[j];
                    v2u w; w.x = cvt_pk_bf16(o[0], o[1]); w.y = cvt_pk_bf16(o[2], o[3]);
                    *(v2u*)(rowp + bj * 64) = w; } }
    }
};
}

#define XB_TMO      128
#define XB_XCNT(j)  (256  + 64 * (j))
#define XB_XSUB(j)  (1280 + 64 * (j))
#define XB_XGEN(j)  (2304 + 64 * (j))
#define XB_TOP      3328
#define XB_TOPGEN   3392
#define XCD_BAR_WORDS 3456
#define XB_SPIN_CAP (1u << 18)
__device__ __forceinline__ unsigned xb_ld(unsigned* p)              { return __hip_atomic_load(p, __ATOMIC_RELAXED, __HIP_MEMORY_SCOPE_AGENT); }
__device__ __forceinline__ unsigned xb_add(unsigned* p, unsigned v) { return __hip_atomic_fetch_add(p, v, __ATOMIC_RELAXED, __HIP_MEMORY_SCOPE_AGENT); }
__device__ __forceinline__ unsigned xb_xcc_id() { return (unsigned)__builtin_amdgcn_s_getreg((3 << 11) | 20) & 0xFu; }
#define XB_SPIN(cond, bar) do { unsigned _sp = 0; while (cond) { __builtin_amdgcn_s_sleep(1); \
    if ((++_sp & 255u) == 0u) { if (xb_ld(&(bar)[XB_TMO])) break; if (_sp > XB_SPIN_CAP) { atomicAdd(&(bar)[XB_TMO], 1u); break; } } } } while (0)
struct XcdBarrier { unsigned* bar; unsigned x; volatile LAS unsigned* st; };
__device__ __forceinline__ XcdBarrier xcd_barrier_post(unsigned* bar, volatile LAS unsigned* st) {
    XcdBarrier b; b.bar = bar; b.x = xb_xcc_id(); b.st = st;
    if (threadIdx.x == 0) (void)xb_add(&bar[XB_XCNT(b.x)], 1u);
    return b;
}
__device__ __forceinline__ void xcd_barrier_complete(unsigned* bar, unsigned x, unsigned& nloc, unsigned& nx) {
    const unsigned G = gridDim.x * gridDim.y * gridDim.z;
    unsigned sum, cnt, mine, sp = 0u;
    for (;;) {
        sum = 0u; cnt = 0u; mine = 0u;
#pragma unroll
        for (unsigned j = 0; j < 16; ++j) { const unsigned c = xb_ld(&bar[XB_XCNT(j)]); sum += c; cnt += (c > 0u) ? 1u : 0u; mine = (j == x) ? c : mine; }
        if (sum == G) break;
        __builtin_amdgcn_s_sleep(1);
        if ((++sp & 255u) == 0u) { if (xb_ld(&bar[XB_TMO])) break; if (sp > XB_SPIN_CAP) { atomicAdd(&bar[XB_TMO], 1u); break; } }
    }
    nloc = mine > 0u ? mine : 1u; nx = cnt > 0u ? cnt : 1u;
}
__device__ __forceinline__ void xcd_barrier(const XcdBarrier& b, int wave_id) {
    asm volatile("s_waitcnt vmcnt(0)" ::: "memory");
    __syncthreads();
    if (wave_id == 0 && lane_id() == 0) {
        unsigned* bar = b.bar;
        __builtin_amdgcn_s_waitcnt(0);
        unsigned nloc = b.st[0], nx = b.st[1];
        if (nloc == 0u) { xcd_barrier_complete(bar, b.x, nloc, nx); b.st[0] = nloc; b.st[1] = nx; }
        const unsigned old = xb_add(&bar[XB_XSUB(b.x)], 1u);
        const unsigned gen = old / nloc;
        if (old + 1u == (gen + 1u) * nloc) {
            __builtin_amdgcn_fence(__ATOMIC_RELEASE, "agent");
            asm volatile("s_waitcnt vmcnt(0)" ::: "memory");
            const unsigned og = xb_add(&bar[XB_TOP], 1u);
            const unsigned tg = og / nx;
            asm volatile("buffer_inv sc1" ::: "memory");
            if (og + 1u == (tg + 1u) * nx) xb_add(&bar[XB_TOPGEN], 1u);
            else XB_SPIN(xb_ld(&bar[XB_TOPGEN]) == tg, bar);
            xb_add(&bar[XB_XGEN(b.x)], 1u);
            asm volatile("s_waitcnt vmcnt(0)" ::: "memory");
        } else {
            asm volatile("buffer_inv sc1" ::: "memory");
            XB_SPIN(xb_ld(&bar[XB_XGEN(b.x)]) == gen, bar);
            asm volatile("s_waitcnt vmcnt(0)" ::: "memory");
        }
    }
    __syncthreads();
}

struct Args { const float* in[34]; float* out; unsigned char* ws; int ph_lo, ph_hi; };
typedef const __attribute__((address_space(4))) Args* KArgs;
#define KIN(ka, i) ((const float*)(const GAS float*)(ka)->in[i])
__device__ __forceinline__ KArgs kargs() { KArgs p = (KArgs)__builtin_amdgcn_kernarg_segment_ptr(); asm volatile("" : "+s"(p)); return p; }
enum { I_X = 0, I_C, I_CTX, I_CCTX, I_WMOD, I_BMOD, I_NMG, I_NFG, I_WIN, I_POOLW, I_POOLS, I_SHMU, I_DW0, I_DW2, I_A0, I_A2, I_KKK, I_KKA, I_BONUS, I_GNG, I_GNB, I_GG2,
       I_QNG, I_KNG, I_RPB, I_WBR, I_WOUT, I_F1, I_F3, I_F2, I_ROUTER, I_M1, I_M3, I_M2 };

struct Frame {
    LAS unsigned char* lds;
    unsigned char* ws;
    int tid, lane, wave, vcu, G;
};
__device__ __forceinline__ void frame_refresh(Frame& F) {
    int w_ = __builtin_amdgcn_readfirstlane(F.wave); asm volatile("" : "+s"(w_));
    int t = w_ * 64 + lane_id(); asm volatile("" : "+v"(t));
    F.tid = t; F.lane = t & 63; F.wave = w_;
    unsigned long long w = (unsigned long long)F.ws; { const unsigned lo_ = __builtin_amdgcn_readfirstlane((unsigned)w), hi_ = __builtin_amdgcn_readfirstlane((unsigned)(w >> 32)); w = ((unsigned long long)hi_ << 32) | lo_; }
    asm volatile("" : "+s"(w)); F.ws = (unsigned char*)(GAS unsigned char*)w;
}

struct MapPlain { int off; __device__ __forceinline__ int operator()(int n) const { return n + off; } };
struct MapWin { __device__ __forceinline__ int operator()(int n) const { return n < 2272 ? n : n + 32; } };
struct MapF13 { int add; __device__ __forceinline__ int operator()(int n) const { return 32 * (n >> 4) + (n & 15) + add; } };
template <class RowMap>
__device__ __forceinline__ void tr_item(const float* W, int ldw, int k0, int n0, bf16* WT, int ldt, const RowMap rm, LAS float* scr, int lane) {
    float tv[32];
#pragma unroll
    for (int i = 0; i < 32; ++i) { const int kk = 2 * i + (lane >> 5); tv[i] = W[(size_t)(k0 + kk) * ldw + n0 + (lane & 31)]; }
#pragma unroll
    for (int i = 0; i < 32; ++i) { const int kk = 2 * i + (lane >> 5); scr[kk * 33 + (lane & 31)] = tv[i]; }
    LDS_WAIT(); asm volatile("" ::: "memory");
    const int c = lane & 7;
#pragma unroll
    for (int j = 0; j < 4; ++j) { const int n = (lane >> 3) + 8 * j; const LAS float* s = scr + (8 * c) * 33 + n;
        v4u o; o.x = pk2(s[0 * 33], s[1 * 33]); o.y = pk2(s[2 * 33], s[3 * 33]); o.z = pk2(s[4 * 33], s[5 * 33]); o.w = pk2(s[6 * 33], s[7 * 33]);
        *(GAS v4u*)(WT + (size_t)rm(n0 + n) * ldt + k0 + 8 * c) = o; }
    LDS_WAIT(); asm volatile("" ::: "memory");
}


template <class RowMap>
__device__ __forceinline__ void tr_item8(const float* W, int ldw, int k0, int n0, unsigned char* WT, int ldt, const RowMap rm, LAS float* scr, int lane) {
    float tv[32];
#pragma unroll
    for (int i = 0; i < 32; ++i) { const int kk = 2 * i + (lane >> 5); tv[i] = W[(size_t)(k0 + kk) * ldw + n0 + (lane & 31)]; }
#pragma unroll
    for (int i = 0; i < 32; ++i) { const int kk = 2 * i + (lane >> 5); scr[kk * 33 + (lane & 31)] = tv[i]; }
    LDS_WAIT(); asm volatile("" ::: "memory");
    const int c = lane & 3;
#pragma unroll
    for (int j = 0; j < 2; ++j) { const int n = (lane >> 2) + 16 * j; const LAS float* s = scr + (16 * c) * 33 + n; unsigned w[4];
#pragma unroll
        for (int q = 0; q < 4; ++q) { unsigned x = 0u; x = __builtin_amdgcn_cvt_pk_fp8_f32(sat8(32.f * s[(4 * q) * 33]), sat8(32.f * s[(4 * q + 1) * 33]), x, false); x = __builtin_amdgcn_cvt_pk_fp8_f32(sat8(32.f * s[(4 * q + 2) * 33]), sat8(32.f * s[(4 * q + 3) * 33]), x, true); w[q] = x; }
        *(GAS v4u*)(WT + (size_t)rm(n0 + n) * ldt + k0 + 16 * c) = (v4u){w[0], w[1], w[2], w[3]}; }
    LDS_WAIT(); asm volatile("" ::: "memory");
}
__device__ __forceinline__ void moe_convert(Frame& F, const Args& args, int j) {
    frame_refresh(F); KArgs KA = kargs();
    unsigned char* ws = F.ws;
    const int gw = F.vcu * 8 + F.wave, NGW = F.G * 8, lane = F.lane;
    LAS float* scr = (LAS float*)(F.lds + F.wave * 16384);
    constexpr int IT_F13 = 16 * 88, IT_F2 = 44 * 32, H0 = 16 * IT_F13, H1 = H0 + 8 * IT_F2;
    for (int it = gw; it < H1; it += NGW) {
        if (it < H0) { const int job = it / IT_F13, r = it % IT_F13, kb = r / 88, nb = r % 88; const int e = job >> 1, w3 = job & 1;
            tr_item8(KIN(KA, w3 ? I_M3 : I_M1) + (size_t)(j * NEXP + e) * D * DFF, DFF, kb * 64, nb * 32, ws + WS_MW13 + (size_t)e * NF1 * D, D, MapF13{w3 * 16}, scr, lane); }
        else { const int q = it - H0, e = q / IT_F2, r = q % IT_F2, kb = r / 32, nb = r % 32;
            tr_item8(KIN(KA, I_M2) + (size_t)(j * NEXP + e) * DFF * D, D, kb * 64, nb * 32, ws + WS_MW2 + (size_t)e * D * DFF, DFF, MapPlain{0}, scr, lane); }
    }
}

__device__ __forceinline__ void p0_prologue(Frame& F, const Args& args) {
    frame_refresh(F); KArgs KA = kargs();
    unsigned char* ws = F.ws;
    const int gw = F.vcu * 8 + F.wave, NGW = F.G * 8, lane = F.lane;
    {
        LAS float* scr = (LAS float*)(F.lds + F.wave * 16384);
        constexpr int IT_WIN = 16 * 199, IT_BR = 8 * 32, IT_OUT = 16 * 32, IT_F13 = 16 * 88, IT_F2 = 44 * 32;
        constexpr int G0 = 4 * IT_WIN, G1 = G0 + 12 * IT_BR, G2 = G1 + 4 * IT_OUT, G3 = G2 + 4 * IT_F13, G4 = G3 + 2 * IT_F2;
        for (int it = gw; it < G4; it += NGW) {
            if (it < G0) { const int job = it / IT_WIN, r = it % IT_WIN, kb = r / 199, nb = r % 199;
                if (nb < 103) tr_item(KIN(KA, I_WIN) + (size_t)job * D * IN_TOTAL, IN_TOTAL, kb * 64, 512 + nb * 32, (bf16*)(ws + WS_WIN) + (size_t)job * NZB * D, D, MapWin{}, scr, lane);
                else tr_item8(KIN(KA, I_WIN) + (size_t)job * D * IN_TOTAL, IN_TOTAL, kb * 64, 512 + nb * 32, ws + WS_WING8 + (size_t)job * NZG * D, D, MapPlain{-3808}, scr, lane); }
            else if (it < G1) { const int q = it - G0, job = q / IT_BR, r = q % IT_BR, kb = r / 32, nb = r % 32;
                const int l = job / 3, n = job % 3;
                tr_item(KIN(KA, I_WBR) + (size_t)job * 512 * D, D, kb * 64, nb * 32, (bf16*)(ws + WS_WBR) + (size_t)l * 3072 * 512, 512, MapPlain{n * 1024}, scr, lane); }
            else if (it < G2) { const int q = it - G1, job = q / IT_OUT, r = q % IT_OUT, kb = r / 32, nb = r % 32;
                tr_item(KIN(KA, I_WOUT) + (size_t)job * D * D, D, kb * 64, nb * 32, (bf16*)(ws + WS_WOUT) + (size_t)job * D * D, D, MapPlain{0}, scr, lane); }
            else if (it < G3) { const int q = it - G2, job = q / IT_F13, r = q % IT_F13, kb = r / 88, nb = r % 88;
                const int j = job >> 1, w3 = job & 1;
                tr_item(KIN(KA, w3 ? I_F3 : I_F1) + (size_t)j * D * DFF, DFF, kb * 64, nb * 32, (bf16*)(ws + WS_W13) + (size_t)j * NF1 * D, D, MapF13{w3 * 16}, scr, lane); }
            else { const int q = it - G3, job = q / IT_F2, r = q % IT_F2, kb = r / 32, nb = r % 32;
                tr_item(KIN(KA, I_F2) + (size_t)job * DFF * D, D, kb * 64, nb * 32, (bf16*)(ws + WS_W2) + (size_t)job * D * DFF, DFF, MapPlain{0}, scr, lane); }
        }
    }
    moe_convert(F, args, 0);
    for (int u = F.vcu; u < DEPTH * D; u += F.G) {
        const int l = u >> 10, k = u & 1023, gd = F.tid, g = gd >> 7, d = gd & 127;
        const float* wi = KIN(KA, I_WIN) + ((size_t)l * D + k) * IN_TOTAL + g * 128;
        const float* pw = KIN(KA, I_POOLW) + ((size_t)(l * 4 + g) * 128) * 128 + d;
        float s = 0.f;
#pragma unroll 8
        for (int c = 0; c < 128; ++c) s += wi[c] * pw[(size_t)c * 128];
        s *= KIN(KA, I_POOLS)[l * 512 + gd];
        ((bf16*)(ws + WS_WIN))[((size_t)l * NZB + gd) * D + k] = (bf16)f2bf(s);
    }
    for (size_t i = (size_t)blockIdx.x * 512 + F.tid; i < (size_t)DEPTH * NLORA * KLORA; i += (size_t)F.G * 512) {
        const int kk = (int)(i & 255), n = (int)((i >> 8) % NLORA), l = (int)(i / ((size_t)NLORA * KLORA));
        const int seg = n >> 9, c = n & 511; float v = 0.f;
        if (seg < 2) { if ((kk >> 5) == seg) v = KIN(KA, I_DW2)[(((size_t)l * 2 + seg) * 32 + (kk & 31)) * 512 + c]; }
        else if (seg < 4) { if ((kk >> 5) == seg) v = KIN(KA, I_A2)[(((size_t)l * 2 + (seg - 2)) * 32 + (kk & 31)) * 512 + c]; }
        else { if (kk >= 128 && kk < 224) v = KIN(KA, I_GG2)[((size_t)l * 96 + (kk - 128)) * 512 + c]; }
        ((bf16*)(ws + WS_WLORA))[i] = (bf16)f2bf(v);
    }
    {
        __syncthreads();
        LAS float* sc = (LAS float*)F.lds;
        LAS float* red = (LAS float*)(F.lds + 16384);
        for (int i = F.tid; i < 3 * D; i += 512) { const int s = i >> 10, k = i & 1023; const float c = s < 2 ? KIN(KA, I_C)[s * D + k] : KIN(KA, I_CCTX)[k]; sc[i] = c * sigmoidf_(c); }
        __syncthreads();
        const int kq = F.tid >> 6, nl = F.tid & 63;
        for (int u = F.vcu; u < DEPTH * 96; u += F.G) {
            const int l = u / 96, n = (u % 96) * 64 + nl;
            const float* wm = KIN(KA, I_WMOD) + (size_t)l * D * 6 * D + n;
            float s0 = 0.f, s1 = 0.f, s2 = 0.f;
#pragma unroll 32
            for (int k = kq * 128; k < kq * 128 + 128; ++k) { const float w = wm[(size_t)k * 6 * D]; s0 += sc[k] * w; s1 += sc[D + k] * w; s2 += sc[2 * D + k] * w; }
            red[(kq * 64 + nl) * 3 + 0] = s0; red[(kq * 64 + nl) * 3 + 1] = s1; red[(kq * 64 + nl) * 3 + 2] = s2;
            __syncthreads();
            if (F.tid < 192) { const int s = F.tid >> 6; float a = KIN(KA, I_BMOD)[l * 6 * D + n];
#pragma unroll
                for (int q = 0; q < 8; ++q) a += red[(q * 64 + nl) * 3 + s];
                ((float*)(ws + WS_MOD))[((size_t)l * 3 + s) * 6 * D + n] = a; }
            __syncthreads();
        }
    }
}

__device__ __forceinline__ void norm_phase(Frame& F, const Args& args, const float* xlat_in, const float* xctx_in, int ymode, const float* gate_mod  ,
                                           const float* gn, const float* sc_mod, const float* sh_mod, bool moe_route, const float* router, int moe_j, int rblk, int rnb, int rbase, int rcount  ,
                                           unsigned char* hb8 = nullptr  ,
                                           int rbase2 = 0, int rcount2 = 0, int ymode2 = 0, unsigned* wcnt = nullptr, unsigned wneed = 0  ) {
    frame_refresh(F); KArgs KA = kargs();
    unsigned char* ws = F.ws;
    const int gw = rblk * 8 + F.wave, NGW = rnb * 8, lane = F.lane;
    float* xs_lat = ((float*)(GAS float*)KA->out); float* xs_ctx = (float*)(ws + WS_XSC);
    bf16* HB = (bf16*)(ws + WS_HB); const bf16* Y = (const bf16*)(ws + WS_Y); const bf16* Y2 = (const bf16*)(ws + WS_Y2); const bf16* YP = (const bf16*)(ws + WS_ARENA + AR_YP);
    unsigned* RT = (unsigned*)(ws + WS_RT);
    LAS float* rl = (LAS float*)F.lds;
    LAS unsigned* lcnt = (LAS unsigned*)(F.lds + 32768);
    if (moe_route) {
        __syncthreads();
        for (int i = F.tid; i < D * 8; i += 512) rl[i] = router[i];
        if (F.tid < 8) lcnt[F.tid] = 0u;
        __syncthreads();
    }
    struct NormIn { f32x4 x[4]; v2u ya[4], yb[4]; float w0, w1; unsigned r0, r1; };
#define NORM_RT(mm, R) do { R.w0 = 0.f; R.w1 = 0.f; R.r0 = 0u; R.r1 = 0u; \
        if (ymode == 2) { const v4u rt = *(const v4u*)(RT + (size_t)(mm) * 8); const v4u rt2 = *(const v4u*)(RT + (size_t)(mm) * 8 + 4); R.w0 = __uint_as_float(rt.z); R.w1 = __uint_as_float(rt.w); R.r0 = rt2.x; R.r1 = rt2.y; } } while (0)
#define NORM_LOAD(mm, R) do { const bool lat_ = (mm) < MLAT; const float* xin_ = lat_ ? xlat_in + (size_t)(mm) * D : xctx_in + (size_t)((mm) - MLAT) * D; \
        _Pragma("unroll") for (int j = 0; j < 4; ++j) { const int col = 4 * lane + 256 * j; R.x[j] = *(const f32x4*)(xin_ + col); R.ya[j] = (v2u){0u, 0u}; R.yb[j] = (v2u){0u, 0u}; \
            if (ymode == 1 || ymode == 3) R.ya[j] = *(const v2u*)(Y + (size_t)(mm) * D + col); \
            if (ymode == 3) R.yb[j] = *(const v2u*)(Y2 + (size_t)((mm) - MLAT) * D + col);     \
            if (ymode == 2) { R.ya[j] = *(const v2u*)(YP + (size_t)R.r0 * D + col); R.yb[j] = *(const v2u*)(YP + (size_t)R.r1 * D + col); } } } while (0)
#define NORM_COMPUTE(mm, R) do { const int m = (mm); const bool lat = m < MLAT; const int srow = lat ? (m >> 13) : 2; \
        float* xo = lat ? xs_lat + (size_t)m * D : xs_ctx + (size_t)(m - MLAT) * D; \
        f32x4 v[4]; float ss = 0.f; \
        _Pragma("unroll") for (int j = 0; j < 4; ++j) { const int col = 4 * lane + 256 * j; v[j] = R.x[j]; \
            if (ymode != 0) { f32x4 yv; const v2u ya = R.ya[j], yb = R.yb[j]; \
                if (ymode == 1) yv = (f32x4){bflo(ya.x), bfhi(ya.x), bflo(ya.y), bfhi(ya.y)}; \
                else if (ymode == 3) yv = (f32x4){bflo(ya.x) + bflo(yb.x), bfhi(ya.x) + bfhi(yb.x), bflo(ya.y) + bflo(yb.y), bfhi(ya.y) + bfhi(yb.y)}; \
                else yv = (f32x4){R.w0 * bflo(ya.x) + R.w1 * bflo(yb.x), R.w0 * bfhi(ya.x) + R.w1 * bfhi(yb.x), R.w0 * bflo(ya.y) + R.w1 * bflo(yb.y), R.w0 * bfhi(ya.y) + R.w1 * bfhi(yb.y)}; \
                const f32x4 gt = *(const f32x4*)(gate_mod + (size_t)srow * 6 * D + col); v[j] = v[j] + gt * yv; } \
            *(f32x4*)(xo + col) = v[j]; ss += (v[j].x * v[j].x + v[j].y * v[j].y) + (v[j].z * v[j].z + v[j].w * v[j].w); } \
        const float rinv = 1.0f / sqrtf(wave_sum(ss) * (1.f / D) + 1e-6f); \
        float lg[8]; _Pragma("unroll") for (int e = 0; e < 8; ++e) lg[e] = 0.f; \
        _Pragma("unroll") for (int j = 0; j < 4; ++j) { const int col = 4 * lane + 256 * j; \
            const f32x4 g4 = *(const f32x4*)(gn + col), s4 = *(const f32x4*)(sc_mod + (size_t)srow * 6 * D + col), h4 = *(const f32x4*)(sh_mod + (size_t)srow * 6 * D + col); \
            const f32x4 h = v[j] * rinv * g4 * (s4 + 1.0f) + h4; \
            if (moe_route) { unsigned w8 = 0u; w8 = __builtin_amdgcn_cvt_pk_fp8_f32(sat8(4.f * h.x), sat8(4.f * h.y), w8, false); w8 = __builtin_amdgcn_cvt_pk_fp8_f32(sat8(4.f * h.z), sat8(4.f * h.w), w8, true); \
                *(unsigned*)((unsigned char*)HB + (size_t)m * D + col) = w8; }     \
            else { v2u o; o.x = pk2(h.x, h.y); o.y = pk2(h.z, h.w); *(v2u*)(HB + (size_t)m * D + col) = o; \
                if (hb8) { unsigned w8 = 0u; w8 = __builtin_amdgcn_cvt_pk_fp8_f32(sat8(4.f * h.x), sat8(4.f * h.y), w8, false); w8 = __builtin_amdgcn_cvt_pk_fp8_f32(sat8(4.f * h.z), sat8(4.f * h.w), w8, true); \
                    *(unsigned*)(hb8 + (size_t)m * D + col) = w8; } } \
            if (moe_route) { _Pragma("unroll") for (int q = 0; q < 4; ++q) { const f32x4 ra = *(const LAS f32x4*)(rl + (col + q) * 8), rb = *(const LAS f32x4*)(rl + (col + q) * 8 + 4); const float hv = h[q]; \
                lg[0] += hv * ra.x; lg[1] += hv * ra.y; lg[2] += hv * ra.z; lg[3] += hv * ra.w; lg[4] += hv * rb.x; lg[5] += hv * rb.y; lg[6] += hv * rb.z; lg[7] += hv * rb.w; } } } \
        if (moe_route) { _Pragma("unroll") for (int e = 0; e < 8; ++e) lg[e] = wave_sum(lg[e]); \
            int i0 = 0; float b0 = lg[0]; _Pragma("unroll") for (int e = 1; e < 8; ++e) if (lg[e] > b0) { b0 = lg[e]; i0 = e; } \
            int i1 = -1; float b1 = -3.0e38f; _Pragma("unroll") for (int e = 0; e < 8; ++e) if (e != i0 && lg[e] > b1) { b1 = lg[e]; i1 = e; } \
            const float p0 = 1.0f / (1.0f + __expf(b1 - b0)), p1 = 1.0f - p0; \
            if (lane == 0) { const unsigned q0 = __hip_atomic_fetch_add(&lcnt[i0], 1u, __ATOMIC_RELAXED, __HIP_MEMORY_SCOPE_WORKGROUP), q1 = __hip_atomic_fetch_add(&lcnt[i1], 1u, __ATOMIC_RELAXED, __HIP_MEMORY_SCOPE_WORKGROUP); \
                v4u a; a.x = (unsigned)i0; a.y = (unsigned)i1; a.z = __builtin_bit_cast(unsigned, p0); a.w = __builtin_bit_cast(unsigned, p1); v4u b; b.x = q0; b.y = q1; b.z = (unsigned)F.vcu; b.w = 0u;     \
                *(v4u*)(RT + (size_t)m * 8) = a; *(v4u*)(RT + (size_t)m * 8 + 4) = b; } } } while (0)
#pragma unroll 1
    for (int pass = 0; pass < (rcount2 > 0 ? 2 : 1); ++pass) {
    if (pass == 1) {
        rbase = rbase2; rcount = rcount2; ymode = ymode2;
        if (F.tid == 0) { unsigned sp = 0; while ((__hip_atomic_load(wcnt, RLX_AGENT) < wneed || __hip_atomic_load(wcnt + 64, RLX_AGENT) < wneed) && ++sp < (1u << 21)) __builtin_amdgcn_s_sleep(2);
            __builtin_amdgcn_fence(__ATOMIC_ACQUIRE, "agent"); asm volatile("s_waitcnt vmcnt(0)" ::: "memory"); }
        __syncthreads(); }
    for (int i0 = gw; i0 < rcount; i0 += 4 * NGW) {
        const int m0 = rbase + i0, m1 = m0 + NGW, m2 = m1 + NGW, m3 = m2 + NGW; const bool h1 = i0 + NGW < rcount, h2 = i0 + 2 * NGW < rcount, h3 = i0 + 3 * NGW < rcount;
        NormIn RA, RB, RC, RD;
        NORM_RT(m0, RA); if (h1) NORM_RT(m1, RB); if (h2) NORM_RT(m2, RC); if (h3) NORM_RT(m3, RD);
        NORM_LOAD(m0, RA); if (h1) NORM_LOAD(m1, RB); if (h2) NORM_LOAD(m2, RC); if (h3) NORM_LOAD(m3, RD);
        NORM_COMPUTE(m0, RA);
        if (h1) NORM_COMPUTE(m1, RB);
        if (h2) NORM_COMPUTE(m2, RC);
        if (h3) NORM_COMPUTE(m3, RD);
    }
    }
#undef NORM_RT
#undef NORM_LOAD
#undef NORM_COMPUTE
    if (moe_route) {
        __syncthreads();
        if (F.tid < 8) { unsigned* ctl = (unsigned*)(ws + WS_CTL);
            const unsigned base = __hip_atomic_fetch_add(ctl + CW_MOE + moe_j * 64 + F.tid, lcnt[F.tid], RLX_AGENT);
            ctl[CW_BB + (moe_j * 256 + F.vcu) * 8 + F.tid] = base; }
    }
}

__device__ __forceinline__ void moe_prefix(const unsigned* cnt, int (&pe)[9]) {
    pe[0] = 0;
#pragma unroll
    for (int e = 0; e < 8; ++e) pe[e + 1] = pe[e] + (int)((cnt[e] + 255u) >> 8);
}
__device__ __forceinline__ void moe_perm_phase(Frame& F, int moe_j, int mrows) {
    frame_refresh(F);
    unsigned char* ws = F.ws;
    const int gw = F.vcu * 8 + F.wave, NGW = F.G * 8, lane = F.lane;
    const unsigned* ctl = (const unsigned*)(ws + WS_CTL);
    unsigned cnt[8];
#pragma unroll
    for (int e = 0; e < 8; ++e) cnt[e] = ctl[CW_MOE + moe_j * 64 + e];
    int pe[9]; moe_prefix(cnt, pe);
    unsigned* RT = (unsigned*)(ws + WS_RT); const unsigned char* HB = ws + WS_HB; unsigned char* HP = ws + WS_ARENA + AR_HP;
    for (int m = gw; m < mrows; m += NGW) {
        const v4u a = *(const v4u*)(RT + (size_t)m * 8); const v4u b = *(const v4u*)(RT + (size_t)m * 8 + 4);
        const int blk = (int)b.z;
        const int e0 = (int)a.x, e1 = (int)a.y;
        int p0 = 0, p1 = 0;
#pragma unroll
        for (int e = 0; e < 8; ++e) { if (e == e0) p0 = pe[e] * 256; if (e == e1) p1 = pe[e] * 256; }
        p0 += (int)ctl[CW_BB + (moe_j * 256 + blk) * 8 + e0] + (int)b.x;
        p1 += (int)ctl[CW_BB + (moe_j * 256 + blk) * 8 + e1] + (int)b.y;
        const v4u* src = (const v4u*)(HB + (size_t)m * D);
        v4u* d0 = (v4u*)(HP + (size_t)p0 * D); v4u* d1 = (v4u*)(HP + (size_t)p1 * D);
        const v4u x0 = src[lane];
        d0[lane] = x0; d1[lane] = x0;
        if (lane == 0) { v4u nb; nb.x = (unsigned)p0; nb.y = (unsigned)p1; nb.z = 0u; nb.w = 0u; *(v4u*)(RT + (size_t)m * 8 + 4) = nb; }
    }
}

__device__ __forceinline__ f32x4 mfma16(const v4u a, const v4u b, const f32x4 c) {
    return __builtin_amdgcn_mfma_f32_16x16x32_bf16(__builtin_bit_cast(bf16x8, a), __builtin_bit_cast(bf16x8, b), c, 0, 0, 0);
}
constexpr int PREP_LA_OFF = 67584, PREP_LA_PITCH = 528;
__device__ __forceinline__ void seq_of_row(int m, int& seq0, int& t, int& Tn) {
    if (m < MLAT) { seq0 = m & ~(T - 1); t = m & (T - 1); Tn = T; } else { const int mc = m - MLAT; seq0 = MLAT + (mc & ~(CL - 1)); t = mc & (CL - 1); Tn = CL; }
}
struct Sh8 { v4u c, p, n; bool hp, hn; };
__device__ __forceinline__ void sh8_load(Sh8& s, const bf16* Z, int m, int t, int Tn, int col) {
    s.hp = t > 0; s.hn = t < Tn - 1;
    s.c = *(const v4u*)(Z + (size_t)m * NZ + col); s.p = *(const v4u*)(Z + (size_t)(s.hp ? m - 1 : m) * NZ + col); s.n = *(const v4u*)(Z + (size_t)(s.hn ? m + 1 : m) * NZ + col);
}
__device__ __forceinline__ void sh8_eval(const Sh8& s, const float* mup, const float* mun, float (&o)[8]) {
    float c[8], p[8], n[8]; unpack8(s.c, c); unpack8(s.p, p); unpack8(s.n, n);
    const f32x4 mp0 = *(const f32x4*)mup, mp1 = *(const f32x4*)(mup + 4), mn0 = *(const f32x4*)mun, mn1 = *(const f32x4*)(mun + 4);
#pragma unroll
    for (int j = 0; j < 8; ++j) { const float a = j < 4 ? mp0[j & 3] : mp1[j & 3], b = j < 4 ? mn0[j & 3] : mn1[j & 3]; const float pj = s.hp ? p[j] : 0.f, nj = s.hn ? n[j] : 0.f; o[j] = c[j] + a * (pj - c[j]) + b * (nj - c[j]); }
}
__device__ __forceinline__ void prep_phase(Frame& F, const Args& args, int l) {
    frame_refresh(F); KArgs KA = kargs();
    unsigned char* ws = F.ws;
    const int gw = F.vcu * 8 + F.wave, NGW = F.G * 8, lane = F.lane;
    const bf16* Z = (const bf16*)(ws + WS_ARENA + AR_Z);
    bf16* BR = (bf16*)(ws + WS_ARENA + AR_BR); float* KINV = (float*)(ws + WS_KINV);
    const int row0 = F.vcu * (M / 256);
    static_assert(M % 256 == 0 && M / 256 == 66, "rows per workgroup");
    bf16* QN = (bf16*)(ws + WS_Y); bf16* KN = QN + (size_t)M * 512;
    const float* mu0 = KIN(KA, I_SHMU) + (size_t)l * 2 * 1760; const float* mu1 = mu0 + 1760;
    const float* kkw = KIN(KA, I_KKK) + l * 512; const float* qng = KIN(KA, I_QNG) + l * 64; const float* kng = KIN(KA, I_KNG) + l * 64;
    const int mbeg = (int)(((long)gw * M) / NGW), mend = (int)(((long)(gw + 1) * M) / NGW);
    float S[8];
#pragma unroll
    for (int j = 0; j < 8; ++j) S[j] = 0.f;
    for (int m = mbeg; m < mend; ++m) {
        int seq0, t, Tn; seq_of_row(m, seq0, t, Tn);
        const int g = lane >> 4, half = 1 << g; const int lo = t - half < 0 ? 0 : t - half, hi = t + half > Tn ? Tn : t + half;
        const bool ent = t + half < Tn, lev = t - half >= 0;
        const v4u zc = *(const v4u*)(Z + (size_t)(seq0 + t) * NZ + ZP + lane * 8);
        const v4u ze = *(const v4u*)(Z + (size_t)(seq0 + (ent ? t + half : t)) * NZ + ZP + lane * 8), zl = *(const v4u*)(Z + (size_t)(seq0 + (lev ? t - half : t)) * NZ + ZP + lane * 8);
        Sh8 sk, sl; sh8_load(sk, Z, m, t, Tn, ZK + lane * 8); sh8_load(sl, Z, m, t, Tn, ZWLO + (lane < 28 ? lane : 0) * 8);
        const v4u zq = *(const v4u*)(Z + (size_t)m * NZ + ZQ + lane * 8), zk = *(const v4u*)(Z + (size_t)m * NZ + ZNK + lane * 8);
        if (m == mbeg || t == 0) {
            v4u ptap[16];
#pragma unroll
            for (int o = -8; o < 8; ++o) { const int s_ = t + o; const bool in = s_ >= lo && s_ < hi; ptap[o + 8] = *(const v4u*)(Z + (size_t)(seq0 + (in ? s_ : t)) * NZ + ZP + lane * 8); }
#pragma unroll
            for (int j = 0; j < 8; ++j) S[j] = 0.f;
#pragma unroll
            for (int o = -8; o < 8; ++o) { const int s_ = t + o; const float wgt = (s_ >= lo && s_ < hi) ? 1.f : 0.f; float q[8]; unpack8(ptap[o + 8], q);
#pragma unroll
                for (int j = 0; j < 8; ++j) S[j] += wgt * q[j]; }
        }
        asm volatile("" ::: "memory"); __builtin_amdgcn_sched_barrier(0);
        { float q[8], qe[8], ql[8], acc[8]; unpack8(zc, q); unpack8(ze, qe); unpack8(zl, ql);
          const float inv = 1.0f / (float)(hi - lo), we = ent ? 1.f : 0.f, wl = lev ? 1.f : 0.f;
#pragma unroll
          for (int j = 0; j < 8; ++j) { acc[j] = S[j] * inv - q[j]; S[j] += we * qe[j] - wl * ql[j]; }
          *(v4u*)(BR + (size_t)m * 1536 + lane * 8) = pack8(acc); }
        { float ks[8]; sh8_eval(sk, mu0 + 512 + lane * 8, mu1 + 512 + lane * 8, ks);
          float ss = 0.f;
#pragma unroll
          for (int j = 0; j < 8; ++j) { const float q = ks[j] * kkw[lane * 8 + j]; ss += q * q; }
          ss = red8(ss);
          if ((lane & 7) == 0) KINV[(size_t)m * 8 + (lane >> 3)] = 1.0f / fmaxf(sqrtf(ss), 1e-12f); }
        if (lane < 32) { float o[8];
          if (lane < 28) { sh8_eval(sl, mu0 + 1536 + lane * 8, mu1 + 1536 + lane * 8, o);
#pragma unroll
              for (int j = 0; j < 8; ++j) { if (lane < 8) o[j] = tanhf(o[j]); else if (lane >= 16) o[j] = sigmoidf_(o[j]); } }
          else {
#pragma unroll
              for (int j = 0; j < 8; ++j) o[j] = 0.f; }
          *(LAS v4u*)(F.lds + PREP_LA_OFF + (m - row0) * PREP_LA_PITCH + lane * 16) = pack8(o); }
        { float q[8], k[8]; unpack8(zq, q); unpack8(zk, k); float sq = 0.f, sk2 = 0.f;
#pragma unroll
          for (int j = 0; j < 8; ++j) { sq += q[j] * q[j]; sk2 += k[j] * k[j]; }
          sq = red8(sq); sk2 = red8(sk2);
          const float rq = (0.125f * 1.4426950408889634f) / sqrtf(sq * (1.f / 64.f) + 1e-6f), rk = 1.0f / sqrtf(sk2 * (1.f / 64.f) + 1e-6f);
#pragma unroll
          for (int j = 0; j < 8; ++j) { q[j] = q[j] * rq * qng[(lane & 7) * 8 + j]; k[j] = k[j] * rk * kng[(lane & 7) * 8 + j]; }
          *(v4u*)(QN + (size_t)m * 512 + lane * 8) = pack8(q); *(v4u*)(KN + (size_t)m * 512 + lane * 8) = pack8(k); }
    }
    {
        { unsigned z_ = 0u; asm volatile("" : "+v"(z_));
          if (F.tid < 14 * 32) *(LAS v4u*)(F.lds + PREP_LA_OFF + (66 + F.tid / 32) * PREP_LA_PITCH + (F.tid & 31) * 16) = (v4u){z_, z_, z_, z_}; }
        __syncthreads();
        const bf16* WL = (const bf16*)(ws + WS_WLORA) + (size_t)l * NLORA * KLORA;
        const float* w0b = KIN(KA, I_DW0) + l * 1024; const float* a0b = KIN(KA, I_A0) + l * 1024;
        bf16* LO = (bf16*)(ws + WS_ARENA + AR_LO);
        const int fr = lane & 15, fq = lane >> 4;
        for (int g = F.wave; g < NLORA / 32; g += 8) {
            const int seg = g >> 4, nbase = 32 * g, kbase = seg < 4 ? 32 * seg : 128, nks = seg < 4 ? 1 : 3;
            v4u bfr[2][3];
#pragma unroll
            for (int t = 0; t < 2; ++t) { const bf16* wp = WL + (size_t)(nbase + pg8::perm32(16 * t + fr)) * KLORA + kbase + 8 * fq;
#pragma unroll
                for (int ks = 0; ks < 3; ++ks) bfr[t][ks] = ks < nks ? *(const v4u*)(wp + 32 * ks) : (v4u){0u, 0u, 0u, 0u}; }
            const int cc = (nbase & 511) + 8 * fq;
            float bias[8];
#pragma unroll
            for (int j = 0; j < 8; ++j) bias[j] = seg < 2 ? w0b[seg * 512 + cc + j] : (seg < 4 ? a0b[(seg - 2) * 512 + cc + j] : 0.f);
#pragma unroll 1
            for (int mt = 0; mt < 5; ++mt) {
                f32x4 a0_ = (f32x4){0.f, 0.f, 0.f, 0.f}, a1_ = (f32x4){0.f, 0.f, 0.f, 0.f};
#pragma unroll
                for (int ks = 0; ks < 3; ++ks) if (ks < nks) { const v4u af = *(const LAS v4u*)(F.lds + PREP_LA_OFF + (16 * mt + fr) * PREP_LA_PITCH + (kbase + 32 * ks + 8 * fq) * 2);
                    a0_ = mfma16(bfr[0][ks], af, a0_); a1_ = mfma16(bfr[1][ks], af, a1_); }
                float v[8] = {a0_[0], a0_[1], a0_[2], a0_[3], a1_[0], a1_[1], a1_[2], a1_[3]};
                if (seg < 4) { const float sc = seg < 2 ? -0.60653066f : 1.0f;
#pragma unroll
                    for (int j = 0; j < 8; ++j) v[j] = sc * sigmoidf_(v[j] + bias[j]); }
                const int r = 16 * mt + fr;
                if (r < M / 256) *(v4u*)(LO + (size_t)(row0 + r) * NLORA + nbase + 8 * fq) = pack8(v);
            }
        }
    }
    {
        bf16* VT = (bf16*)(ws + WS_ARENA + AR_VT); bf16* VTC = VT + (size_t)NB * 8 * 64 * T;
        LAS unsigned char* tile = F.lds;
        for (int u = F.vcu; u < M / 64; u += F.G) {
            const int m0 = u * 64;
            __syncthreads();
#pragma unroll
            for (int i = 0; i < 8; ++i) { const int id = F.tid + 512 * i, row = id >> 6, ch = id & 63;
                *(LAS v4u*)(tile + row * 1040 + ch * 16) = *(const v4u*)(Z + (size_t)(m0 + row) * NZ + ZNV + ch * 8); }
            __syncthreads();
            const int c = F.tid, h = c >> 6, dim = c & 63;
            bf16* dst; if (m0 < MLAT) { const int b = m0 >> 13, t0 = m0 & (T - 1); dst = VT + ((size_t)(b * 8 + h) * 64 + dim) * T + t0; }
            else { const int mc = m0 - MLAT, b = mc >> 8, t0 = mc & (CL - 1); dst = VTC + ((size_t)(b * 8 + h) * 64 + dim) * CL + t0; }
#pragma unroll
            for (int tg = 0; tg < 8; ++tg) { unsigned short e[8];
#pragma unroll
                for (int j = 0; j < 8; ++j) e[j] = *(const LAS unsigned short*)(tile + (tg * 8 + j) * 1040 + c * 2);
                v4u o; o.x = e[0] | ((unsigned)e[1] << 16); o.y = e[2] | ((unsigned)e[3] << 16); o.z = e[4] | ((unsigned)e[5] << 16); o.w = e[6] | ((unsigned)e[7] << 16);
                *(v4u*)(dst + tg * 8) = o; }
        }
        __syncthreads();
    }
}

#define WAVE_LDS_SYNC() do { asm volatile("s_waitcnt lgkmcnt(0)" ::: "memory"); __builtin_amdgcn_wave_barrier(); asm volatile("" ::: "memory"); } while (0)
constexpr int SP_MID0 = 264, SP_NMID = 16;
__device__ __forceinline__ void scanpre_phase(Frame& F, const Args& args, int l, int mid) {
    frame_refresh(F); KArgs KA = kargs();
    unsigned char* ws = F.ws;
    const int gw = F.vcu * 8 + F.wave, NGW = F.G * 8, lane = F.lane, fr = lane & 15, fq = lane >> 4;
    const bf16* Z = (const bf16*)(ws + WS_ARENA + AR_Z); const bf16* LO = (const bf16*)(ws + WS_ARENA + AR_LO); const float* KINV = (const float*)(ws + WS_KINV);
    unsigned char* FR = ws + WS_FRAG; v2u* VFR = (v2u*)(ws + WS_HB);
    LAS unsigned char* wl = F.lds + F.wave * 16384;
    LAS unsigned char* XK = wl; LAS unsigned char* XR = wl + 2304; LAS unsigned char* XH = wl + 4608; LAS unsigned char* XA = wl + 6912;
    LAS unsigned char* VTt = wl + 9216; LAS unsigned char* KWT = wl + 11264; LAS unsigned char* AWT = wl + 13312;
    LAS float* At = (LAS float*)(wl + 15360);
    const float* mu0 = KIN(KA, I_SHMU) + (size_t)l * 2 * 1760; const float* mu1 = mu0 + 1760;
#define SP_DIR(DIRV, SH1, SH2, SH4, SH8, SHT, LOPTR, RECID) do { int ln__ = lane; asm volatile("" : "+v"(ln__)); const int tf = ln__ & 15, cq = ln__ >> 4, ch0 = h * 64 + cq * 16; \
        const int taud = (DIRV) ? 15 - tf : tf; \
        const v4u ldh_[2] = {*(const v4u*)((LOPTR) + ch0), *(const v4u*)((LOPTR) + ch0 + 8)}, avh_[2] = {*(const v4u*)((LOPTR) + 1024 + ch0), *(const v4u*)((LOPTR) + 1024 + ch0 + 8)};     \
        _Pragma("unroll") for (int hh = 0; hh < 2; ++hh) { unsigned xk[4], xr[4], xh[4], xa[4]; float ldv[8], avv[8]; unpack8(ldh_[hh], ldv); unpack8(avh_[hh], avv); \
            int zo = 0; asm volatile("" : "+v"(zo)); \
            const f32x4 ka0 = *(const f32x4*)(KIN(KA, I_KKA) + l * 512 + ch0 + hh * 8 + zo), ka1 = *(const f32x4*)(KIN(KA, I_KKA) + l * 512 + ch0 + hh * 8 + 4 + zo); \
            _Pragma("unroll") for (int j = 0; j < 8; ++j) { const int c = hh * 8 + j; \
                float Lc = ldv[j];     \
                Lc += __builtin_bit_cast(float, __builtin_amdgcn_update_dpp(0, __builtin_bit_cast(int, Lc), SH1, 0xF, 0xF, true)); \
                Lc += __builtin_bit_cast(float, __builtin_amdgcn_update_dpp(0, __builtin_bit_cast(int, Lc), SH2, 0xF, 0xF, true)); \
                Lc += __builtin_bit_cast(float, __builtin_amdgcn_update_dpp(0, __builtin_bit_cast(int, Lc), SH4, 0xF, 0xF, true)); \
                Lc += __builtin_bit_cast(float, __builtin_amdgcn_update_dpp(0, __builtin_bit_cast(int, Lc), SH8, 0xF, 0xF, true)); \
                const float L15 = __builtin_bit_cast(float, __builtin_amdgcn_update_dpp(0, __builtin_bit_cast(int, Lc), SHT, 0xF, 0xF, true)); \
                const float kaw = j < 4 ? ka0[j & 3] : ka1[j & 3]; \
                const float rs_c = (c & 1) ? bfhi(rsp[c >> 1]) : bflo(rsp[c >> 1]), ks_c = (c & 1) ? bfhi(ksp[c >> 1]) : bflo(ksp[c >> 1]), vs_c = (c & 1) ? bfhi(vsp[c >> 1]) : bflo(vsp[c >> 1]), kk_c = (c & 1) ? bfhi(kkp[c >> 1]) : bflo(kkp[c >> 1]); \
                const float kd = ks_c * (1.0f + (avv[j] - 1.0f) * kaw), kka = avv[j] * kk_c; \
                const float eW = __expf(Lc), ePrev = __expf(Lc - ldv[j]), eInv = __expf(-Lc), eEnd = __expf(L15 - Lc); \
                const unsigned bk = f2bf(kk_c * ePrev), br = f2bf(rs_c * eW), bh = f2bf(kd * eInv), ba = f2bf(kka * eInv); \
                if (j & 1) { xk[j >> 1] |= bk << 16; xr[j >> 1] |= br << 16; xh[j >> 1] |= bh << 16; xa[j >> 1] |= ba << 16; } else { xk[j >> 1] = bk; xr[j >> 1] = br; xh[j >> 1] = bh; xa[j >> 1] = ba; } \
                *(LAS unsigned short*)(VTt + (cq * 16 + c) * 32 + taud * 2) = (unsigned short)f2bf(vs_c); \
                *(LAS unsigned short*)(KWT + (cq * 16 + c) * 32 + taud * 2) = (unsigned short)f2bf(kd * eEnd); \
                *(LAS unsigned short*)(AWT + (cq * 16 + c) * 32 + taud * 2) = (unsigned short)f2bf(-kka * eEnd); \
                if (taud == 15) *(float*)(FR + (size_t)(RECID) * REC_BYTES + RO_WC + (cq * 16 + c) * 4) = __expf(Lc); } \
            *(LAS v4u*)(XK + taud * 144 + cq * 32 + hh * 16) = (v4u){xk[0], xk[1], xk[2], xk[3]}; *(LAS v4u*)(XR + taud * 144 + cq * 32 + hh * 16) = (v4u){xr[0], xr[1], xr[2], xr[3]}; \
            *(LAS v4u*)(XH + taud * 144 + cq * 32 + hh * 16) = (v4u){xh[0], xh[1], xh[2], xh[3]}; *(LAS v4u*)(XA + taud * 144 + cq * 32 + hh * 16) = (v4u){xa[0], xa[1], xa[2], xa[3]}; \
            __builtin_amdgcn_sched_barrier(0); } } while (0)
#define SP_STAGE2(RECID) do { \
        WAVE_LDS_SYNC(); \
        int ln__ = lane; asm volatile("" : "+v"(ln__)); const int lane_ = ln__, fr = ln__ & 15, fq = ln__ >> 4;     \
        v4u kf[2], rf[2], hf[2], af[2]; \
        _Pragma("unroll") for (int s = 0; s < 2; ++s) { kf[s] = *(const LAS v4u*)(XK + fr * 144 + 64 * s + 16 * fq); rf[s] = *(const LAS v4u*)(XR + fr * 144 + 64 * s + 16 * fq); \
            hf[s] = *(const LAS v4u*)(XH + fr * 144 + 64 * s + 16 * fq); af[s] = *(const LAS v4u*)(XA + fr * 144 + 64 * s + 16 * fq); } \
        const f32x4 z4 = (f32x4){0.f, 0.f, 0.f, 0.f}; \
        f32x4 Akk = mfma16(hf[0], kf[0], z4); Akk = mfma16(hf[1], kf[1], Akk); \
        f32x4 Aka = mfma16(af[0], kf[0], z4); Aka = mfma16(af[1], kf[1], Aka); \
        f32x4 Ark = mfma16(hf[0], rf[0], z4); Ark = mfma16(hf[1], rf[1], Ark); \
        f32x4 Ara = mfma16(af[0], rf[0], z4); Ara = mfma16(af[1], rf[1], Ara); \
        _Pragma("unroll") for (int j = 0; j < 4; ++j) { const int tp = 4 * fq + j; const bool lt = tp < fr, le = tp <= fr; \
            Akk[j] = lt ? Akk[j] : 0.f; Aka[j] = lt ? Aka[j] : 0.f; Ark[j] = le ? Ark[j] : 0.f; Ara[j] = le ? Ara[j] : 0.f; \
            At[(4 * fq + j) * 16 + fr] = Aka[j]; } \
        WAVE_LDS_SYNC(); \
        float Tr[16]; \
        _Pragma("unroll") for (int s = 0; s < 16; ++s) Tr[s] = (s == fr) ? 1.f : 0.f; \
        _Pragma("unroll") for (int c = 14; c >= 0; --c) { float arow[16]; \
            _Pragma("unroll") for (int g = 0; g < 4; ++g) { const f32x4 a4 = *(const LAS f32x4*)(At + c * 16 + 4 * g); arow[4 * g] = a4.x; arow[4 * g + 1] = a4.y; arow[4 * g + 2] = a4.z; arow[4 * g + 3] = a4.w; } \
            float acc = 0.f; \
            _Pragma("unroll") for (int s = c + 1; s < 16; ++s) acc += Tr[s] * arow[s]; \
            Tr[c] = (c < fr) ? -acc : Tr[c]; \
            if ((c & 1) == 0) __builtin_amdgcn_sched_barrier(0); } \
        float T4[4]; \
        _Pragma("unroll") for (int j = 0; j < 4; ++j) T4[j] = fq == 0 ? Tr[j] : (fq == 1 ? Tr[4 + j] : (fq == 2 ? Tr[8 + j] : Tr[12 + j])); \
        unsigned char* rec = FR + (size_t)(RECID) * REC_BYTES; \
        _Pragma("unroll") for (int s = 0; s < 2; ++s) { \
            const v2u klo = *(const LAS v2u*)(XK + fr * 144 + (32 * s + 4 * fq) * 2), khi = *(const LAS v2u*)(XK + fr * 144 + (32 * s + 16 + 4 * fq) * 2); \
            const v2u rlo = *(const LAS v2u*)(XR + fr * 144 + (32 * s + 4 * fq) * 2), rhi = *(const LAS v2u*)(XR + fr * 144 + (32 * s + 16 + 4 * fq) * 2); \
            *(v4u*)(rec + RO_KT + s * 1024 + lane_ * 16) = (v4u){klo.x, klo.y, khi.x, khi.y}; \
            *(v4u*)(rec + RO_RT + s * 1024 + lane_ * 16) = (v4u){rlo.x, rlo.y, rhi.x, rhi.y}; } \
        _Pragma("unroll") for (int kt = 0; kt < 4; ++kt) { const v2u kwv = *(const LAS v2u*)(KWT + (16 * kt + fr) * 32 + 8 * fq), awv = *(const LAS v2u*)(AWT + (16 * kt + fr) * 32 + 8 * fq); \
            *(v4u*)(rec + RO_KA + kt * 1024 + lane_ * 16) = (v4u){kwv.x, kwv.y, awv.x, awv.y}; } \
        *(v4u*)(rec + RO_OA + lane_ * 16) = (v4u){pk2(Ark[0], Ark[1]), pk2(Ark[2], Ark[3]), pk2(-Ara[0], -Ara[1]), pk2(-Ara[2], -Ara[3])}; \
        *(v2u*)(rec + RO_AK + lane_ * 8) = (v2u){pk2(Akk[0], Akk[1]), pk2(Akk[2], Akk[3])}; \
        *(v2u*)(rec + RO_TT + lane_ * 8) = (v2u){pk2(T4[0], T4[1]), pk2(T4[2], T4[3])}; \
        _Pragma("unroll") for (int w = 0; w < 4; ++w) VFR[((size_t)(RECID) * 4 + w) * 64 + lane_] = *(const LAS v2u*)(VTt + (16 * w + fr) * 32 + 8 * fq); \
        WAVE_LDS_SYNC(); } while (0)
    int t0_ = gw, tstep = NGW, tend = 16 * (NCHUNK - SP_NMID);
    if (mid) { const int nw = ((int)blockIdx.x - 32) * 8 + F.wave; tstep = 1 << 20; tend = 16 * SP_NMID; t0_ = (nw % 7 == 0) ? nw / 7 : tend; }
    for (int tk = t0_; tk < tend; tk += tstep) {
        int bh, blk;
        if (mid) { bh = tk >> 4; blk = SP_MID0 + (tk & 15); } else { bh = tk >> 9; const int j_ = tk & 511; blk = j_ < SP_MID0 ? j_ : j_ + SP_NMID; }
        static_assert(NCHUNK - SP_NMID == 512, "task decode");
        const int h = bh & 7, b = bh >> 3;
        int m0, t0, Tn;
        if (blk < CL / 16) { t0 = 16 * blk; Tn = CL; m0 = MLAT + b * CL + t0; } else { t0 = 16 * (blk - CL / 16); Tn = T; m0 = b * T + t0; }
        const int recF = ((b << 4) | (h << 1) | 0) * NCHUNK + blk;
        const int recB = ((b << 4) | (h << 1) | 1) * NCHUNK + (blk < CL / 16 ? CL / 16 - 1 - blk : NCHUNK - 1 - (blk - CL / 16));
        int lnt_ = lane; asm volatile("" : "+v"(lnt_)); const int tf_ = lnt_ & 15, cq_ = lnt_ >> 4;
        const int fr = tf_, fq = cq_;
        const int tf = tf_, cq = cq_, ch0 = h * 64 + cq * 16;
        const int tt = t0 + tf; const int m = m0 + tf;
        const bool okP = tt > 0, okN = tt < Tn - 1;
        const bf16* zc = Z + (size_t)m * NZ + ch0; const bf16* zp = Z + (size_t)(okP ? m - 1 : m) * NZ + ch0; const bf16* zn = Z + (size_t)(okN ? m + 1 : m) * NZ + ch0;
        const float kinv = KINV[(size_t)m * 8 + h];
        unsigned rsp[8], ksp[8], vsp[8], kkp[8];
#pragma unroll
        for (int hh = 0; hh < 2; ++hh) {
            int zo = 0; asm volatile("" : "+v"(zo));
            v4u raw[3][3];
#pragma unroll
            for (int tn = 0; tn < 3; ++tn) { raw[tn][0] = *(const v4u*)(zc + ZR + tn * 512 + hh * 8 + zo); raw[tn][1] = *(const v4u*)(zp + ZR + tn * 512 + hh * 8 + zo); raw[tn][2] = *(const v4u*)(zn + ZR + tn * 512 + hh * 8 + zo); }
            const f32x4 kw0 = *(const f32x4*)(KIN(KA, I_KKK) + l * 512 + ch0 + hh * 8 + zo), kw1 = *(const f32x4*)(KIN(KA, I_KKK) + l * 512 + ch0 + hh * 8 + 4 + zo);
            float xs_[3][8];
#pragma unroll
            for (int tn = 0; tn < 3; ++tn) { float c[8], p[8], n[8]; unpack8(raw[tn][0], c); unpack8(raw[tn][1], p); unpack8(raw[tn][2], n);
                const f32x4 mp0 = *(const f32x4*)(mu0 + tn * 512 + ch0 + hh * 8 + zo), mp1 = *(const f32x4*)(mu0 + tn * 512 + ch0 + hh * 8 + 4 + zo), mn0 = *(const f32x4*)(mu1 + tn * 512 + ch0 + hh * 8 + zo), mn1 = *(const f32x4*)(mu1 + tn * 512 + ch0 + hh * 8 + 4 + zo);
#pragma unroll
                for (int j = 0; j < 8; ++j) { const float wp = j < 4 ? mp0[j & 3] : mp1[j & 3], wn = j < 4 ? mn0[j & 3] : mn1[j & 3]; const float pv = okP ? p[j] : 0.f, nv = okN ? n[j] : 0.f;
                    const float x = c[j] + wp * (pv - c[j]) + wn * (nv - c[j]);
                    xs_[tn][j] = x; } }
#pragma unroll
            for (int j = 0; j < 8; j += 2) { const int q = hh * 4 + (j >> 1);
                rsp[q] = pk2(xs_[0][j], xs_[0][j + 1]); ksp[q] = pk2(xs_[1][j], xs_[1][j + 1]); vsp[q] = pk2(xs_[2][j], xs_[2][j + 1]);
                kkp[q] = pk2(xs_[1][j] * (j < 4 ? kw0[j & 3] : kw1[j & 3]) * kinv, xs_[1][j + 1] * (j + 1 < 4 ? kw0[(j + 1) & 3] : kw1[(j + 1) & 3]) * kinv); }
            __builtin_amdgcn_sched_barrier(0);
        }
        SP_DIR(0, 0x111, 0x112, 0x114, 0x118, 0x15F, LO + (size_t)m * NLORA, recF);
        SP_STAGE2(recF);
        SP_DIR(1, 0x101, 0x102, 0x104, 0x108, 0x150, LO + (size_t)m * NLORA + 512, recB);
        SP_STAGE2(recB);
    }
#undef SP_DIR
#undef SP_STAGE2
}
struct ScanRec { v4u kt[2], rt[2], ka[4], oa; v2u ak, tt, v; f32x4 wc[4]; };
constexpr int SC_OROW = 136, SC_OTILE = 16 * SC_OROW;
__device__ __forceinline__ void scan_step(const ScanRec& R, f32x4 (&Hk)[4], f32x4& oprev, LAS unsigned short* otp  , bool wr) {
    const f32x4 z4 = (f32x4){0.f, 0.f, 0.f, 0.f};
    if (wr) {
#pragma unroll
        for (int j = 0; j < 4; ++j) otp[j * (SC_OROW / 2)] = (unsigned short)f2bf(oprev[j]);
    }
    const v4u Hb0 = (v4u){pk2(Hk[0][0], Hk[0][1]), pk2(Hk[0][2], Hk[0][3]), pk2(Hk[1][0], Hk[1][1]), pk2(Hk[1][2], Hk[1][3])};
    const v4u Hb1 = (v4u){pk2(Hk[2][0], Hk[2][1]), pk2(Hk[2][2], Hk[2][3]), pk2(Hk[3][0], Hk[3][1]), pk2(Hk[3][2], Hk[3][3])};
    f32x4 U = mfma16(R.kt[0], Hb0, z4); U = mfma16(R.kt[1], Hb1, U);
    U = mfma16((v4u){R.ak.x, R.ak.y, 0u, 0u}, (v4u){R.v.x, R.v.y, 0u, 0u}, U);
    const f32x4 sa = mfma16((v4u){R.tt.x, R.tt.y, 0u, 0u}, (v4u){pk2(U[0], U[1]), pk2(U[2], U[3]), 0u, 0u}, z4);
    const v4u VS = (v4u){R.v.x, R.v.y, pk2(sa[0], sa[1]), pk2(sa[2], sa[3])};
    f32x4 o = mfma16(R.rt[0], Hb0, z4); o = mfma16(R.rt[1], Hb1, o); o = mfma16(R.oa, VS, o);
#pragma unroll
    for (int kt = 0; kt < 4; ++kt) Hk[kt] = mfma16(R.ka[kt], VS, Hk[kt] * R.wc[kt]);
    oprev = o;
}
constexpr int SC_SLOT = 12544, SC_R = 10, SC_D = 8, SC_V0 = 10496;
static_assert(SC_R * SC_SLOT + 2 * SC_OTILE <= LDSCTL_OFF, "scan ring + output tiles");
__device__ __forceinline__ void scan_load_lds(ScanRec& R, const LAS unsigned char* slot, int w, int lane, int fq) {
    R.kt[0] = *(const LAS v4u*)(slot + RO_KT + lane * 16); R.kt[1] = *(const LAS v4u*)(slot + RO_KT + 1024 + lane * 16);
    R.rt[0] = *(const LAS v4u*)(slot + RO_RT + lane * 16); R.rt[1] = *(const LAS v4u*)(slot + RO_RT + 1024 + lane * 16);
#pragma unroll
    for (int kt = 0; kt < 4; ++kt) { R.ka[kt] = *(const LAS v4u*)(slot + RO_KA + kt * 1024 + lane * 16); R.wc[kt] = *(const LAS f32x4*)(slot + RO_WC + (16 * kt + 4 * fq) * 4); }
    R.oa = *(const LAS v4u*)(slot + RO_OA + lane * 16); R.ak = *(const LAS v2u*)(slot + RO_AK + lane * 8); R.tt = *(const LAS v2u*)(slot + RO_TT + lane * 8);
    R.v = *(const LAS v2u*)(slot + SC_V0 + w * 512 + lane * 8);
}
__device__ __forceinline__ void scan3_block(Frame& F, int chain, unsigned* spcnt  ) {
    unsigned char* ws = F.ws;
    const int lane = F.lane, fr = lane & 15, fq = lane >> 4, wave = F.wave;
    const int d = chain & 1, h = (chain >> 1) & 7, b = chain >> 4;
    const unsigned char* FR = ws + WS_FRAG + (size_t)chain * NCHUNK * REC_BYTES; const unsigned char* VF = ws + WS_HB + (size_t)chain * NCHUNK * 2048;
    LAS unsigned char* ring = F.lds;
    if (wave >= 6) {
        const int k = wave - 6, sgn = d ? -1 : 1;
        const long rbc = d ? (long)MLAT + b * CL + CL - 1 : (long)MLAT + b * CL, rbl = (d ? (long)b * T + T - 1 : (long)b * T) - (long)sgn * CL;
        bf16* OFBK = (bf16*)(ws + WS_ARENA + AR_OFB) + (size_t)d * M * 512 + h * 64 + 4 * fr + (long)sgn * (8 * k + fq) * 512;
        const LAS unsigned char* otrk = ring + SC_R * SC_SLOT + (8 * k + fq) * SC_OROW + fr * 8;
#define SC_FLUSHK(c_) do { const int c__ = (c_); const LAS unsigned char* tp_ = otrk + (c__ & 1) * SC_OTILE; const v2u ova_ = *(const LAS v2u*)tp_, ovb_ = *(const LAS v2u*)(tp_ + 4 * SC_OROW); \
        const long rb_ = (c__ < CL / 16 ? rbc : rbl) + (long)sgn * 16 * c__; *(v2u*)(OFBK + rb_ * 512) = ova_; *(v2u*)(OFBK + (rb_ + 4 * sgn) * 512) = ovb_; asm volatile("s_waitcnt lgkmcnt(0)" ::: "memory"); } while (0)
        __builtin_amdgcn_s_barrier();
        for (int c = 0; c < NCHUNK; ++c) {
            if (c >= 3) SC_FLUSHK(c - 3);
            __builtin_amdgcn_s_barrier();
        }
        SC_FLUSHK(NCHUNK - 3);
        __builtin_amdgcn_s_barrier();
        SC_FLUSHK(NCHUNK - 2);
        __builtin_amdgcn_s_barrier();
        SC_FLUSHK(NCHUNK - 1);
        asm volatile("s_waitcnt vmcnt(0)" ::: "memory");
#undef SC_FLUSHK
    } else if (wave >= 4) {
        const int k = wave - 4;
#define SC_DMA16(g_, l_) __builtin_amdgcn_global_load_lds((const unsigned*)((g_) + lane * 16), (LAS unsigned*)(l_), 16, 0, 2)
#define SC_ISSUE(cc, slotidx) do { const unsigned char* rec_ = FR + (size_t)(cc) * REC_BYTES; const unsigned char* vf_ = VF + (size_t)(cc) * 2048; LAS unsigned char* sb_ = ring + (slotidx) * SC_SLOT; \
        if (k == 0) { _Pragma("unroll") for (int p_ = 0; p_ < 7; ++p_) SC_DMA16(rec_ + p_ * 1024, sb_ + p_ * 1024); } \
        else { _Pragma("unroll") for (int p_ = 7; p_ < 10; ++p_) SC_DMA16(rec_ + p_ * 1024, sb_ + p_ * 1024); \
            __builtin_amdgcn_global_load_lds((const unsigned*)(rec_ + RO_WC + lane * 4), (LAS unsigned*)(sb_ + RO_WC), 4, 0, 2); SC_DMA16(vf_, sb_ + SC_V0); SC_DMA16(vf_ + 1024, sb_ + SC_V0 + 1024); } } while (0)
#define SC_WAIT() do { if (k == 0) asm volatile("s_waitcnt vmcnt(56)" ::: "memory"); else asm volatile("s_waitcnt vmcnt(48)" ::: "memory"); } while (0)
        for (int c = 0; c <= SC_D; ++c) SC_ISSUE(c, c);
        SC_WAIT();
        __builtin_amdgcn_s_barrier();
        for (int c = 0; c < NCHUNK; ++c) {
            const int cc = c + SC_D + 1, ccl = cc < NCHUNK ? cc : NCHUNK - 1;
            if (cc == SP_MID0) {
                unsigned sp_ = 0; while (__hip_atomic_load(spcnt, RLX_AGENT) < (unsigned)(16 * SP_NMID) && ++sp_ < (1u << 20)) __builtin_amdgcn_s_sleep(4);
                __builtin_amdgcn_fence(__ATOMIC_ACQUIRE, "agent"); }
            SC_ISSUE(ccl, cc % SC_R);
            SC_WAIT();
            __builtin_amdgcn_s_barrier();
        }
        __builtin_amdgcn_s_barrier();
        __builtin_amdgcn_s_barrier();
        asm volatile("s_waitcnt vmcnt(0)" ::: "memory");
#undef SC_ISSUE
#undef SC_WAIT
#undef SC_DMA16
    } else {
        const int w = wave;
        LAS unsigned char* otile = ring + SC_R * SC_SLOT;
        LAS unsigned short* otw = (LAS unsigned short*)(otile + (4 * fq) * SC_OROW + (16 * w + fr) * 2);
        f32x4 Hk[4];
#pragma unroll
        for (int kt = 0; kt < 4; ++kt) Hk[kt] = (f32x4){0.f, 0.f, 0.f, 0.f};
        ScanRec RA, RB;
        __builtin_amdgcn_s_barrier();
        scan_load_lds(RA, ring, w, lane, fq);
        f32x4 oprev = (f32x4){0.f, 0.f, 0.f, 0.f};
        for (int ch = 0; ch < NCHUNK; ch += 2) {
            asm volatile("s_waitcnt lgkmcnt(0)" ::: "memory"); __builtin_amdgcn_s_barrier();
            scan_load_lds(RB, ring + ((ch + 1) % SC_R) * SC_SLOT, w, lane, fq);
            scan_step(RA, Hk, oprev, otw + SC_OTILE / 2, ch > 0);
            asm volatile("s_waitcnt lgkmcnt(0)" ::: "memory"); __builtin_amdgcn_s_barrier();
            if (ch + 2 < NCHUNK) scan_load_lds(RA, ring + ((ch + 2) % SC_R) * SC_SLOT, w, lane, fq);
            scan_step(RB, Hk, oprev, otw, true);
        }
        asm volatile("s_waitcnt lgkmcnt(0)" ::: "memory"); __builtin_amdgcn_s_barrier();
#pragma unroll
        for (int j = 0; j < 4; ++j) (otw + SC_OTILE / 2)[j * (SC_OROW / 2)] = (unsigned short)f2bf(oprev[j]);
        asm volatile("s_waitcnt lgkmcnt(0)" ::: "memory"); __builtin_amdgcn_s_barrier();
    }
}

__device__ __forceinline__ void nat_phase(Frame& F, const Args& args, int l, int nblk, int NW, bool ctxq) {
    frame_refresh(F); KArgs KA = kargs(); const int nwave = nblk * 8 + F.wave;
    unsigned char* ws = F.ws;
    const int lane = F.lane, fr = lane & 15, fq = lane >> 4;
    const bf16* QN = (const bf16*)(ws + WS_Y); const bf16* KN = QN + (size_t)M * 512;
    const bf16* VT = (const bf16*)(ws + WS_ARENA + AR_VT); const bf16* VTC = VT + (size_t)NB * 8 * 64 * T;
    bf16* BR = (bf16*)(ws + WS_ARENA + AR_BR);
    LAS float* rpb = (LAS float*)F.lds;
    LAS unsigned* bmax = (LAS unsigned*)(F.lds + 16384);
    if (F.tid == 0) *bmax = 0u;
    __syncthreads();
    { float mb = 0.f; for (int i = F.tid; i < 8 * 15 * 32; i += 512) { const int rw = i >> 5, co = i & 31; float v = 0.f; if (co < 31) { v = KIN(KA, I_RPB)[(size_t)l * 8 * 15 * 31 + rw * 31 + co]; mb = fmaxf(mb, fabsf(v)); } rpb[i] = v; }
      __hip_atomic_fetch_max(bmax, __float_as_uint(mb), __ATOMIC_RELAXED, __HIP_MEMORY_SCOPE_WORKGROUP); }
    __syncthreads();
    float mfix2;
    { float gq = 0.f, gk = 0.f;
#pragma unroll 8
      for (int i = 0; i < 64; ++i) { gq = fmaxf(gq, fabsf(KIN(KA, I_QNG)[l * 64 + i])); gk = fmaxf(gk, fabsf(KIN(KA, I_KNG)[l * 64 + i])); }
      mfix2 = (1.03f * 8.0f * gq * gk + __uint_as_float(*bmax) + 0.25f) * 1.4426950408889634f; }
    for (int i = F.tid; i < 8 * 15 * 32; i += 512) rpb[i] = (i & 31) < 31 ? rpb[i] * 1.4426950408889634f - mfix2 : -__builtin_inff();
    __syncthreads();
    constexpr int NWX = (256 - 32);
    const int xcd = (int)blockIdx.x & 7, wx = (nblk >> 3) * 8 + F.wave;
    {
        unsigned sink = 0u;
#pragma unroll 1
        for (int pp = 0; pp < 2; ++pp) { const int pair = 2 * xcd + pp, hh = pair & 7, bb = pair >> 3;
            const bf16* vt0 = VT + (size_t)(bb * 8 + hh) * 64 * T; const bf16* vc0 = VTC + (size_t)(bb * 8 + hh) * 64 * CL;
#pragma unroll 1
            for (int i = wx * 64 + lane; i < T + CL; i += NWX * 64) {
                const size_t row = i < T ? (size_t)bb * T + i : (size_t)MLAT + bb * CL + (i - T);
                sink ^= *(const unsigned*)(KN + row * 512 + hh * 64);
                sink ^= *(const unsigned*)(i < T ? vt0 + (size_t)i * 64 : vc0 + (size_t)(i - T) * 64); } }
        asm volatile("" :: "v"(sink));
    }
    constexpr int NLT = 512, NCT = 16;
    for (int task = wx; task < NLT + (ctxq ? NCT : 0); task += NWX) {
        const bool isl = task < NLT;
        int gp, h, r, b, rs = 0, cb0 = 0; int qm[2];
        unsigned boff[2][3][4];
        if (isl) { const int pair = 2 * xcd + (task >> 8); gp = task & 1; r = (task >> 1) & 127; h = pair & 7; b = pair >> 3;
            rs = r - 4 < 0 ? 0 : (r - 4 > GROWS - 8 ? GROWS - 8 : r - 4); cb0 = gp;
            const unsigned rowbase = (unsigned)((h * 15 + (rs - r + 7)) * 128);
#pragma unroll
            for (int t = 0; t < 2; ++t) { const int g = 2 * gp + t, c = 16 * g + fr, cs = c - 8 < 0 ? 0 : (c - 8 > 48 ? 48 : c - 8); qm[t] = b * T + r * 64 + c;
#pragma unroll
                for (int br = 0; br < 3; ++br)
#pragma unroll
                    for (int j = 0; j < 4; ++j) { const int kc = (cb0 + br) * 16 + 4 * fq + j; const bool ok = (unsigned)(kc - cs) < 16u; boff[t][br][j] = rowbase + (unsigned)(ok ? (kc - c + 15) * 4 : 31 * 4); } } }
        else { const int q = task - NLT, pair = 2 * xcd + (q >> 3); gp = q & 7; h = pair & 7; b = pair >> 3; r = 0;
#pragma unroll
            for (int t = 0; t < 2; ++t) { qm[t] = MLAT + b * CL + 16 * (2 * gp + t) + fr;
#pragma unroll
                for (int br = 0; br < 3; ++br)
#pragma unroll
                    for (int j = 0; j < 4; ++j) boff[t][br][j] = 0u; } }
        v4u q0[2], q1[2];
#pragma unroll
        for (int t = 0; t < 2; ++t) { q0[t] = *(const v4u*)(QN + (size_t)qm[t] * 512 + h * 64 + 8 * fq); q1[t] = *(const v4u*)(QN + (size_t)qm[t] * 512 + h * 64 + 32 + 8 * fq); }
        float lpart[2] = {0.f, 0.f};
        f32x4 O[2][4];
#pragma unroll
        for (int t = 0; t < 2; ++t)
#pragma unroll
            for (int dt = 0; dt < 4; ++dt) O[t][dt] = (f32x4){0.f, 0.f, 0.f, 0.f};
        const bf16* vt_lat = VT + ((size_t)(b * 8 + h) * 64 + fr) * T;
        const bf16* vt_ctx = VTC + ((size_t)(b * 8 + h) * 64 + fr) * CL;
        struct NatOps { v4u ka0, ka1, kb0, kb1; v2u va[4], vb[4]; };
#define NAT_LOAD(ks_, OP) do { const int ks__ = (ks_); const bool loc_ = isl && ks__ < 12; int tokA_, tokB_; const bf16* vA_; const bf16* vB_; size_t vst_; \
            if (loc_) { const int br_ = ks__ >> 2, i_ = ks__ & 3; const int ta_ = (rs + 2 * i_) * 64 + (cb0 + br_) * 16, tb_ = ta_ + 64; \
                tokA_ = b * T + ta_; tokB_ = b * T + tb_; vA_ = vt_lat + ta_ + 4 * fq; vB_ = vt_lat + tb_ + 4 * fq; vst_ = (size_t)16 * T; } \
            else { const int kc_ = isl ? ks__ - 12 : ks__; const int ta_ = 32 * kc_, tb_ = 32 * kc_ + 16; \
                tokA_ = MLAT + b * CL + ta_; tokB_ = MLAT + b * CL + tb_; vA_ = vt_ctx + ta_ + 4 * fq; vB_ = vt_ctx + tb_ + 4 * fq; vst_ = (size_t)16 * CL; } \
            const bf16* ka_ = KN + (size_t)(tokA_ + fr) * 512 + h * 64 + 8 * fq; const bf16* kb_ = KN + (size_t)(tokB_ + fr) * 512 + h * 64 + 8 * fq; \
            OP.ka0 = *(const v4u*)ka_; OP.ka1 = *(const v4u*)(ka_ + 32); OP.kb0 = *(const v4u*)kb_; OP.kb1 = *(const v4u*)(kb_ + 32); \
            _Pragma("unroll") for (int dt = 0; dt < 4; ++dt) { OP.va[dt] = *(const v2u*)(vA_ + dt * vst_); OP.vb[dt] = *(const v2u*)(vB_ + dt * vst_); } } while (0)
#define NAT_COMPUTE(LOCAL, br_, i_, OP) do { \
            _Pragma("unroll") for (int t = 0; t < 2; ++t) { \
                f32x4 sA = mfma16(OP.ka0, q0[t], (f32x4){0.f, 0.f, 0.f, 0.f}); sA = mfma16(OP.ka1, q1[t], sA); \
                f32x4 sB = mfma16(OP.kb0, q0[t], (f32x4){0.f, 0.f, 0.f, 0.f}); sB = mfma16(OP.kb1, q1[t], sB); \
                float ps = 0.f; f32x4 pA, pB; \
                if (LOCAL) { const unsigned ra_ = (unsigned)(2 * (i_)) * 128u; \
                    _Pragma("unroll") for (int j = 0; j < 4; ++j) { const LAS unsigned char* bp_ = (const LAS unsigned char*)rpb + (boff[t][br_][j] + ra_); \
                        pA[j] = __builtin_amdgcn_exp2f(sA[j] + *(const LAS float*)bp_); pB[j] = __builtin_amdgcn_exp2f(sB[j] + *(const LAS float*)(bp_ + 128)); ps += pA[j] + pB[j]; } } \
                else { _Pragma("unroll") for (int j = 0; j < 4; ++j) { pA[j] = __builtin_amdgcn_exp2f(sA[j] - mfix2); pB[j] = __builtin_amdgcn_exp2f(sB[j] - mfix2); ps += pA[j] + pB[j]; } } \
                lpart[t] += ps; \
                v4u pf; pf.x = pk2(pA[0], pA[1]); pf.y = pk2(pA[2], pA[3]); pf.z = pk2(pB[0], pB[1]); pf.w = pk2(pB[2], pB[3]); \
                _Pragma("unroll") for (int dt = 0; dt < 4; ++dt) { v4u vf; vf.x = OP.va[dt].x; vf.y = OP.va[dt].y; vf.z = OP.vb[dt].x; vf.w = OP.vb[dt].y; \
                    O[t][dt] = mfma16(vf, pf, O[t][dt]); } } } while (0)
        NatOps PA, PB;
        NAT_LOAD(0, PA);
        if (isl) {
#pragma unroll
            for (int br = 0; br < 3; ++br) {
#pragma unroll 1
                for (int i = 0; i < 4; i += 2) { const int ks = 4 * br + i;
                    NAT_LOAD(ks + 1, PB);
                    NAT_COMPUTE(true, br, i, PA);
                    NAT_LOAD(ks + 2, PA);
                    NAT_COMPUTE(true, br, i + 1, PB); } }
        }
        { const int k0 = isl ? 12 : 0;
#pragma unroll 1
          for (int kc = 0; kc < 8; kc += 2) {
              NAT_LOAD(k0 + kc + 1, PB);
              NAT_COMPUTE(false, 0, 0, PA);
              if (kc + 2 < 8) NAT_LOAD(k0 + kc + 2, PA);
              NAT_COMPUTE(false, 0, 0, PB); } }
#undef NAT_LOAD
#undef NAT_COMPUTE
#pragma unroll
        for (int t = 0; t < 2; ++t) {
            float lsum = lpart[t];
            lsum += __builtin_bit_cast(float, __builtin_amdgcn_ds_bpermute((lane ^ 16) << 2, __builtin_bit_cast(int, lsum)));
            lsum += __builtin_bit_cast(float, __builtin_amdgcn_ds_bpermute((lane ^ 32) << 2, __builtin_bit_cast(int, lsum)));
            const float inv = 1.0f / lsum;
#pragma unroll
            for (int dt = 0; dt < 4; ++dt) { v2u o; o.x = pk2(O[t][dt][0] * inv, O[t][dt][1] * inv); o.y = pk2(O[t][dt][2] * inv, O[t][dt][3] * inv);
                *(v2u*)(BR + (size_t)qm[t] * 1536 + 1024 + h * 64 + 16 * dt + 4 * fq) = o; } }
    }
}

__device__ __forceinline__ void readout_phase(Frame& F, const Args& args, int l, int mrows) {
    frame_refresh(F); KArgs KA = kargs();
    unsigned char* ws = F.ws;
    const int gw = F.vcu * 8 + F.wave, NGW = F.G * 8, lane = F.lane;
    const bf16* Z = (const bf16*)(ws + WS_ARENA + AR_Z); const bf16* LO = (const bf16*)(ws + WS_ARENA + AR_LO);
    const bf16* O0 = (const bf16*)(ws + WS_ARENA + AR_OFB); const bf16* O1 = O0 + (size_t)M * 512;
    bf16* BR = (bf16*)(ws + WS_ARENA + AR_BR);
    const float* mu0 = KIN(KA, I_SHMU) + (size_t)l * 2 * 1760; const float* mu1 = mu0 + 1760;
    const int ch = lane * 8;
    float kaw[8], brk[8], gg[8], gb[8];
#pragma unroll
    for (int j = 0; j < 8; ++j) { kaw[j] = KIN(KA, I_KKA)[l * 512 + ch + j]; brk[j] = KIN(KA, I_BONUS)[l * 512 + ch + j]; gg[j] = KIN(KA, I_GNG)[l * 512 + ch + j]; gb[j] = KIN(KA, I_GNB)[l * 512 + ch + j]; }
    for (int m = gw; m < mrows; m += NGW) {
        int seq0, t, Tn; seq_of_row(m, seq0, t, Tn);
        const v4u vo0 = *(const v4u*)(O0 + (size_t)m * 512 + ch), vo1 = *(const v4u*)(O1 + (size_t)m * 512 + ch);
        Sh8 sr, sk, sv; sh8_load(sr, Z, m, t, Tn, ZR + ch); sh8_load(sk, Z, m, t, Tn, ZK + ch); sh8_load(sv, Z, m, t, Tn, ZV + ch);
        const v4u va0 = *(const v4u*)(LO + (size_t)m * NLORA + 1024 + ch), va1 = *(const v4u*)(LO + (size_t)m * NLORA + 1536 + ch), vgt = *(const v4u*)(LO + (size_t)m * NLORA + 2048 + ch);
        asm volatile("" ::: "memory"); __builtin_amdgcn_sched_barrier(0);
        float o0[8], o1[8]; unpack8(vo0, o0); unpack8(vo1, o1);
        float s = 0.f;
#pragma unroll
        for (int j = 0; j < 8; ++j) { o0[j] += o1[j]; s += o0[j]; }
        const float mean = red8(s) * (1.f / 64.f); float q = 0.f;
#pragma unroll
        for (int j = 0; j < 8; ++j) { o0[j] -= mean; q += o0[j] * o0[j]; }
        const float rstd = 1.0f / sqrtf(red8(q) * (1.f / 64.f) + 64e-5f);
        float rs_[8], ks_[8], vs_[8];
        sh8_eval(sr, mu0 + ch, mu1 + ch, rs_);
        sh8_eval(sk, mu0 + 512 + ch, mu1 + 512 + ch, ks_);
        sh8_eval(sv, mu0 + 1024 + ch, mu1 + 1024 + ch, vs_);
        float a0[8], a1[8], gt[8];
        unpack8(va0, a0); unpack8(va1, a1); unpack8(vgt, gt);
        float bs = 0.f;
#pragma unroll
        for (int j = 0; j < 8; ++j) { const float kd = ks_[j] * ((1.0f + (a0[j] - 1.0f) * kaw[j]) + (1.0f + (a1[j] - 1.0f) * kaw[j])); bs += rs_[j] * kd * brk[j]; }
        bs = red8(bs);
        float out[8];
#pragma unroll
        for (int j = 0; j < 8; ++j) out[j] = (o0[j] * rstd * gg[j] + gb[j] + bs * vs_[j]) * gt[j];
        *(v4u*)(BR + (size_t)m * 1536 + 512 + ch) = pack8(out);
    }
}

__device__ __forceinline__ void sum_phase(Frame& F, int rbase, int rcount, int rblk, int rnb  ) {
    frame_refresh(F);
    rbase = __builtin_amdgcn_readfirstlane(rbase); rcount = __builtin_amdgcn_readfirstlane(rcount); rblk = __builtin_amdgcn_readfirstlane(rblk); rnb = __builtin_amdgcn_readfirstlane(rnb);
    asm volatile("" : "+s"(rbase), "+s"(rcount), "+s"(rblk), "+s"(rnb));
    unsigned char* ws = F.ws;
    const v4u* P = (const v4u*)(ws + WS_ARENA + AR_P) + (size_t)rbase * 384; v4u* U = (v4u*)(ws + WS_HB) + (size_t)rbase * 128;
    for (size_t i = (size_t)rblk * 512 + F.tid; i < (size_t)rcount * 128; i += (size_t)rnb * 512) {
        const size_t row = i >> 7, c = i & 127;
        float a[8], b[8], d[8]; unpack8(P[row * 384 + c], a); unpack8(P[row * 384 + 128 + c], b); unpack8(P[row * 384 + 256 + c], d);
#pragma unroll
        for (int j = 0; j < 8; ++j) a[j] += b[j] + d[j];
        U[i] = pack8(a);
    }
}

__device__ __forceinline__ void final_phase(Frame& F, const Args& args, int ymode, const float* gate_mod) {
    frame_refresh(F); KArgs KA = kargs();
    unsigned char* ws = F.ws;
    const int gw = F.vcu * 8 + F.wave, NGW = F.G * 8, lane = F.lane;
    const bf16* Y = (const bf16*)(ws + WS_Y); const bf16* YP = (const bf16*)(ws + WS_ARENA + AR_YP); const unsigned* RT = (const unsigned*)(ws + WS_RT);
    for (int m = gw; m < MLAT; m += NGW) {
        const int srow = m >> 13; float* xo = ((float*)(GAS float*)KA->out) + (size_t)m * D;
        unsigned r0 = 0, r1 = 0; float w0 = 0.f, w1 = 0.f;
        if (ymode == 2) { const v4u rt = *(const v4u*)(RT + (size_t)m * 8); const v4u rt2 = *(const v4u*)(RT + (size_t)m * 8 + 4); w0 = __uint_as_float(rt.z); w1 = __uint_as_float(rt.w); r0 = rt2.x; r1 = rt2.y; }
#pragma unroll
        for (int j = 0; j < 4; ++j) {
            const int col = 4 * lane + 256 * j; f32x4 v = *(const f32x4*)(xo + col); f32x4 yv;
            if (ymode == 1) { const v2u yy = *(const v2u*)(Y + (size_t)m * D + col); yv = (f32x4){bflo(yy.x), bfhi(yy.x), bflo(yy.y), bfhi(yy.y)}; }
            else { const v2u ya = *(const v2u*)(YP + (size_t)r0 * D + col), yb = *(const v2u*)(YP + (size_t)r1 * D + col);
                yv = (f32x4){w0 * bflo(ya.x) + w1 * bflo(yb.x), w0 * bfhi(ya.x) + w1 * bfhi(yb.x), w0 * bflo(ya.y) + w1 * bflo(yb.y), w0 * bfhi(ya.y) + w1 * bfhi(yb.y)}; }
            const f32x4 gt = *(const f32x4*)(gate_mod + (size_t)srow * 6 * D + col);
            *(f32x4*)(xo + col) = v + gt * yv;
        }
    }
}

template <bool FFN>
__device__ __forceinline__ void deferred_ctx_tile(Frame& F, const Args& args, int l  ) {
    frame_refresh(F);
    unsigned char* ws = F.ws; unsigned* ctl = (unsigned*)(ws + WS_CTL);
    const int bx = (int)blockIdx.x, khalf = FFN ? bx >> 3 : 0, tl = FFN ? bx & 7 : bx, panel = tl >> 2, pn = tl & 3;
    pg8::SingleSched S; S.pm = MLAT / 256 + panel; S.pn = pn;
    if (FFN) { const int j = l >> 1; S.a = (const char*)(ws + WS_ARENA + AR_ACT) + (size_t)S.pm * 256 * DFF * 2 + (size_t)khalf * (DFF / 2) * 2; S.b = (const char*)(ws + WS_W2) + (size_t)j * D * DFF * 2 + (size_t)pn * 256 * DFF * 2 + (size_t)khalf * (DFF / 2) * 2; }
    else { S.a = (const char*)(ws + WS_HB) + (size_t)S.pm * 256 * D * 2; S.b = (const char*)(ws + WS_WOUT) + (size_t)l * D * D * 2 + (size_t)pn * 256 * D * 2; }
    pg8::EpiBf16 E{khalf ? (bf16*)(ws + WS_Y2) - (size_t)MLAT * D : (bf16*)(ws + WS_Y), D};
    if (FFN) pg8::gemm_phase(F.lds, pg8::Gemm{DFF, DFF, DFF / 2}, S, E, F.wave); else pg8::gemm_phase(F.lds, pg8::Gemm{D, D, D}, S, E, F.wave);
    asm volatile("s_waitcnt vmcnt(0)" ::: "memory"); __syncthreads();
    frame_refresh(F);
    if (F.tid == 0) { unsigned* cnt = ctl + CW_DEF + ((l * 2 + (FFN ? 1 : 0)) * 2 + panel) * 64;
        __builtin_amdgcn_fence(__ATOMIC_RELEASE, "agent"); asm volatile("s_waitcnt vmcnt(0)" ::: "memory");
        __hip_atomic_fetch_add(cnt, 1u, RLX_AGENT); }
    __syncthreads();
}

__device__ __forceinline__ void deferred_ctx_branch(Frame& F, const Args& args, int l, bf16* Zb) {
    frame_refresh(F);
    unsigned char* ws = F.ws; unsigned* ctl = (unsigned*)(ws + WS_CTL);
    const int bx = (int)blockIdx.x, panel = bx / 12, pn = bx % 12;
    pg8::SingleSched S; S.pm = MLAT / 256 + panel; S.pn = pn;
    S.a = (const char*)(ws + WS_ARENA + AR_BR) + (size_t)S.pm * 256 * 1536 * 2 + (size_t)(pn / 4) * 512 * 2; S.b = (const char*)(ws + WS_WBR) + (size_t)l * 3072 * 512 * 2 + (size_t)pn * 256 * 512 * 2;
    pg8::EpiGate E{(bf16*)(ws + WS_ARENA + AR_P), Zb + ZG};
    pg8::gemm_phase(F.lds, pg8::Gemm{1536, 512, 512}, S, E, F.wave);
    asm volatile("s_waitcnt vmcnt(0)" ::: "memory"); __syncthreads();
    frame_refresh(F);
    if (F.tid == 0) { unsigned* cnt = ctl + CW_DEFB + (l * 2 + panel) * 64;
        __builtin_amdgcn_fence(__ATOMIC_RELEASE, "agent"); asm volatile("s_waitcnt vmcnt(0)" ::: "memory");
        __hip_atomic_fetch_add(cnt, 1u, RLX_AGENT);
        unsigned sp = 0; while (__hip_atomic_load(cnt, RLX_AGENT) < 12u && ++sp < (1u << 21)) __builtin_amdgcn_s_sleep(2);
        __builtin_amdgcn_fence(__ATOMIC_ACQUIRE, "agent"); asm volatile("s_waitcnt vmcnt(0)" ::: "memory"); }
    __syncthreads();
}

constexpr int NPH_LAYER = 14, PH_FINAL = 1 + DEPTH * NPH_LAYER, NPHASES = PH_FINAL + 1;
__global__ void __launch_bounds__(512, 2) mk_fwd(Args args) {
    extern __shared__ __attribute__((aligned(16))) unsigned char lds[];
    Frame F;
    F.lds = (LAS unsigned char*)lds; F.ws = args.ws;
    F.tid = threadIdx.x; F.lane = F.tid & 63; F.wave = __builtin_amdgcn_readfirstlane(F.tid >> 6);
    F.G = gridDim.x; { const int bx = blockIdx.x; F.vcu = (F.G % 8 == 0) ? (bx % 8) * (F.G / 8) + bx / 8 : bx; }
    volatile LAS unsigned* MISC = (volatile LAS unsigned*)(F.lds + MISC_OFF);
    unsigned char* ws = args.ws;
    unsigned* ctl = (unsigned*)(ws + WS_CTL);
    for (int u = F.tid; u < (LDS_BYTES - LDSCTL_OFF) / 4; u += 512) ((LAS unsigned*)(F.lds + LDSCTL_OFF))[u] = 0u;
    __syncthreads();
    XcdBarrier bar; bar.bar = ctl + CW_BAR; bar.x = 0; bar.st = nullptr;
    if (!MK_PER_PHASE) bar = xcd_barrier_post(ctl + CW_BAR, MISC + 8);
    const int lo = args.ph_lo, hi = args.ph_hi;
#define IN(k) (lo <= (k) && (k) < hi)
#define SEAM(k) do { if (!MK_PER_PHASE && IN((k) + 1)) xcd_barrier(bar, F.wave); } while (0)

    if (IN(0)) { p0_prologue(F, args); SEAM(0); }

    const float* MOD = (const float*)(ws + WS_MOD);
    bf16* Zb = (bf16*)(ws + WS_ARENA + AR_Z);
    for (int l = 0; l < DEPTH; ++l) {
        KArgs KA = kargs(); { unsigned long long w_ = (unsigned long long)ws; asm volatile("" : "+s"(w_)); ws = (unsigned char*)(GAS unsigned char*)w_; }
        const int pb = 1 + l * NPH_LAYER;
        const bool moe = (l & 1) != 0; const int j2 = l >> 1;
        const int mrows = l + 1 < DEPTH ? M : MLAT;
        const float* modl = MOD + (size_t)l * 3 * 6 * D;
        if (IN(pb + 0)) {
            const float* modp = MOD + (size_t)(l - 1) * 3 * 6 * D;
            const float* xl = l == 0 ? KIN(KA, I_X) : ((float*)(GAS float*)KA->out); const float* xc = l == 0 ? KIN(KA, I_CTX) : (const float*)(ws + WS_XSC);
            const int ymode = l == 0 ? 0 : (((l - 1) & 1) ? 2 : 1);
            if (l >= 1 && ((l - 1) & 1) == 0) {
                if (blockIdx.x < 16) deferred_ctx_tile<true>(F, args, l - 1);
                else norm_phase(F, args, xl, xc, ymode, modp + 5 * D, KIN(KA, I_NMG) + l * D, modl + 1 * D, modl + 0 * D, false, nullptr, 0, (int)blockIdx.x - 16, F.G - 16, 0, MLAT, ws + WS_HB8,
                                MLAT, MCTX, 3, ctl + CW_DEF + (((l - 1) * 2 + 1) * 2) * 64, 8u);
            } else norm_phase(F, args, xl, xc, ymode, l == 0 ? nullptr : modp + 5 * D, KIN(KA, I_NMG) + l * D, modl + 1 * D, modl + 0 * D, false, nullptr, 0, F.vcu, F.G, 0, M, ws + WS_HB8);
            SEAM(pb + 0);
        }
        if (IN(pb + 1)) {
            { pg8::DenseSched S; S.to.init(M / 256, NZB / 256, F.G, (int)blockIdx.x); S.A = (const char*)(ws + WS_HB); S.Bt = (const char*)(ws + WS_WIN) + (size_t)l * NZB * D * 2;
              S.a_tile = (size_t)256 * D * 2; S.b_tile = (size_t)256 * D * 2; S.acol_div = 1 << 20; S.acol_step = 0;
              pg8::EpiBf16 E{Zb, NZ};
              pg8::gemm_phase(F.lds, pg8::Gemm{D, D, D}, S, E, F.wave); }
            { pg8::DenseSched S; S.to.init(M / 256, NZG / 256, F.G, ((int)blockIdx.x + 32) % F.G); S.A = (const char*)(ws + WS_HB8); S.Bt = (const char*)(ws + WS_WING8) + (size_t)l * NZG * D;
              S.a_tile = (size_t)256 * D; S.b_tile = (size_t)256 * D; S.acol_div = 1 << 20; S.acol_step = 0;
              pg8::EpiBf16 E{Zb + ZG, NZ};
              pg8::gemm_phase<pg8::EpiBf16, pg8::DenseSched, true>(F.lds, pg8::Gemm{D / 2, D / 2, D / 2}, S, E, F.wave); }
            SEAM(pb + 1);
        }
        if (IN(pb + 2)) { prep_phase(F, args, l); SEAM(pb + 2); }
#pragma unroll 1
        for (int sp = 0; sp < 2; ++sp) {
            if (sp == 0 ? IN(pb + 4) : (IN(pb + 5) && blockIdx.x >= 32)) scanpre_phase(F, args, l, sp);
            if (sp == 0) { if (IN(pb + 4)) SEAM(pb + 4); }
            else if (IN(pb + 5)) {
                unsigned* spcnt = ctl + CW_SPM + l * 64;
                if (blockIdx.x < 32) { frame_refresh(F); scan3_block(F, (int)blockIdx.x, spcnt); }
                else {
                    { const int nw = ((int)blockIdx.x - 32) * 8 + F.wave;
                      if (nw % 7 == 0 && nw / 7 < 16 * SP_NMID) { asm volatile("s_waitcnt vmcnt(0)" ::: "memory"); __builtin_amdgcn_fence(__ATOMIC_RELEASE, "agent"); asm volatile("s_waitcnt vmcnt(0)" ::: "memory");
                          if (F.lane == 0) __hip_atomic_fetch_add(spcnt, 1u, RLX_AGENT); } }
                    __syncthreads();
                    nat_phase(F, args, l, (int)blockIdx.x - 32, (F.G - 32) * 8, l + 1 < DEPTH);
                }
                SEAM(pb + 5);
            }
        }
        if (IN(pb + 6)) { readout_phase(F, args, l, mrows); if (l == 2) moe_convert(F, args, 1); SEAM(pb + 6); }
        if (IN(pb + 7)) {
            pg8::DenseSched S; S.to.init(MLAT / 256, 12, F.G, (int)blockIdx.x); S.A = (const char*)(ws + WS_ARENA + AR_BR); S.Bt = (const char*)(ws + WS_WBR) + (size_t)l * 3072 * 512 * 2;
            S.a_tile = (size_t)256 * 1536 * 2; S.b_tile = (size_t)256 * 512 * 2; S.acol_div = 4; S.acol_step = 512 * 2;
            pg8::EpiGate E{(bf16*)(ws + WS_ARENA + AR_P), Zb + ZG};
            pg8::gemm_phase(F.lds, pg8::Gemm{1536, 512, 512}, S, E, F.wave);
            SEAM(pb + 7);
        }
        if (IN(pb + 8)) {
            if (l + 1 < DEPTH) {
                if (blockIdx.x < 24) { deferred_ctx_branch(F, args, l, Zb); sum_phase(F, MLAT + ((int)blockIdx.x / 12) * 256, 256, (int)blockIdx.x % 12, 12); }
                else sum_phase(F, 0, MLAT, (int)blockIdx.x - 24, F.G - 24);
            } else sum_phase(F, 0, MLAT, (int)blockIdx.x, F.G);
            SEAM(pb + 8);
        }
        if (IN(pb + 9)) {
            pg8::DenseSched S; S.to.init(MLAT / 256, D / 256, F.G, (int)blockIdx.x); S.A = (const char*)(ws + WS_HB); S.Bt = (const char*)(ws + WS_WOUT) + (size_t)l * D * D * 2;
            S.a_tile = (size_t)256 * D * 2; S.b_tile = (size_t)256 * D * 2; S.acol_div = 1 << 20; S.acol_step = 0;
            pg8::EpiBf16 E{(bf16*)(ws + WS_Y), D};
            pg8::gemm_phase(F.lds, pg8::Gemm{D, D, D}, S, E, F.wave);
            SEAM(pb + 9);
        }
        if (IN(pb + 10)) {
            if (l + 1 < DEPTH) {
                if (blockIdx.x < 8) deferred_ctx_tile<false>(F, args, l);
                else norm_phase(F, args, ((float*)(GAS float*)KA->out), (const float*)(ws + WS_XSC), 1, modl + 2 * D, KIN(KA, I_NFG) + l * D, modl + 4 * D, modl + 3 * D, moe, KIN(KA, I_ROUTER) + (size_t)j2 * D * 8, j2, (int)blockIdx.x - 8, F.G - 8, 0, MLAT, nullptr,
                                MLAT, MCTX, 1, ctl + CW_DEF + ((l * 2 + 0) * 2) * 64, 4u);
            } else norm_phase(F, args, ((float*)(GAS float*)KA->out), (const float*)(ws + WS_XSC), 1, modl + 2 * D, KIN(KA, I_NFG) + l * D, modl + 4 * D, modl + 3 * D, moe, KIN(KA, I_ROUTER) + (size_t)j2 * D * 8, j2, F.vcu, F.G, 0, MLAT);
            SEAM(pb + 10);
        }
        if (IN(pb + 11)) { if (moe) { moe_perm_phase(F, j2, mrows); SEAM(pb + 11); } }
        if (IN(pb + 12)) {
            if (moe) {
                pg8::GroupSched S; S.a_tile = (size_t)256 * D; S.b_tile = (size_t)256 * D; S.b_exp = (size_t)NF1 * D;
                unsigned cnt[8];
#pragma unroll
                for (int e = 0; e < 8; ++e) cnt[e] = ctl[CW_MOE + j2 * 64 + e];
                moe_prefix(cnt, S.pe); S.A = (const char*)(ws + WS_ARENA + AR_HP); S.Bt = (const char*)(ws + WS_MW13); S.to.init(S.pe[8], NF1 / 256, F.G, (int)blockIdx.x);
                pg8::EpiSwiglu8 E{ws + WS_ARENA + AR_ACT};
                pg8::gemm_phase<pg8::EpiSwiglu8, pg8::GroupSched, true>(F.lds, pg8::Gemm{D / 2, D / 2, D / 2}, S, E, F.wave);
            } else {
                pg8::GroupSched S; S.a_tile = (size_t)256 * D * 2; S.b_tile = (size_t)256 * D * 2; S.b_exp = (size_t)NF1 * D * 2;
#pragma unroll
                for (int e = 0; e < 9; ++e) S.pe[e] = e == 0 ? 0 : M / 256;
                S.A = (const char*)(ws + WS_HB); S.Bt = (const char*)(ws + WS_W13) + (size_t)j2 * NF1 * D * 2; S.to.init(M / 256, NF1 / 256, F.G, (int)blockIdx.x);
                pg8::EpiSwiglu E{(bf16*)(ws + WS_ARENA + AR_ACT)};
                pg8::gemm_phase(F.lds, pg8::Gemm{D, D, D}, S, E, F.wave);
            }
            SEAM(pb + 12);
        }
        if (IN(pb + 13)) {
            if (moe) {
                pg8::GroupSched S; S.a_tile = (size_t)256 * DFF; S.b_tile = (size_t)256 * DFF; S.b_exp = (size_t)D * DFF;
                unsigned cnt[8];
#pragma unroll
                for (int e = 0; e < 8; ++e) cnt[e] = ctl[CW_MOE + j2 * 64 + e];
                moe_prefix(cnt, S.pe); S.A = (const char*)(ws + WS_ARENA + AR_ACT); S.Bt = (const char*)(ws + WS_MW2); S.to.init(S.pe[8], D / 256, F.G, (int)blockIdx.x);
                pg8::EpiBf16 E{(bf16*)(ws + WS_ARENA + AR_YP), D};
                pg8::gemm_phase<pg8::EpiBf16, pg8::GroupSched, true>(F.lds, pg8::Gemm{DFF / 2, DFF / 2, DFF / 2}, S, E, F.wave);
            } else {
                pg8::GroupSched S; S.a_tile = (size_t)256 * DFF * 2; S.b_tile = (size_t)256 * DFF * 2; S.b_exp = (size_t)D * DFF * 2;
#pragma unroll
                for (int e = 0; e < 9; ++e) S.pe[e] = e == 0 ? 0 : M / 256;
                S.A = (const char*)(ws + WS_ARENA + AR_ACT); S.Bt = (const char*)(ws + WS_W2) + (size_t)j2 * D * DFF * 2; S.to.init(MLAT / 256, D / 256, F.G, (int)blockIdx.x);
                pg8::EpiBf16 E{(bf16*)(ws + WS_Y), D};
                pg8::gemm_phase(F.lds, pg8::Gemm{DFF, DFF, DFF}, S, E, F.wave);
            }
            SEAM(pb + 13);
        }
    }
    if (IN(PH_FINAL)) { final_phase(F, args, ((DEPTH - 1) & 1) ? 2 : 1, MOD + (size_t)(DEPTH - 1) * 3 * 6 * D + 5 * D); }
#undef IN
#undef SEAM
}

extern "C" void kernel_launch(void* const* d_in, const int* in_sizes, int n_in, void* d_out, int out_size, void* d_ws, size_t ws_size, hipStream_t stream) {
    static int grid = 0;
    if (grid == 0) {
        if (n_in != 34 || out_size != MLAT * D || ws_size < WS_END) { fprintf(stderr, "kernel_launch: unexpected shapes (n_in %d, out %d, ws %zu < %zu)\n", n_in, out_size, ws_size, (size_t)WS_END); grid = -1; return; }
        int dev = 0, cus = 0, per_cu = 0;
        if (hipGetDevice(&dev) != hipSuccess || hipDeviceGetAttribute(&cus, hipDeviceAttributeMultiprocessorCount, dev) != hipSuccess) { grid = -1; return; }
        if (hipFuncSetAttribute((const void*)mk_fwd, hipFuncAttributeMaxDynamicSharedMemorySize, LDS_BYTES) != hipSuccess) { fprintf(stderr, "kernel_launch: hipFuncSetAttribute failed\n"); grid = -1; return; }
        if (hipOccupancyMaxActiveBlocksPerMultiprocessor(&per_cu, (const void*)mk_fwd, 512, LDS_BYTES) != hipSuccess || per_cu < 1) fprintf(stderr, "kernel_launch: occupancy query says %d\n", per_cu);
        (void)hipGetLastError();
        if (cus != 256) { fprintf(stderr, "kernel_launch: this kernel is laid out for 256 CUs (found %d)\n", cus); grid = -1; return; }
        grid = cus;
    }
    if (grid < 0) return;
    if (hipMemsetAsync((char*)d_ws + WS_CTL, 0, CTL_ZERO_BYTES, stream) != hipSuccess) return;
    Args a{};
    for (int i = 0; i < 34; ++i) a.in[i] = (const float*)d_in[i];
    a.out = (float*)d_out; a.ws = (unsigned char*)d_ws;
#if MK_PER_PHASE
    for (int p = 0; p < NPHASES; ++p) { a.ph_lo = p; a.ph_hi = p + 1; hipLaunchKernelGGL(mk_fwd, dim3(grid), dim3(512), LDS_BYTES, stream, a); }
#else
    a.ph_lo = 0; a.ph_hi = NPHASES;
    hipLaunchKernelGGL(mk_fwd, dim3(grid), dim3(512), LDS_BYTES, stream, a);
#endif
}
```

```cpp
#include <hip/hip_runtime.h>
#include <cstdio>
#include <cstdint>

#ifndef MK_PER_PHASE
#define MK_PER_PHASE 0
#endif

#define GAS __attribute__((address_space(1)))
#define LAS __attribute__((address_space(3)))
typedef unsigned short bf16;
typedef unsigned v4u __attribute__((ext_vector_type(4)));
typedef unsigned v2u __attribute__((ext_vector_type(2)));
typedef float f32x4 __attribute__((ext_vector_type(4)));
typedef float f32x2 __attribute__((ext_vector_type(2)));
typedef short bf16x8 __attribute__((ext_vector_type(8)));
typedef GAS unsigned gu32;

constexpr int D = 1024, NB = 2, T = 8192, DEPTH = 4, CL = 256, GWID = 64, GROWS = 128;
constexpr int MLAT = NB * T, MCTX = NB * CL, M = MLAT + MCTX;
constexpr int BWID = 512, DFF = 2816, NEXP = 8;
constexpr int IN_TOTAL = 6880, NZ = 6912;
constexpr int ZP = 0, ZR = 512, ZK = 1024, ZV = 1536, ZWLO = 2048, ZQ = 2304, ZNK = 2816, ZNV = 3328, ZG = 3840;
constexpr int NLORA = 2560, KLORA = 256;
constexpr int NF1 = 2 * DFF;
constexpr int MAXPANELS = 140;

constexpr size_t MiB = 1u << 20;
constexpr size_t al(size_t x) { return (x + 4095) & ~(size_t)4095; }
constexpr size_t WS_CTL = 0, CTL_ZERO_BYTES = 1 * MiB;
constexpr size_t WS_MOD = WS_CTL + CTL_ZERO_BYTES;
constexpr size_t WS_XSC = al(WS_MOD + (size_t)DEPTH * 3 * 6 * D * 4);
constexpr size_t WS_RT = al(WS_XSC + (size_t)MCTX * D * 4);
constexpr size_t WS_KINV = al(WS_RT + (size_t)M * 32);
constexpr size_t WS_HB = al(WS_KINV + (size_t)M * 8 * 4);
constexpr size_t WS_Y = al(WS_HB + (size_t)M * D * 2);
constexpr int NZB = 3840, NZG = 3072;
static_assert(ZG == NZB && NZB + NZG == NZ, "gate columns");
constexpr size_t WS_WIN = al(WS_Y + (size_t)M * D * 2);
constexpr size_t WS_WING8 = al(WS_WIN + (size_t)DEPTH * NZB * D * 2);
constexpr size_t WS_HB8 = al(WS_WING8 + (size_t)DEPTH * NZG * D);
constexpr size_t WS_Y2 = al(WS_HB8 + (size_t)M * D);
constexpr size_t WS_WLORA = al(WS_Y2 + (size_t)MCTX * D * 2);
constexpr size_t WS_WBR = al(WS_WLORA + (size_t)DEPTH * NLORA * KLORA * 2);
constexpr size_t WS_WOUT = al(WS_WBR + (size_t)DEPTH * 3072 * 512 * 2);
constexpr size_t WS_W13 = al(WS_WOUT + (size_t)DEPTH * D * D * 2);
constexpr size_t WS_W2 = al(WS_W13 + (size_t)2 * NF1 * D * 2);
constexpr size_t WS_MW13 = al(WS_W2 + (size_t)2 * D * DFF * 2);
constexpr size_t WS_MW2 = al(WS_MW13 + (size_t)NEXP * NF1 * D * 2);
constexpr int NCHUNK = (CL + T) / 16;
constexpr int REC_BYTES = 10496, RO_KT = 0, RO_RT = 2048, RO_KA = 4096, RO_OA = 8192, RO_AK = 9216, RO_TT = 9728, RO_WC = 10240;
constexpr size_t WS_FRAG = al(WS_MW2 + (size_t)NEXP * D * DFF * 2);
constexpr size_t WS_ARENA = al(WS_FRAG + (size_t)32 * NCHUNK * REC_BYTES);
constexpr size_t AR_Z = 0;
constexpr size_t AR_BR = al(AR_Z + (size_t)M * NZ * 2);
constexpr size_t AR_LO = al(AR_BR + (size_t)M * 1536 * 2);
constexpr size_t AR_VT = AR_LO + (size_t)M * NLORA * 2;
constexpr size_t AR_P = AR_LO;
constexpr size_t AR_OFB = al(AR_VT + (size_t)M * 512 * 2);
constexpr size_t AR_END_MIX = al(AR_OFB + (size_t)2 * M * 512 * 2);
constexpr size_t AR_HP = 0;
constexpr size_t AR_ACT = al(AR_HP + (size_t)MAXPANELS * 256 * D * 2);
constexpr size_t AR_YP = al(AR_ACT + (size_t)MAXPANELS * 256 * DFF * 2);
constexpr size_t AR_END_FFN = al(AR_YP + (size_t)MAXPANELS * 256 * D * 2);
constexpr size_t ARENA_BYTES = AR_END_MIX > AR_END_FFN ? AR_END_MIX : AR_END_FFN;
constexpr size_t WS_END = WS_ARENA + ARENA_BYTES;
static_assert(AR_P + (size_t)M * 3072 * 2 <= AR_OFB, "P overlays LO+VT only");
static_assert(WS_END <= (size_t)948 * 1000 * 1000, "workspace budget");

constexpr int CW_BAR = 4096;
constexpr int CW_MOE = 16384;
constexpr int CW_BB = 32768;
constexpr int CW_SPM = 52224;
constexpr int CW_DEFB = 53248;
constexpr int CW_DEF = 49152;

constexpr int RING_BYTES = 131072;
constexpr int LDSCTL_OFF = RING_BYTES, MISC_OFF = LDSCTL_OFF + 320;
constexpr int LDS_BYTES = 147456;

#define RLX_AGENT __ATOMIC_RELAXED, __HIP_MEMORY_SCOPE_AGENT
#define LDS_WAIT() asm volatile("s_waitcnt lgkmcnt(0)" ::: "memory")
#define VM_WAIT() asm volatile("s_waitcnt vmcnt(0)" ::: "memory")
typedef __bf16 bf2_t __attribute__((ext_vector_type(2)));
__device__ __forceinline__ unsigned f2bf(float f) { const __bf16 b = (__bf16)f; return (unsigned)__builtin_bit_cast(unsigned short, b); }
__device__ __forceinline__ unsigned pk2(float lo, float hi) { const bf2_t v = __builtin_convertvector((f32x2){lo, hi}, bf2_t); return __builtin_bit_cast(unsigned, v); }
__device__ __forceinline__ float bflo(unsigned u) { return __builtin_bit_cast(float, u << 16); }
__device__ __forceinline__ float bfhi(unsigned u) { return __builtin_bit_cast(float, u & 0xffff0000u); }
__device__ __forceinline__ float bf1(bf16 b) { return __builtin_bit_cast(float, ((unsigned)b) << 16); }
__device__ __forceinline__ void unpack8(const v4u v, float (&o)[8]) { o[0] = bflo(v.x); o[1] = bfhi(v.x); o[2] = bflo(v.y); o[3] = bfhi(v.y); o[4] = bflo(v.z); o[5] = bfhi(v.z); o[6] = bflo(v.w); o[7] = bfhi(v.w); }
__device__ __forceinline__ v4u pack8(const float (&o)[8]) { v4u v; v.x = pk2(o[0], o[1]); v.y = pk2(o[2], o[3]); v.z = pk2(o[4], o[5]); v.w = pk2(o[6], o[7]); return v; }
__device__ __forceinline__ int lane_id() { return (int)__builtin_amdgcn_mbcnt_hi(~0u, __builtin_amdgcn_mbcnt_lo(~0u, 0u)); }
__device__ __forceinline__ float sigmoidf_(float x) { return 1.0f / (1.0f + __expf(-x)); }
__device__ __forceinline__ float sat8(float x) { return fminf(fmaxf(x, -448.0f), 448.0f); }
__device__ __forceinline__ float dppf(float x, const int ctrl_sel) {
    int xi = __builtin_bit_cast(int, x), r;
    if (ctrl_sel == 0) r = __builtin_amdgcn_mov_dpp(xi, 0xB1, 0xF, 0xF, true);
    else if (ctrl_sel == 1) r = __builtin_amdgcn_mov_dpp(xi, 0x4E, 0xF, 0xF, true);
    else r = __builtin_amdgcn_mov_dpp(xi, 0x141, 0xF, 0xF, true);
    return __builtin_bit_cast(float, r);
}
__device__ __forceinline__ float red8_dpp(float v) { v += dppf(v, 0); v += dppf(v, 1); v += dppf(v, 2); return v; }
__device__ __forceinline__ float red8(float v) { return red8_dpp(v); }
__device__ __forceinline__ float wave_sum(float v) {
    v = red8_dpp(v);
    v += __builtin_bit_cast(float, __builtin_amdgcn_mov_dpp(__builtin_bit_cast(int, v), 0x140, 0xF, 0xF, true));
    v += __builtin_bit_cast(float, __builtin_amdgcn_update_dpp(0, __builtin_bit_cast(int, v), 0x142, 0xA, 0xF, false));
    v += __builtin_bit_cast(float, __builtin_amdgcn_update_dpp(0, __builtin_bit_cast(int, v), 0x143, 0xC, 0xF, false));
    return __builtin_bit_cast(float, __builtin_amdgcn_readlane(__builtin_bit_cast(int, v), 63));
}

namespace pg8 {
#define PG8_LAS __attribute__((address_space(3)))
typedef unsigned short bf16_t;
typedef unsigned u32x4 __attribute__((ext_vector_type(4)));
constexpr int BM = 256, BK = 64, HALF = 128, HTB = HALF * BK * 2, STAGE_BYTES = 8 * HTB, NXCD = 8, WGM = 8;

__host__ __device__ __forceinline__ int lds_byte(int r, int c) { const int st = (r >> 4) * 2 + (c >> 5), rr = r & 15, cc = c & 31, ob = rr * 64 + cc * 2; return st * 1024 + (ob ^ (((ob >> 9) & 1) << 5)); }
__host__ __device__ __forceinline__ void stage_rc(int b, int& R, int& C) { const int st = b / 1024, sb = b % 1024, swz = sb ^ (((sb >> 9) & 1) << 5); R = (st >> 1) * 16 + swz / 64; C = (st & 1) * 32 + (swz % 64) / 2; }
__host__ __device__ __forceinline__ int perm32(int rho) { const int n = rho >> 4, i = rho & 15; return 8 * (i >> 2) + 4 * n + (i & 3); }

struct Unit { int pm, pn; const char* a; const char* b; };
struct Gemm { int lda, ldb, K; };

struct TileOrder {
    int nM, nN, nwg, G, c;
    __device__ __forceinline__ void init(int nM_, int nN_, int G_, int c_) { nM = nM_; nN = nN_; nwg = nM * nN; G = G_; c = c_; }
    __device__ __forceinline__ bool tile(int i, int& pm, int& pn) const {
        const long L = (long)i * G + c; if (L >= nwg) return false;
        int wgid = (int)L; { const int q = nwg / NXCD, r = nwg % NXCD, xcd = wgid % NXCD, off = wgid / NXCD; wgid = (xcd < r ? xcd * (q + 1) : r * (q + 1) + (xcd - r) * q) + off; }
        const int nig = WGM * nN, gid = wgid / nig, fm = gid * WGM, gsz = (nM - fm) < WGM ? (nM - fm) : WGM;
        pm = fm + ((wgid % nig) % gsz); pn = (wgid % nig) / gsz; return true;
    }
};

__device__ __forceinline__ unsigned cvt_pk_bf16(float lo, float hi) { unsigned r; asm volatile("v_cvt_pk_bf16_f32 %0, %1, %2" : "=v"(r) : "v"(lo), "v"(hi)); return r; }

template <class Epi, class Sched, bool FP8 = false, bool ALIGN_EPI = true>
__device__ __forceinline__ void gemm_phase(PG8_LAS unsigned char* lds, const Gemm g, const Sched& S, const Epi& E, int wave_id) {
    int tid_ = wave_id * 64 + lane_id(); asm volatile("" : "+v"(tid_));
    const int tid = tid_, wid = __builtin_amdgcn_readfirstlane(tid >> 6), lane = tid & 63, wr = wid >> 2, wc = wid & 3, fr = lane & 15, fq = lane >> 4;
    int K_ = g.K; asm volatile("" : "+s"(K_));
    const int K = K_, nt = K / BK;
    unsigned voffA[2], voffB[2];
#pragma unroll
    for (int i = 0; i < 2; ++i) { int R, C; stage_rc(tid * 16 + i * 8192, R, C); const int Rb = Epi::PERM ? ((R & ~31) + perm32(R & 31)) : R;
        voffA[i] = (unsigned)(R * g.lda + C) * 2u; voffB[i] = (unsigned)(Rb * g.ldb + C) * 2u; }
    const size_t kstep = (size_t)(BK * 2);
    const size_t hstepA = (size_t)HALF * g.lda * 2, hstepB = (size_t)HALF * g.ldb * 2;
    const unsigned ldsw = (unsigned)wid * 1024u;
    const int aoff = lds_byte(wr * 64 + fr, fq * 8), boff = lds_byte(wc * 32 + fr, fq * 8);
#define PG8_SA(b, h) (((b) * 2 + (h)) * HTB)
#define PG8_SB(b, h) ((4 + (b) * 2 + (h)) * HTB)
#define PG8_STAGE(bufoff, gbase, voff) do { _Pragma("unroll") for (int _i = 0; _i < 2; ++_i) \
        __builtin_amdgcn_global_load_lds((const unsigned*)((const char*)(gbase) + (voff)[_i]), (PG8_LAS unsigned*)(lds + (bufoff) + ldsw + _i * 8192), 16, 0, 0); } while (0)
#define PG8_LDA(dst, b, h) do { _Pragma("unroll") for (int m = 0; m < 4; ++m) _Pragma("unroll") for (int k = 0; k < 2; ++k) dst[m][k] = *(const PG8_LAS bf16x8*)(lds + PG8_SA(b, h) + aoff + m * 2048 + k * 1024); } while (0)
#define PG8_LDB(dst, b, h) do { _Pragma("unroll") for (int n = 0; n < 2; ++n) _Pragma("unroll") for (int k = 0; k < 2; ++k) dst[n][k] = *(const PG8_LAS bf16x8*)(lds + PG8_SB(b, h) + boff + n * 2048 + k * 1024); } while (0)
#define PG8_MMA(ai, bj, At, Bt) do { __builtin_amdgcn_s_setprio(1); _Pragma("unroll") for (int m = 0; m < 4; ++m) _Pragma("unroll") for (int n = 0; n < 2; ++n) { \
        if constexpr (FP8) { typedef int v8i_ __attribute__((ext_vector_type(8))); typedef int v4i_ __attribute__((ext_vector_type(4))); \
            const v4i_ b0_ = __builtin_bit_cast(v4i_, Bt[n][0]), b1_ = __builtin_bit_cast(v4i_, Bt[n][1]), a0_ = __builtin_bit_cast(v4i_, At[m][0]), a1_ = __builtin_bit_cast(v4i_, At[m][1]); \
            const v8i_ bo_ = {b0_[0], b0_[1], b0_[2], b0_[3], b1_[0], b1_[1], b1_[2], b1_[3]}, ao_ = {a0_[0], a0_[1], a0_[2], a0_[3], a1_[0], a1_[1], a1_[2], a1_[3]}; \
            asm volatile("v_mfma_scale_f32_16x16x128_f8f6f4 %0, %1, %2, %0, %3, %4 op_sel_hi:[0,0,0]" : "+v"(acc[ai][bj][m][n]) : "v"(bo_), "v"(ao_), "v"(0x7A7A7A7A), "v"(0x7D7D7D7D)); }   \
        else { _Pragma("unroll") for (int k = 0; k < 2; ++k) acc[ai][bj][m][n] = __builtin_amdgcn_mfma_f32_16x16x32_bf16(Bt[n][k], At[m][k], acc[ai][bj][m][n], 0, 0, 0); } } \
        __builtin_amdgcn_s_setprio(0); } while (0)
#define PG8_WAIT_V(n) asm volatile("s_waitcnt vmcnt(" #n ")" ::: "memory")
#define PG8_WAIT_L(n) asm volatile("s_waitcnt lgkmcnt(" #n ")" ::: "memory")
#define PG8_BAR __builtin_amdgcn_s_barrier()
#define PG8_SCHED __builtin_amdgcn_sched_barrier(0)
    Unit cur, nxt; int ui = 0;
    if (!S.next(0, cur)) return;
    f32x4 acc[2][2][4][2];
#pragma unroll
    for (int a = 0; a < 2; ++a)
#pragma unroll
        for (int b = 0; b < 2; ++b)
#pragma unroll
            for (int m = 0; m < 4; ++m)
#pragma unroll
                for (int n = 0; n < 2; ++n) acc[a][b][m][n] = (f32x4){0.f, 0.f, 0.f, 0.f};
    bf16x8 At[4][2], B0[2][2], B1[2][2];
    const char* cA = cur.a; const char* cB = cur.b;
    PG8_STAGE(PG8_SB(0, 0), cB, voffB); PG8_STAGE(PG8_SB(0, 1), cB + hstepB, voffB); PG8_STAGE(PG8_SA(0, 0), cA, voffA); PG8_STAGE(PG8_SA(0, 1), cA + hstepA, voffA);
    if (wr == 1) PG8_BAR;
    PG8_WAIT_V(2); PG8_BAR;
    PG8_STAGE(PG8_SB(1, 0), cB + kstep, voffB); PG8_STAGE(PG8_SA(1, 0), cA + kstep, voffA); PG8_STAGE(PG8_SB(1, 1), cB + hstepB + kstep, voffB);
    PG8_WAIT_V(6); PG8_BAR;
    for (;;) {
        const bool has_next = S.next(ui + 1, nxt);
        const char* nA = has_next ? nxt.a : cA; const char* nB = has_next ? nxt.b : cB;
        for (int t = 0; t < nt; t += 2) {
            const bool last = (t == nt - 2);
            const char* a1 = cA + (size_t)(t + 1) * kstep;
            const char* a2 = last ? nA : cA + (size_t)(t + 2) * kstep; const char* b2 = last ? nB : cB + (size_t)(t + 2) * kstep;
            const char* a3 = a2 + kstep; const char* b3 = b2 + kstep;
            PG8_LDB(B0, 0, 0); PG8_LDB(B1, 0, 1); PG8_SCHED; PG8_LDA(At, 0, 0); PG8_STAGE(PG8_SA(1, 1), a1 + hstepA, voffA);
            PG8_WAIT_V(8); PG8_WAIT_L(0); PG8_BAR; PG8_MMA(0, 0, At, B0); PG8_MMA(0, 1, At, B1); PG8_BAR; PG8_SCHED;
            PG8_LDA(At, 0, 1); PG8_STAGE(PG8_SB(0, 0), b2, voffB); PG8_STAGE(PG8_SB(0, 1), b2 + hstepB, voffB); PG8_STAGE(PG8_SA(0, 0), a2, voffA);
            PG8_WAIT_V(8); PG8_WAIT_L(0); PG8_BAR; PG8_MMA(1, 0, At, B0); PG8_MMA(1, 1, At, B1); PG8_BAR; PG8_SCHED;
            PG8_LDB(B0, 1, 0); PG8_LDB(B1, 1, 1); PG8_SCHED; PG8_LDA(At, 1, 0); PG8_STAGE(PG8_SA(0, 1), a2 + hstepA, voffA);
            PG8_WAIT_V(8); PG8_WAIT_L(0); PG8_BAR; PG8_MMA(0, 0, At, B0); PG8_MMA(0, 1, At, B1); PG8_BAR; PG8_SCHED;
            PG8_LDA(At, 1, 1); PG8_STAGE(PG8_SB(1, 0), b3, voffB); PG8_STAGE(PG8_SB(1, 1), b3 + hstepB, voffB); PG8_STAGE(PG8_SA(1, 0), a3, voffA);
            PG8_WAIT_V(8); PG8_WAIT_L(0); PG8_BAR; PG8_MMA(1, 0, At, B0); PG8_MMA(1, 1, At, B1); PG8_BAR; PG8_SCHED;
        }
        if constexpr (ALIGN_EPI) { if (wr == 0) PG8_BAR; }
        if constexpr (FP8) asm volatile("s_nop 15\n\ts_nop 15" ::: "memory");
        E(acc, cur, wr, wc, fr, fq);
        if (!has_next) break;
#pragma unroll
        for (int a = 0; a < 2; ++a)
#pragma unroll
            for (int b = 0; b < 2; ++b)
#pragma unroll
                for (int m = 0; m < 4; ++m)
#pragma unroll
                    for (int n = 0; n < 2; ++n) acc[a][b][m][n] = (f32x4){0.f, 0.f, 0.f, 0.f};
        cur = nxt; cA = nA; cB = nB; ++ui;
        if constexpr (ALIGN_EPI) { if (wr == 1) PG8_BAR; }
    }
    PG8_WAIT_V(0);
    if constexpr (!ALIGN_EPI) { if (wr == 0) PG8_BAR; }
    PG8_BAR;
#undef PG8_SA
#undef PG8_SB
#undef PG8_STAGE
#undef PG8_LDA
#undef PG8_LDB
#undef PG8_MMA
#undef PG8_WAIT_V
#undef PG8_WAIT_L
#undef PG8_BAR
#undef PG8_SCHED
}

struct DenseSched {
    TileOrder to; const char* A; const char* Bt; size_t a_tile, b_tile; int acol_div; size_t acol_step;
    __device__ __forceinline__ bool next(int i, Unit& u) const {
        int pm, pn; if (!to.tile(i, pm, pn)) return false;
        u.pm = pm; u.pn = pn; u.a = A + (size_t)pm * a_tile + (size_t)(pn / acol_div) * acol_step; u.b = Bt + (size_t)pn * b_tile; return true;
    }
};
struct GroupSched {
    TileOrder to; const char* A; const char* Bt; size_t a_tile, b_tile, b_exp; int pe[9];
    __device__ __forceinline__ bool next(int i, Unit& u) const {
        int pm, pn; if (!to.tile(i, pm, pn)) return false;
        int e = 0;
#pragma unroll
        for (int j = 1; j < 8; ++j) e += (pm >= pe[j]) ? 1 : 0;
        u.pm = pm; u.pn = pn; u.a = A + (size_t)pm * a_tile; u.b = Bt + (size_t)e * b_exp + (size_t)pn * b_tile; return true;
    }
};

struct SingleSched {
    int pm, pn; const char* a; const char* b;
    __device__ __forceinline__ bool next(int i, Unit& u) const { if (i != 0) return false; u.pm = pm; u.pn = pn; u.a = a; u.b = b; return true; }
};
struct EpiBf16 {
    static constexpr bool PERM = true;
    bf16_t* O; int ldc;
    __device__ __forceinline__ void operator()(const f32x4 (&acc)[2][2][4][2], const Unit& u, int wr, int wc, int fr, int fq) const {
        const int row0 = u.pm * BM + wr * 64 + fr, col0 = u.pn * BM + wc * 32 + 8 * fq;
#pragma unroll
        for (int ai = 0; ai < 2; ++ai)
#pragma unroll
            for (int m = 0; m < 4; ++m) { bf16_t* rowp = O + (size_t)(row0 + ai * HALF + m * 16) * ldc + col0;
#pragma unroll
                for (int bj = 0; bj < 2; ++bj) { const f32x4 v0 = acc[ai][bj][m][0], v1 = acc[ai][bj][m][1];
                    u32x4 w; w.x = cvt_pk_bf16(v0[0], v0[1]); w.y = cvt_pk_bf16(v0[2], v0[3]); w.z = cvt_pk_bf16(v1[0], v1[1]); w.w = cvt_pk_bf16(v1[2], v1[3]);
                    *(u32x4*)(rowp + bj * HALF) = w; } }
    }
};
struct EpiGate {
    static constexpr bool PERM = true;
    bf16_t* O; const bf16_t* zg;
    __device__ __forceinline__ void operator()(const f32x4 (&acc)[2][2][4][2], const Unit& u, int wr, int wc, int fr, int fq) const {
        const int row0 = u.pm * BM + wr * 64 + fr, col0 = u.pn * BM + wc * 32 + 8 * fq;
#pragma unroll
        for (int ai = 0; ai < 2; ++ai) {
            u32x4 gz[4][2];
#pragma unroll
            for (int m = 0; m < 4; ++m)
#pragma unroll
                for (int bj = 0; bj < 2; ++bj) gz[m][bj] = *(const u32x4*)(zg + (size_t)(row0 + ai * HALF + m * 16) * NZ + col0 + bj * HALF);
            asm volatile("" ::: "memory"); __builtin_amdgcn_sched_barrier(0);
#pragma unroll
            for (int m = 0; m < 4; ++m) { const size_t row = (size_t)(row0 + ai * HALF + m * 16); bf16_t* rowp = O + row * 3072 + col0;
#pragma unroll
                for (int bj = 0; bj < 2; ++bj) { const f32x4 v0 = acc[ai][bj][m][0], v1 = acc[ai][bj][m][1];
                    float gq[8]; unpack8(gz[m][bj], gq);
                    u32x4 w; w.x = cvt_pk_bf16(v0[0] * sigmoidf_(gq[0]), v0[1] * sigmoidf_(gq[1])); w.y = cvt_pk_bf16(v0[2] * sigmoidf_(gq[2]), v0[3] * sigmoidf_(gq[3]));
                    w.z = cvt_pk_bf16(v1[0] * sigmoidf_(gq[4]), v1[1] * sigmoidf_(gq[5])); w.w = cvt_pk_bf16(v1[2] * sigmoidf_(gq[6]), v1[3] * sigmoidf_(gq[7]));
                    *(u32x4*)(rowp + bj * HALF) = w; } }
        }
    }
};
struct EpiLora {
    static constexpr bool PERM = true;
    bf16_t* O; const float* w0; const float* a0;
    __device__ __forceinline__ void operator()(const f32x4 (&acc)[2][2][4][2], const Unit& u, int wr, int wc, int fr, int fq) const {
        const int row0 = u.pm * BM + wr * 64 + fr, col0 = u.pn * BM + wc * 32 + 8 * fq;
        const int seg = u.pn >> 1;
        const float* bias = seg < 2 ? w0 + seg * 512 : a0 + (seg - 2) * 512;
        const int cc = col0 & 511;
        f32x4 bv[2][2];
#pragma unroll
        for (int bj = 0; bj < 2; ++bj) { bv[bj][0] = *(const f32x4*)(bias + cc + bj * HALF); bv[bj][1] = *(const f32x4*)(bias + cc + bj * HALF + 4); }
        asm volatile("" ::: "memory"); __builtin_amdgcn_sched_barrier(0);
#pragma unroll
        for (int ai = 0; ai < 2; ++ai)
#pragma unroll
            for (int m = 0; m < 4; ++m) { bf16_t* rowp = O + (size_t)(row0 + ai * HALF + m * 16) * NLORA + col0;
#pragma unroll
                for (int bj = 0; bj < 2; ++bj) { f32x4 v0 = acc[ai][bj][m][0], v1 = acc[ai][bj][m][1];
                    if (seg < 4) { const f32x4 b0 = bv[bj][0], b1 = bv[bj][1];
                        const float sc = seg < 2 ? -0.60653066f : 1.0f;
#pragma unroll
                        for (int j = 0; j < 4; ++j) { v0[j] = sc * sigmoidf_(v0[j] + b0[j]); v1[j] = sc * sigmoidf_(v1[j] + b1[j]); } }
                    u32x4 w; w.x = cvt_pk_bf16(v0[0], v0[1]); w.y = cvt_pk_bf16(v0[2], v0[3]); w.z = cvt_pk_bf16(v1[0], v1[1]); w.w = cvt_pk_bf16(v1[2], v1[3]);
                    *(u32x4*)(rowp + bj * HALF) = w; } }
    }
};
struct EpiSwiglu8 {
    static constexpr bool PERM = false;
    unsigned char* O;
    __device__ __forceinline__ void operator()(const f32x4 (&acc)[2][2][4][2], const Unit& u, int wr, int wc, int fr, int fq) const {
        const int row0 = u.pm * BM + wr * 64 + fr, col0 = u.pn * 128 + wc * 16 + 4 * fq;
#pragma unroll
        for (int ai = 0; ai < 2; ++ai)
#pragma unroll
            for (int m = 0; m < 4; ++m) { unsigned char* rowp = O + (size_t)(row0 + ai * HALF + m * 16) * DFF + col0;
#pragma unroll
                for (int bj = 0; bj < 2; ++bj) { const f32x4 a = acc[ai][bj][m][0], b = acc[ai][bj][m][1]; float o[4];
#pragma unroll
                    for (int j = 0; j < 4; ++j) o[j] = sat8(4.0f * a[j] * sigmoidf_(a[j]) * b[j]);
                    unsigned w = 0u; w = __builtin_amdgcn_cvt_pk_fp8_f32(o[0], o[1], w, false); w = __builtin_amdgcn_cvt_pk_fp8_f32(o[2], o[3], w, true);
                    *(unsigned*)(rowp + bj * 64) = w; } }
    }
};
struct EpiSwiglu {
    static constexpr bool PERM = false;
    bf16_t* O;
    __device__ __forceinline__ void operator()(const f32x4 (&acc)[2][2][4][2], const Unit& u, int wr, int wc, int fr, int fq) const {
        const int row0 = u.pm * BM + wr * 64 + fr, col0 = u.pn * 128 + wc * 16 + 4 * fq;
#pragma unroll
        for (int ai = 0; ai < 2; ++ai)
#pragma unroll
            for (int m = 0; m < 4; ++m) { bf16_t* rowp = O + (size_t)(row0 + ai * HALF + m * 16) * DFF + col0;
#pragma unroll
                for (int bj = 0; bj < 2; ++bj) { const f32x4 a = acc[ai][bj][m][0], b = acc[ai][bj][m][1]; float o[4];
#pragma unroll
                    for (int j = 0; j < 4; ++j) o[j] = a[j] * sigmoidf_(a[j]) * b[j];
                    v2u w; w.x = cvt_pk_bf16(o[0], o[1]); w.y = cvt_pk_bf16(o[2], o[3]);
                    *(v2u*)(rowp + bj * 64) = w; } }
    }
};
}

#define XB_TMO      128
#define XB_XCNT(j)  (256  + 64 * (j))
#define XB_XSUB(j)  (1280 + 64 * (j))
#define XB_XGEN(j)  (2304 + 64 * (j))
#define XB_TOP      3328
#define XB_TOPGEN   3392
#define XCD_BAR_WORDS 3456
#define XB_SPIN_CAP (1u << 18)
__device__ __forceinline__ unsigned xb_ld(unsigned* p)              { return __hip_atomic_load(p, __ATOMIC_RELAXED, __HIP_MEMORY_SCOPE_AGENT); }
__device__ __forceinline__ unsigned xb_add(unsigned* p, unsigned v) { return __hip_atomic_fetch_add(p, v, __ATOMIC_RELAXED, __HIP_MEMORY_SCOPE_AGENT); }
__device__ __forceinline__ unsigned xb_xcc_id() { return (unsigned)__builtin_amdgcn_s_getreg((3 << 11) | 20) & 0xFu; }
#define XB_SPIN(cond, bar) do { unsigned _sp = 0; while (cond) { __builtin_amdgcn_s_sleep(1); \
    if ((++_sp & 255u) == 0u) { if (xb_ld(&(bar)[XB_TMO])) break; if (_sp > XB_SPIN_CAP) { atomicAdd(&(bar)[XB_TMO], 1u); break; } } } } while (0)
struct XcdBarrier { unsigned* bar; unsigned x; volatile LAS unsigned* st; };
__device__ __forceinline__ XcdBarrier xcd_barrier_post(unsigned* bar, volatile LAS unsigned* st) {
    XcdBarrier b; b.bar = bar; b.x = xb_xcc_id(); b.st = st;
    if (threadIdx.x == 0) (void)xb_add(&bar[XB_XCNT(b.x)], 1u);
    return b;
}
__device__ __forceinline__ void xcd_barrier_complete(unsigned* bar, unsigned x, unsigned& nloc, unsigned& nx) {
    const unsigned G = gridDim.x * gridDim.y * gridDim.z;
    unsigned sum, cnt, mine, sp = 0u;
    for (;;) {
        sum = 0u; cnt = 0u; mine = 0u;
#pragma unroll
        for (unsigned j = 0; j < 16; ++j) { const unsigned c = xb_ld(&bar[XB_XCNT(j)]); sum += c; cnt += (c > 0u) ? 1u : 0u; mine = (j == x) ? c : mine; }
        if (sum == G) break;
        __builtin_amdgcn_s_sleep(1);
        if ((++sp & 255u) == 0u) { if (xb_ld(&bar[XB_TMO])) break; if (sp > XB_SPIN_CAP) { atomicAdd(&bar[XB_TMO], 1u); break; } }
    }
    nloc = mine > 0u ? mine : 1u; nx = cnt > 0u ? cnt : 1u;
}
__device__ __forceinline__ void xcd_barrier(const XcdBarrier& b, int wave_id) {
    asm volatile("s_waitcnt vmcnt(0)" ::: "memory");
    __syncthreads();
    if (wave_id == 0 && lane_id() == 0) {
        unsigned* bar = b.bar;
        __builtin_amdgcn_s_waitcnt(0);
        unsigned nloc = b.st[0], nx = b.st[1];
        if (nloc == 0u) { xcd_barrier_complete(bar, b.x, nloc, nx); b.st[0] = nloc; b.st[1] = nx; }
        const unsigned old = xb_add(&bar[XB_XSUB(b.x)], 1u);
        const unsigned gen = old / nloc;
        if (old + 1u == (gen + 1u) * nloc) {
            __builtin_amdgcn_fence(__ATOMIC_RELEASE, "agent");
            asm volatile("s_waitcnt vmcnt(0)" ::: "memory");
            const unsigned og = xb_add(&bar[XB_TOP], 1u);
            const unsigned tg = og / nx;
            asm volatile("buffer_inv sc1" ::: "memory");
            if (og + 1u == (tg + 1u) * nx) xb_add(&bar[XB_TOPGEN], 1u);
            else XB_SPIN(xb_ld(&bar[XB_TOPGEN]) == tg, bar);
            xb_add(&bar[XB_XGEN(b.x)], 1u);
            asm volatile("s_waitcnt vmcnt(0)" ::: "memory");
        } else {
            asm volatile("buffer_inv sc1" ::: "memory");
            XB_SPIN(xb_ld(&bar[XB_XGEN(b.x)]) == gen, bar);
            asm volatile("s_waitcnt vmcnt(0)" ::: "memory");
        }
    }
    __syncthreads();
}

struct Args { const float* in[34]; float* out; unsigned char* ws; int ph_lo, ph_hi; };
typedef const __attribute__((address_space(4))) Args* KArgs;
#define KIN(ka, i) ((const float*)(const GAS float*)(ka)->in[i])
__device__ __forceinline__ KArgs kargs() { KArgs p = (KArgs)__builtin_amdgcn_kernarg_segment_ptr(); asm volatile("" : "+s"(p)); return p; }
enum { I_X = 0, I_C, I_CTX, I_CCTX, I_WMOD, I_BMOD, I_NMG, I_NFG, I_WIN, I_POOLW, I_POOLS, I_SHMU, I_DW0, I_DW2, I_A0, I_A2, I_KKK, I_KKA, I_BONUS, I_GNG, I_GNB, I_GG2,
       I_QNG, I_KNG, I_RPB, I_WBR, I_WOUT, I_F1, I_F3, I_F2, I_ROUTER, I_M1, I_M3, I_M2 };

struct Frame {
    LAS unsigned char* lds;
    unsigned char* ws;
    int tid, lane, wave, vcu, G;
};
__device__ __forceinline__ void frame_refresh(Frame& F) {
    int w_ = __builtin_amdgcn_readfirstlane(F.wave); asm volatile("" : "+s"(w_));
    int t = w_ * 64 + lane_id(); asm volatile("" : "+v"(t));
    F.tid = t; F.lane = t & 63; F.wave = w_;
    unsigned long long w = (unsigned long long)F.ws; { const unsigned lo_ = __builtin_amdgcn_readfirstlane((unsigned)w), hi_ = __builtin_amdgcn_readfirstlane((unsigned)(w >> 32)); w = ((unsigned long long)hi_ << 32) | lo_; }
    asm volatile("" : "+s"(w)); F.ws = (unsigned char*)(GAS unsigned char*)w;
}

struct MapPlain { int off; __device__ __forceinline__ int operator()(int n) const { return n + off; } };
struct MapWin { __device__ __forceinline__ int operator()(int n) const { return n < 2272 ? n : n + 32; } };
struct MapF13 { int add; __device__ __forceinline__ int operator()(int n) const { return 32 * (n >> 4) + (n & 15) + add; } };
template <class RowMap>
__device__ __forceinline__ void tr_item(const float* W, int ldw, int k0, int n0, bf16* WT, int ldt, const RowMap rm, LAS float* scr, int lane) {
    float tv[32];
#pragma unroll
    for (int i = 0; i < 32; ++i) { const int kk = 2 * i + (lane >> 5); tv[i] = W[(size_t)(k0 + kk) * ldw + n0 + (lane & 31)]; }
#pragma unroll
    for (int i = 0; i < 32; ++i) { const int kk = 2 * i + (lane >> 5); scr[kk * 33 + (lane & 31)] = tv[i]; }
    LDS_WAIT(); asm volatile("" ::: "memory");
    const int c = lane & 7;
#pragma unroll
    for (int j = 0; j < 4; ++j) { const int n = (lane >> 3) + 8 * j; const LAS float* s = scr + (8 * c) * 33 + n;
        v4u o; o.x = pk2(s[0 * 33], s[1 * 33]); o.y = pk2(s[2 * 33], s[3 * 33]); o.z = pk2(s[4 * 33], s[5 * 33]); o.w = pk2(s[6 * 33], s[7 * 33]);
        *(GAS v4u*)(WT + (size_t)rm(n0 + n) * ldt + k0 + 8 * c) = o; }
    LDS_WAIT(); asm volatile("" ::: "memory");
}


template <class RowMap>
__device__ __forceinline__ void tr_item8(const float* W, int ldw, int k0, int n0, unsigned char* WT, int ldt, const RowMap rm, LAS float* scr, int lane) {
    float tv[32];
#pragma unroll
    for (int i = 0; i < 32; ++i) { const int kk = 2 * i + (lane >> 5); tv[i] = W[(size_t)(k0 + kk) * ldw + n0 + (lane & 31)]; }
#pragma unroll
    for (int i = 0; i < 32; ++i) { const int kk = 2 * i + (lane >> 5); scr[kk * 33 + (lane & 31)] = tv[i]; }
    LDS_WAIT(); asm volatile("" ::: "memory");
    const int c = lane & 3;
#pragma unroll
    for (int j = 0; j < 2; ++j) { const int n = (lane >> 2) + 16 * j; const LAS float* s = scr + (16 * c) * 33 + n; unsigned w[4];
#pragma unroll
        for (int q = 0; q < 4; ++q) { unsigned x = 0u; x = __builtin_amdgcn_cvt_pk_fp8_f32(sat8(32.f * s[(4 * q) * 33]), sat8(32.f * s[(4 * q + 1) * 33]), x, false); x = __builtin_amdgcn_cvt_pk_fp8_f32(sat8(32.f * s[(4 * q + 2) * 33]), sat8(32.f * s[(4 * q + 3) * 33]), x, true); w[q] = x; }
        *(GAS v4u*)(WT + (size_t)rm(n0 + n) * ldt + k0 + 16 * c) = (v4u){w[0], w[1], w[2], w[3]}; }
    LDS_WAIT(); asm volatile("" ::: "memory");
}
__device__ __forceinline__ void moe_convert(Frame& F, const Args& args, int j) {
    frame_refresh(F); KArgs KA = kargs();
    unsigned char* ws = F.ws;
    const int gw = F.vcu * 8 + F.wave, NGW = F.G * 8, lane = F.lane;
    LAS float* scr = (LAS float*)(F.lds + F.wave * 16384);
    constexpr int IT_F13 = 16 * 88, IT_F2 = 44 * 32, H0 = 16 * IT_F13, H1 = H0 + 8 * IT_F2;
    for (int it = gw; it < H1; it += NGW) {
        if (it < H0) { const int job = it / IT_F13, r = it % IT_F13, kb = r / 88, nb = r % 88; const int e = job >> 1, w3 = job & 1;
            tr_item8(KIN(KA, w3 ? I_M3 : I_M1) + (size_t)(j * NEXP + e) * D * DFF, DFF, kb * 64, nb * 32, ws + WS_MW13 + (size_t)e * NF1 * D, D, MapF13{w3 * 16}, scr, lane); }
        else { const int q = it - H0, e = q / IT_F2, r = q % IT_F2, kb = r / 32, nb = r % 32;
            tr_item8(KIN(KA, I_M2) + (size_t)(j * NEXP + e) * DFF * D, D, kb * 64, nb * 32, ws + WS_MW2 + (size_t)e * D * DFF, DFF, MapPlain{0}, scr, lane); }
    }
}

__device__ __forceinline__ void p0_prologue(Frame& F, const Args& args) {
    frame_refresh(F); KArgs KA = kargs();
    unsigned char* ws = F.ws;
    const int gw = F.vcu * 8 + F.wave, NGW = F.G * 8, lane = F.lane;
    {
        LAS float* scr = (LAS float*)(F.lds + F.wave * 16384);
        constexpr int IT_WIN = 16 * 199, IT_BR = 8 * 32, IT_OUT = 16 * 32, IT_F13 = 16 * 88, IT_F2 = 44 * 32;
        constexpr int G0 = 4 * IT_WIN, G1 = G0 + 12 * IT_BR, G2 = G1 + 4 * IT_OUT, G3 = G2 + 4 * IT_F13, G4 = G3 + 2 * IT_F2;
        for (int it = gw; it < G4; it += NGW) {
            if (it < G0) { const int job = it / IT_WIN, r = it % IT_WIN, kb = r / 199, nb = r % 199;
                if (nb < 103) tr_item(KIN(KA, I_WIN) + (size_t)job * D * IN_TOTAL, IN_TOTAL, kb * 64, 512 + nb * 32, (bf16*)(ws + WS_WIN) + (size_t)job * NZB * D, D, MapWin{}, scr, lane);
                else tr_item8(KIN(KA, I_WIN) + (size_t)job * D * IN_TOTAL, IN_TOTAL, kb * 64, 512 + nb * 32, ws + WS_WING8 + (size_t)job * NZG * D, D, MapPlain{-3808}, scr, lane); }
            else if (it < G1) { const int q = it - G0, job = q / IT_BR, r = q % IT_BR, kb = r / 32, nb = r % 32;
                const int l = job / 3, n = job % 3;
                tr_item(KIN(KA, I_WBR) + (size_t)job * 512 * D, D, kb * 64, nb * 32, (bf16*)(ws + WS_WBR) + (size_t)l * 3072 * 512, 512, MapPlain{n * 1024}, scr, lane); }
            else if (it < G2) { const int q = it - G1, job = q / IT_OUT, r = q % IT_OUT, kb = r / 32, nb = r % 32;
                tr_item(KIN(KA, I_WOUT) + (size_t)job * D * D, D, kb * 64, nb * 32, (bf16*)(ws + WS_WOUT) + (size_t)job * D * D, D, MapPlain{0}, scr, lane); }
            else if (it < G3) { const int q = it - G2, job = q / IT_F13, r = q % IT_F13, kb = r / 88, nb = r % 88;
                const int j = job >> 1, w3 = job & 1;
                tr_item(KIN(KA, w3 ? I_F3 : I_F1) + (size_t)j * D * DFF, DFF, kb * 64, nb * 32, (bf16*)(ws + WS_W13) + (size_t)j * NF1 * D, D, MapF13{w3 * 16}, scr, lane); }
            else { const int q = it - G3, job = q / IT_F2, r = q % IT_F2, kb = r / 32, nb = r % 32;
                tr_item(KIN(KA, I_F2) + (size_t)job * DFF * D, D, kb * 64, nb * 32, (bf16*)(ws + WS_W2) + (size_t)job * D * DFF, DFF, MapPlain{0}, scr, lane); }
        }
    }
    moe_convert(F, args, 0);
    for (int u = F.vcu; u < DEPTH * D; u += F.G) {
        const int l = u >> 10, k = u & 1023, gd = F.tid, g = gd >> 7, d = gd & 127;
        const float* wi = KIN(KA, I_WIN) + ((size_t)l * D + k) * IN_TOTAL + g * 128;
        const float* pw = KIN(KA, I_POOLW) + ((size_t)(l * 4 + g) * 128) * 128 + d;
        float s = 0.f;
#pragma unroll 8
        for (int c = 0; c < 128; ++c) s += wi[c] * pw[(size_t)c * 128];
        s *= KIN(KA, I_POOLS)[l * 512 + gd];
        ((bf16*)(ws + WS_WIN))[((size_t)l * NZB + gd) * D + k] = (bf16)f2bf(s);
    }
    for (size_t i = (size_t)blockIdx.x * 512 + F.tid; i < (size_t)DEPTH * NLORA * KLORA; i += (size_t)F.G * 512) {
        const int kk = (int)(i & 255), n = (int)((i >> 8) % NLORA), l = (int)(i / ((size_t)NLORA * KLORA));
        const int seg = n >> 9, c = n & 511; float v = 0.f;
        if (seg < 2) { if ((kk >> 5) == seg) v = KIN(KA, I_DW2)[(((size_t)l * 2 + seg) * 32 + (kk & 31)) * 512 + c]; }
        else if (seg < 4) { if ((kk >> 5) == seg) v = KIN(KA, I_A2)[(((size_t)l * 2 + (seg - 2)) * 32 + (kk & 31)) * 512 + c]; }
        else { if (kk >= 128 && kk < 224) v = KIN(KA, I_GG2)[((size_t)l * 96 + (kk - 128)) * 512 + c]; }
        ((bf16*)(ws + WS_WLORA))[i] = (bf16)f2bf(v);
    }
    {
        __syncthreads();
        LAS float* sc = (LAS float*)F.lds;
        LAS float* red = (LAS float*)(F.lds + 16384);
        for (int i = F.tid; i < 3 * D; i += 512) { const int s = i >> 10, k = i & 1023; const float c = s < 2 ? KIN(KA, I_C)[s * D + k] : KIN(KA, I_CCTX)[k]; sc[i] = c * sigmoidf_(c); }
        __syncthreads();
        const int kq = F.tid >> 6, nl = F.tid & 63;
        for (int u = F.vcu; u < DEPTH * 96; u += F.G) {
            const int l = u / 96, n = (u % 96) * 64 + nl;
            const float* wm = KIN(KA, I_WMOD) + (size_t)l * D * 6 * D + n;
            float s0 = 0.f, s1 = 0.f, s2 = 0.f;
#pragma unroll 32
            for (int k = kq * 128; k < kq * 128 + 128; ++k) { const float w = wm[(size_t)k * 6 * D]; s0 += sc[k] * w; s1 += sc[D + k] * w; s2 += sc[2 * D + k] * w; }
            red[(kq * 64 + nl) * 3 + 0] = s0; red[(kq * 64 + nl) * 3 + 1] = s1; red[(kq * 64 + nl) * 3 + 2] = s2;
            __syncthreads();
            if (F.tid < 192) { const int s = F.tid >> 6; float a = KIN(KA, I_BMOD)[l * 6 * D + n];
#pragma unroll
                for (int q = 0; q < 8; ++q) a += red[(q * 64 + nl) * 3 + s];
                ((float*)(ws + WS_MOD))[((size_t)l * 3 + s) * 6 * D + n] = a; }
            __syncthreads();
        }
    }
}

__device__ __forceinline__ void norm_phase(Frame& F, const Args& args, const float* xlat_in, const float* xctx_in, int ymode, const float* gate_mod  ,
                                           const float* gn, const float* sc_mod, const float* sh_mod, bool moe_route, const float* router, int moe_j, int rblk, int rnb, int rbase, int rcount  ,
                                           unsigned char* hb8 = nullptr  ,
                                           int rbase2 = 0, int rcount2 = 0, int ymode2 = 0, unsigned* wcnt = nullptr, unsigned wneed = 0  ) {
    frame_refresh(F); KArgs KA = kargs();
    unsigned char* ws = F.ws;
    const int gw = rblk * 8 + F.wave, NGW = rnb * 8, lane = F.lane;
    float* xs_lat = ((float*)(GAS float*)KA->out); float* xs_ctx = (float*)(ws + WS_XSC);
    bf16* HB = (bf16*)(ws + WS_HB); const bf16* Y = (const bf16*)(ws + WS_Y); const bf16* Y2 = (const bf16*)(ws + WS_Y2); const bf16* YP = (const bf16*)(ws + WS_ARENA + AR_YP);
    unsigned* RT = (unsigned*)(ws + WS_RT);
    LAS float* rl = (LAS float*)F.lds;
    LAS unsigned* lcnt = (LAS unsigned*)(F.lds + 32768);
    if (moe_route) {
        __syncthreads();
        for (int i = F.tid; i < D * 8; i += 512) rl[i] = router[i];
        if (F.tid < 8) lcnt[F.tid] = 0u;
        __syncthreads();
    }
    struct NormIn { f32x4 x[4]; v2u ya[4], yb[4]; float w0, w1; unsigned r0, r1; };
#define NORM_RT(mm, R) do { R.w0 = 0.f; R.w1 = 0.f; R.r0 = 0u; R.r1 = 0u; \
        if (ymode == 2) { const v4u rt = *(const v4u*)(RT + (size_t)(mm) * 8); const v4u rt2 = *(const v4u*)(RT + (size_t)(mm) * 8 + 4); R.w0 = __uint_as_float(rt.z); R.w1 = __uint_as_float(rt.w); R.r0 = rt2.x; R.r1 = rt2.y; } } while (0)
#define NORM_LOAD(mm, R) do { const bool lat_ = (mm) < MLAT; const float* xin_ = lat_ ? xlat_in + (size_t)(mm) * D : xctx_in + (size_t)((mm) - MLAT) * D; \
        _Pragma("unroll") for (int j = 0; j < 4; ++j) { const int col = 4 * lane + 256 * j; R.x[j] = *(const f32x4*)(xin_ + col); R.ya[j] = (v2u){0u, 0u}; R.yb[j] = (v2u){0u, 0u}; \
            if (ymode == 1 || ymode == 3) R.ya[j] = *(const v2u*)(Y + (size_t)(mm) * D + col); \
            if (ymode == 3) R.yb[j] = *(const v2u*)(Y2 + (size_t)((mm) - MLAT) * D + col);     \
            if (ymode == 2) { R.ya[j] = *(const v2u*)(YP + (size_t)R.r0 * D + col); R.yb[j] = *(const v2u*)(YP + (size_t)R.r1 * D + col); } } } while (0)
#define NORM_COMPUTE(mm, R) do { const int m = (mm); const bool lat = m < MLAT; const int srow = lat ? (m >> 13) : 2; \
        float* xo = lat ? xs_lat + (size_t)m * D : xs_ctx + (size_t)(m - MLAT) * D; \
        f32x4 v[4]; float ss = 0.f; \
        _Pragma("unroll") for (int j = 0; j < 4; ++j) { const int col = 4 * lane + 256 * j; v[j] = R.x[j]; \
            if (ymode != 0) { f32x4 yv; const v2u ya = R.ya[j], yb = R.yb[j]; \
                if (ymode == 1) yv = (f32x4){bflo(ya.x), bfhi(ya.x), bflo(ya.y), bfhi(ya.y)}; \
                else if (ymode == 3) yv = (f32x4){bflo(ya.x) + bflo(yb.x), bfhi(ya.x) + bfhi(yb.x), bflo(ya.y) + bflo(yb.y), bfhi(ya.y) + bfhi(yb.y)}; \
                else yv = (f32x4){R.w0 * bflo(ya.x) + R.w1 * bflo(yb.x), R.w0 * bfhi(ya.x) + R.w1 * bfhi(yb.x), R.w0 * bflo(ya.y) + R.w1 * bflo(yb.y), R.w0 * bfhi(ya.y) + R.w1 * bfhi(yb.y)}; \
                const f32x4 gt = *(const f32x4*)(gate_mod + (size_t)srow * 6 * D + col); v[j] = v[j] + gt * yv; } \
            *(f32x4*)(xo + col) = v[j]; ss += (v[j].x * v[j].x + v[j].y * v[j].y) + (v[j].z * v[j].z + v[j].w * v[j].w); } \
        const float rinv = 1.0f / sqrtf(wave_sum(ss) * (1.f / D) + 1e-6f); \
        float lg[8]; _Pragma("unroll") for (int e = 0; e < 8; ++e) lg[e] = 0.f; \
        _Pragma("unroll") for (int j = 0; j < 4; ++j) { const int col = 4 * lane + 256 * j; \
            const f32x4 g4 = *(const f32x4*)(gn + col), s4 = *(const f32x4*)(sc_mod + (size_t)srow * 6 * D + col), h4 = *(const f32x4*)(sh_mod + (size_t)srow * 6 * D + col); \
            const f32x4 h = v[j] * rinv * g4 * (s4 + 1.0f) + h4; \
            if (moe_route) { unsigned w8 = 0u; w8 = __builtin_amdgcn_cvt_pk_fp8_f32(sat8(4.f * h.x), sat8(4.f * h.y), w8, false); w8 = __builtin_amdgcn_cvt_pk_fp8_f32(sat8(4.f * h.z), sat8(4.f * h.w), w8, true); \
                *(unsigned*)((unsigned char*)HB + (size_t)m * D + col) = w8; }     \
            else { v2u o; o.x = pk2(h.x, h.y); o.y = pk2(h.z, h.w); *(v2u*)(HB + (size_t)m * D + col) = o; \
                if (hb8) { unsigned w8 = 0u; w8 = __builtin_amdgcn_cvt_pk_fp8_f32(sat8(4.f * h.x), sat8(4.f * h.y), w8, false); w8 = __builtin_amdgcn_cvt_pk_fp8_f32(sat8(4.f * h.z), sat8(4.f * h.w), w8, true); \
                    *(unsigned*)(hb8 + (size_t)m * D + col) = w8; } } \
            if (moe_route) { _Pragma("unroll") for (int q = 0; q < 4; ++q) { const f32x4 ra = *(const LAS f32x4*)(rl + (col + q) * 8), rb = *(const LAS f32x4*)(rl + (col + q) * 8 + 4); const float hv = h[q]; \
                lg[0] += hv * ra.x; lg[1] += hv * ra.y; lg[2] += hv * ra.z; lg[3] += hv * ra.w; lg[4] += hv * rb.x; lg[5] += hv * rb.y; lg[6] += hv * rb.z; lg[7] += hv * rb.w; } } } \
        if (moe_route) { _Pragma("unroll") for (int e = 0; e < 8; ++e) lg[e] = wave_sum(lg[e]); \
            int i0 = 0; float b0 = lg[0]; _Pragma("unroll") for (int e = 1; e < 8; ++e) if (lg[e] > b0) { b0 = lg[e]; i0 = e; } \
            int i1 = -1; float b1 = -3.0e38f; _Pragma("unroll") for (int e = 0; e < 8; ++e) if (e != i0 && lg[e] > b1) { b1 = lg[e]; i1 = e; } \
            const float p0 = 1.0f / (1.0f + __expf(b1 - b0)), p1 = 1.0f - p0; \
            if (lane == 0) { const unsigned q0 = __hip_atomic_fetch_add(&lcnt[i0], 1u, __ATOMIC_RELAXED, __HIP_MEMORY_SCOPE_WORKGROUP), q1 = __hip_atomic_fetch_add(&lcnt[i1], 1u, __ATOMIC_RELAXED, __HIP_MEMORY_SCOPE_WORKGROUP); \
                v4u a; a.x = (unsigned)i0; a.y = (unsigned)i1; a.z = __builtin_bit_cast(unsigned, p0); a.w = __builtin_bit_cast(unsigned, p1); v4u b; b.x = q0; b.y = q1; b.z = (unsigned)F.vcu; b.w = 0u;     \
                *(v4u*)(RT + (size_t)m * 8) = a; *(v4u*)(RT + (size_t)m * 8 + 4) = b; } } } while (0)
#pragma unroll 1
    for (int pass = 0; pass < (rcount2 > 0 ? 2 : 1); ++pass) {
    if (pass == 1) {
        rbase = rbase2; rcount = rcount2; ymode = ymode2;
        if (F.tid == 0) { unsigned sp = 0; while ((__hip_atomic_load(wcnt, RLX_AGENT) < wneed || __hip_atomic_load(wcnt + 64, RLX_AGENT) < wneed) && ++sp < (1u << 21)) __builtin_amdgcn_s_sleep(2);
            __builtin_amdgcn_fence(__ATOMIC_ACQUIRE, "agent"); asm volatile("s_waitcnt vmcnt(0)" ::: "memory"); }
        __syncthreads(); }
    for (int i0 = gw; i0 < rcount; i0 += 4 * NGW) {
        const int m0 = rbase + i0, m1 = m0 + NGW, m2 = m1 + NGW, m3 = m2 + NGW; const bool h1 = i0 + NGW < rcount, h2 = i0 + 2 * NGW < rcount, h3 = i0 + 3 * NGW < rcount;
        NormIn RA, RB, RC, RD;
        NORM_RT(m0, RA); if (h1) NORM_RT(m1, RB); if (h2) NORM_RT(m2, RC); if (h3) NORM_RT(m3, RD);
        NORM_LOAD(m0, RA); if (h1) NORM_LOAD(m1, RB); if (h2) NORM_LOAD(m2, RC); if (h3) NORM_LOAD(m3, RD);
        NORM_COMPUTE(m0, RA);
        if (h1) NORM_COMPUTE(m1, RB);
        if (h2) NORM_COMPUTE(m2, RC);
        if (h3) NORM_COMPUTE(m3, RD);
    }
    }
#undef NORM_RT
#undef NORM_LOAD
#undef NORM_COMPUTE
    if (moe_route) {
        __syncthreads();
        if (F.tid < 8) { unsigned* ctl = (unsigned*)(ws + WS_CTL);
            const unsigned base = __hip_atomic_fetch_add(ctl + CW_MOE + moe_j * 64 + F.tid, lcnt[F.tid], RLX_AGENT);
            ctl[CW_BB + (moe_j * 256 + F.vcu) * 8 + F.tid] = base; }
    }
}

__device__ __forceinline__ void moe_prefix(const unsigned* cnt, int (&pe)[9]) {
    pe[0] = 0;
#pragma unroll
    for (int e = 0; e < 8; ++e) pe[e + 1] = pe[e] + (int)((cnt[e] + 255u) >> 8);
}
__device__ __forceinline__ void moe_perm_phase(Frame& F, int moe_j, int mrows) {
    frame_refresh(F);
    unsigned char* ws = F.ws;
    const int gw = F.vcu * 8 + F.wave, NGW = F.G * 8, lane = F.lane;
    const unsigned* ctl = (const unsigned*)(ws + WS_CTL);
    unsigned cnt[8];
#pragma unroll
    for (int e = 0; e < 8; ++e) cnt[e] = ctl[CW_MOE + moe_j * 64 + e];
    int pe[9]; moe_prefix(cnt, pe);
    unsigned* RT = (unsigned*)(ws + WS_RT); const unsigned char* HB = ws + WS_HB; unsigned char* HP = ws + WS_ARENA + AR_HP;
    for (int m = gw; m < mrows; m += NGW) {
        const v4u a = *(const v4u*)(RT + (size_t)m * 8); const v4u b = *(const v4u*)(RT + (size_t)m * 8 + 4);
        const int blk = (int)b.z;
        const int e0 = (int)a.x, e1 = (int)a.y;
        int p0 = 0, p1 = 0;
#pragma unroll
        for (int e = 0; e < 8; ++e) { if (e == e0) p0 = pe[e] * 256; if (e == e1) p1 = pe[e] * 256; }
        p0 += (int)ctl[CW_BB + (moe_j * 256 + blk) * 8 + e0] + (int)b.x;
        p1 += (int)ctl[CW_BB + (moe_j * 256 + blk) * 8 + e1] + (int)b.y;
        const v4u* src = (const v4u*)(HB + (size_t)m * D);
        v4u* d0 = (v4u*)(HP + (size_t)p0 * D); v4u* d1 = (v4u*)(HP + (size_t)p1 * D);
        const v4u x0 = src[lane];
        d0[lane] = x0; d1[lane] = x0;
        if (lane == 0) { v4u nb; nb.x = (unsigned)p0; nb.y = (unsigned)p1; nb.z = 0u; nb.w = 0u; *(v4u*)(RT + (size_t)m * 8 + 4) = nb; }
    }
}

__device__ __forceinline__ f32x4 mfma16(const v4u a, const v4u b, const f32x4 c) {
    return __builtin_amdgcn_mfma_f32_16x16x32_bf16(__builtin_bit_cast(bf16x8, a), __builtin_bit_cast(bf16x8, b), c, 0, 0, 0);
}
constexpr int PREP_LA_OFF = 67584, PREP_LA_PITCH = 528;
__device__ __forceinline__ void seq_of_row(int m, int& seq0, int& t, int& Tn) {
    if (m < MLAT) { seq0 = m & ~(T - 1); t = m & (T - 1); Tn = T; } else { const int mc = m - MLAT; seq0 = MLAT + (mc & ~(CL - 1)); t = mc & (CL - 1); Tn = CL; }
}
struct Sh8 { v4u c, p, n; bool hp, hn; };
__device__ __forceinline__ void sh8_load(Sh8& s, const bf16* Z, int m, int t, int Tn, int col) {
    s.hp = t > 0; s.hn = t < Tn - 1;
    s.c = *(const v4u*)(Z + (size_t)m * NZ + col); s.p = *(const v4u*)(Z + (size_t)(s.hp ? m - 1 : m) * NZ + col); s.n = *(const v4u*)(Z + (size_t)(s.hn ? m + 1 : m) * NZ + col);
}
__device__ __forceinline__ void sh8_eval(const Sh8& s, const float* mup, const float* mun, float (&o)[8]) {
    float c[8], p[8], n[8]; unpack8(s.c, c); unpack8(s.p, p); unpack8(s.n, n);
    const f32x4 mp0 = *(const f32x4*)mup, mp1 = *(const f32x4*)(mup + 4), mn0 = *(const f32x4*)mun, mn1 = *(const f32x4*)(mun + 4);
#pragma unroll
    for (int j = 0; j < 8; ++j) { const float a = j < 4 ? mp0[j & 3] : mp1[j & 3], b = j < 4 ? mn0[j & 3] : mn1[j & 3]; const float pj = s.hp ? p[j] : 0.f, nj = s.hn ? n[j] : 0.f; o[j] = c[j] + a * (pj - c[j]) + b * (nj - c[j]); }
}
__device__ __forceinline__ void prep_phase(Frame& F, const Args& args, int l) {
    frame_refresh(F); KArgs KA = kargs();
    unsigned char* ws = F.ws;
    const int gw = F.vcu * 8 + F.wave, NGW = F.G * 8, lane = F.lane;
    const bf16* Z = (const bf16*)(ws + WS_ARENA + AR_Z);
    bf16* BR = (bf16*)(ws + WS_ARENA + AR_BR); float* KINV = (float*)(ws + WS_KINV);
    const int row0 = F.vcu * (M / 256);
    static_assert(M % 256 == 0 && M / 256 == 66, "rows per workgroup");
    bf16* QN = (bf16*)(ws + WS_Y); bf16* KN = QN + (size_t)M * 512;
    const float* mu0 = KIN(KA, I_SHMU) + (size_t)l * 2 * 1760; const float* mu1 = mu0 + 1760;
    const float* kkw = KIN(KA, I_KKK) + l * 512; const float* qng = KIN(KA, I_QNG) + l * 64; const float* kng = KIN(KA, I_KNG) + l * 64;
    const int mbeg = (int)(((long)gw * M) / NGW), mend = (int)(((long)(gw + 1) * M) / NGW);
    float S[8];
#pragma unroll
    for (int j = 0; j < 8; ++j) S[j] = 0.f;
    for (int m = mbeg; m < mend; ++m) {
        int seq0, t, Tn; seq_of_row(m, seq0, t, Tn);
        const int g = lane >> 4, half = 1 << g; const int lo = t - half < 0 ? 0 : t - half, hi = t + half > Tn ? Tn : t + half;
        const bool ent = t + half < Tn, lev = t - half >= 0;
        const v4u zc = *(const v4u*)(Z + (size_t)(seq0 + t) * NZ + ZP + lane * 8);
        const v4u ze = *(const v4u*)(Z + (size_t)(seq0 + (ent ? t + half : t)) * NZ + ZP + lane * 8), zl = *(const v4u*)(Z + (size_t)(seq0 + (lev ? t - half : t)) * NZ + ZP + lane * 8);
        Sh8 sk, sl; sh8_load(sk, Z, m, t, Tn, ZK + lane * 8); sh8_load(sl, Z, m, t, Tn, ZWLO + (lane < 28 ? lane : 0) * 8);
        const v4u zq = *(const v4u*)(Z + (size_t)m * NZ + ZQ + lane * 8), zk = *(const v4u*)(Z + (size_t)m * NZ + ZNK + lane * 8);
        if (m == mbeg || t == 0) {
            v4u ptap[16];
#pragma unroll
            for (int o = -8; o < 8; ++o) { const int s_ = t + o; const bool in = s_ >= lo && s_ < hi; ptap[o + 8] = *(const v4u*)(Z + (size_t)(seq0 + (in ? s_ : t)) * NZ + ZP + lane * 8); }
#pragma unroll
            for (int j = 0; j < 8; ++j) S[j] = 0.f;
#pragma unroll
            for (int o = -8; o < 8; ++o) { const int s_ = t + o; const float wgt = (s_ >= lo && s_ < hi) ? 1.f : 0.f; float q[8]; unpack8(ptap[o + 8], q);
#pragma unroll
                for (int j = 0; j < 8; ++j) S[j] += wgt * q[j]; }
        }
        asm volatile("" ::: "memory"); __builtin_amdgcn_sched_barrier(0);
        { float q[8], qe[8], ql[8], acc[8]; unpack8(zc, q); unpack8(ze, qe); unpack8(zl, ql);
          const float inv = 1.0f / (float)(hi - lo), we = ent ? 1.f : 0.f, wl = lev ? 1.f : 0.f;
#pragma unroll
          for (int j = 0; j < 8; ++j) { acc[j] = S[j] * inv - q[j]; S[j] += we * qe[j] - wl * ql[j]; }
          *(v4u*)(BR + (size_t)m * 1536 + lane * 8) = pack8(acc); }
        { float ks[8]; sh8_eval(sk, mu0 + 512 + lane * 8, mu1 + 512 + lane * 8, ks);
          float ss = 0.f;
#pragma unroll
          for (int j = 0; j < 8; ++j) { const float q = ks[j] * kkw[lane * 8 + j]; ss += q * q; }
          ss = red8(ss);
          if ((lane & 7) == 0) KINV[(size_t)m * 8 + (lane >> 3)] = 1.0f / fmaxf(sqrtf(ss), 1e-12f); }
        if (lane < 32) { float o[8];
          if (lane < 28) { sh8_eval(sl, mu0 + 1536 + lane * 8, mu1 + 1536 + lane * 8, o);
#pragma unroll
              for (int j = 0; j < 8; ++j) { if (lane < 8) o[j] = tanhf(o[j]); else if (lane >= 16) o[j] = sigmoidf_(o[j]); } }
          else {
#pragma unroll
              for (int j = 0; j < 8; ++j) o[j] = 0.f; }
          *(LAS v4u*)(F.lds + PREP_LA_OFF + (m - row0) * PREP_LA_PITCH + lane * 16) = pack8(o); }
        { float q[8], k[8]; unpack8(zq, q); unpack8(zk, k); float sq = 0.f, sk2 = 0.f;
#pragma unroll
          for (int j = 0; j < 8; ++j) { sq += q[j] * q[j]; sk2 += k[j] * k[j]; }
          sq = red8(sq); sk2 = red8(sk2);
          const float rq = (0.125f * 1.4426950408889634f) / sqrtf(sq * (1.f / 64.f) + 1e-6f), rk = 1.0f / sqrtf(sk2 * (1.f / 64.f) + 1e-6f);
#pragma unroll
          for (int j = 0; j < 8; ++j) { q[j] = q[j] * rq * qng[(lane & 7) * 8 + j]; k[j] = k[j] * rk * kng[(lane & 7) * 8 + j]; }
          *(v4u*)(QN + (size_t)m * 512 + lane * 8) = pack8(q); *(v4u*)(KN + (size_t)m * 512 + lane * 8) = pack8(k); }
    }
    {
        { unsigned z_ = 0u; asm volatile("" : "+v"(z_));
          if (F.tid < 14 * 32) *(LAS v4u*)(F.lds + PREP_LA_OFF + (66 + F.tid / 32) * PREP_LA_PITCH + (F.tid & 31) * 16) = (v4u){z_, z_, z_, z_}; }
        __syncthreads();
        const bf16* WL = (const bf16*)(ws + WS_WLORA) + (size_t)l * NLORA * KLORA;
        const float* w0b = KIN(KA, I_DW0) + l * 1024; const float* a0b = KIN(KA, I_A0) + l * 1024;
        bf16* LO = (bf16*)(ws + WS_ARENA + AR_LO);
        const int fr = lane & 15, fq = lane >> 4;
        struct LoOps { v4u bfr[2][3]; float bias[8]; };
#define LO_LOAD(g_, OP) do { const int seg_ = (g_) >> 4, nbase_ = 32 * (g_), kbase_ = seg_ < 4 ? 32 * seg_ : 128, nks_ = seg_ < 4 ? 1 : 3; \
            _Pragma("unroll") for (int t = 0; t < 2; ++t) { const bf16* wp = WL + (size_t)(nbase_ + pg8::perm32(16 * t + fr)) * KLORA + kbase_ + 8 * fq; \
                _Pragma("unroll") for (int ks = 0; ks < 3; ++ks) OP.bfr[t][ks] = ks < nks_ ? *(const v4u*)(wp + 32 * ks) : (v4u){0u, 0u, 0u, 0u}; } \
            const int cc_ = (nbase_ & 511) + 8 * fq; \
            _Pragma("unroll") for (int j = 0; j < 8; ++j) OP.bias[j] = seg_ < 2 ? w0b[seg_ * 512 + cc_ + j] : (seg_ < 4 ? a0b[(seg_ - 2) * 512 + cc_ + j] : 0.f); } while (0)
#define LO_COMP(g_, OP) do { const int seg = (g_) >> 4, nbase = 32 * (g_), kbase = seg < 4 ? 32 * seg : 128, nks = seg < 4 ? 1 : 3;     \
            _Pragma("unroll 1") for (int mt = 0; mt < 5; ++mt) { \
                f32x4 a0_ = (f32x4){0.f, 0.f, 0.f, 0.f}, a1_ = (f32x4){0.f, 0.f, 0.f, 0.f}; \
                _Pragma("unroll") for (int ks = 0; ks < 3; ++ks) if (ks < nks) { const v4u af = *(const LAS v4u*)(F.lds + PREP_LA_OFF + (16 * mt + fr) * PREP_LA_PITCH + (kbase + 32 * ks + 8 * fq) * 2); \
                    a0_ = mfma16(OP.bfr[0][ks], af, a0_); a1_ = mfma16(OP.bfr[1][ks], af, a1_); } \
                float v[8] = {a0_[0], a0_[1], a0_[2], a0_[3], a1_[0], a1_[1], a1_[2], a1_[3]};     \
                if (seg < 4) { const float sc = seg < 2 ? -0.60653066f : 1.0f; \
                    _Pragma("unroll") for (int j = 0; j < 8; ++j) v[j] = sc * sigmoidf_(v[j] + OP.bias[j]); } \
                const int r = 16 * mt + fr; \
                if (r < M / 256) *(v4u*)(LO + (size_t)(row0 + r) * NLORA + nbase + 8 * fq) = pack8(v); } } while (0)
        LoOps PA, PB;
        LO_LOAD(F.wave, PA);
#pragma unroll 1
        for (int g = F.wave; g < NLORA / 32; g += 16) {
            LO_LOAD(g + 8, PB);
            LO_COMP(g, PA);
            if (g + 16 < NLORA / 32) LO_LOAD(g + 16, PA);
            LO_COMP(g + 8, PB);
        }
#undef LO_LOAD
#undef LO_COMP
    }
    {
        bf16* VT = (bf16*)(ws + WS_ARENA + AR_VT); bf16* VTC = VT + (size_t)NB * 8 * 64 * T;
        LAS unsigned char* tile = F.lds;
        for (int u = F.vcu; u < M / 64; u += F.G) {
            const int m0 = u * 64;
            __syncthreads();
#pragma unroll
            for (int i = 0; i < 8; ++i) { const int id = F.tid + 512 * i, row = id >> 6, ch = id & 63;
                *(LAS v4u*)(tile + row * 1040 + ch * 16) = *(const v4u*)(Z + (size_t)(m0 + row) * NZ + ZNV + ch * 8); }
            __syncthreads();
            const int c = F.tid, h = c >> 6, dim = c & 63;
            bf16* dst; if (m0 < MLAT) { const int b = m0 >> 13, t0 = m0 & (T - 1); dst = VT + ((size_t)(b * 8 + h) * 64 + dim) * T + t0; }
            else { const int mc = m0 - MLAT, b = mc >> 8, t0 = mc & (CL - 1); dst = VTC + ((size_t)(b * 8 + h) * 64 + dim) * CL + t0; }
#pragma unroll
            for (int tg = 0; tg < 8; ++tg) { unsigned short e[8];
#pragma unroll
                for (int j = 0; j < 8; ++j) e[j] = *(const LAS unsigned short*)(tile + (tg * 8 + j) * 1040 + c * 2);
                v4u o; o.x = e[0] | ((unsigned)e[1] << 16); o.y = e[2] | ((unsigned)e[3] << 16); o.z = e[4] | ((unsigned)e[5] << 16); o.w = e[6] | ((unsigned)e[7] << 16);
                *(v4u*)(dst + tg * 8) = o; }
        }
        __syncthreads();
    }
}

#define WAVE_LDS_SYNC() do { asm volatile("s_waitcnt lgkmcnt(0)" ::: "memory"); __builtin_amdgcn_wave_barrier(); asm volatile("" ::: "memory"); } while (0)
constexpr int SP_MID0 = 264, SP_NMID = 16;
__device__ __forceinline__ void scanpre_phase(Frame& F, const Args& args, int l, int mid) {
    frame_refresh(F); KArgs KA = kargs();
    unsigned char* ws = F.ws;
    const int gw = F.vcu * 8 + F.wave, NGW = F.G * 8, lane = F.lane, fr = lane & 15, fq = lane >> 4;
    const bf16* Z = (const bf16*)(ws + WS_ARENA + AR_Z); const bf16* LO = (const bf16*)(ws + WS_ARENA + AR_LO); const float* KINV = (const float*)(ws + WS_KINV);
    unsigned char* FR = ws + WS_FRAG; v2u* VFR = (v2u*)(ws + WS_HB);
    LAS unsigned char* wl = F.lds + F.wave * 16384;
    LAS unsigned char* XK = wl; LAS unsigned char* XR = wl + 2304; LAS unsigned char* XH = wl + 4608; LAS unsigned char* XA = wl + 6912;
    LAS unsigned char* VTt = wl + 9216; LAS unsigned char* KWT = wl + 11264; LAS unsigned char* AWT = wl + 13312;
    LAS float* At = (LAS float*)(wl + 15360);
    const float* mu0 = KIN(KA, I_SHMU) + (size_t)l * 2 * 1760; const float* mu1 = mu0 + 1760;
#define SP_DIR(DIRV, SH1, SH2, SH4, SH8, SHT, LOPTR, RECID) do { int ln__ = lane; asm volatile("" : "+v"(ln__)); const int tf = ln__ & 15, cq = ln__ >> 4, ch0 = h * 64 + cq * 16; \
        const int taud = (DIRV) ? 15 - tf : tf; \
        const v4u ldh_[2] = {*(const v4u*)((LOPTR) + ch0), *(const v4u*)((LOPTR) + ch0 + 8)}, avh_[2] = {*(const v4u*)((LOPTR) + 1024 + ch0), *(const v4u*)((LOPTR) + 1024 + ch0 + 8)};     \
        _Pragma("unroll") for (int hh = 0; hh < 2; ++hh) { unsigned xk[4], xr[4], xh[4], xa[4]; float ldv[8], avv[8]; unpack8(ldh_[hh], ldv); unpack8(avh_[hh], avv); \
            int zo = 0; asm volatile("" : "+v"(zo)); \
            const f32x4 ka0 = *(const f32x4*)(KIN(KA, I_KKA) + l * 512 + ch0 + hh * 8 + zo), ka1 = *(const f32x4*)(KIN(KA, I_KKA) + l * 512 + ch0 + hh * 8 + 4 + zo); \
            _Pragma("unroll") for (int j = 0; j < 8; ++j) { const int c = hh * 8 + j; \
                float Lc = ldv[j];     \
                Lc += __builtin_bit_cast(float, __builtin_amdgcn_update_dpp(0, __builtin_bit_cast(int, Lc), SH1, 0xF, 0xF, true)); \
                Lc += __builtin_bit_cast(float, __builtin_amdgcn_update_dpp(0, __builtin_bit_cast(int, Lc), SH2, 0xF, 0xF, true)); \
                Lc += __builtin_bit_cast(float, __builtin_amdgcn_update_dpp(0, __builtin_bit_cast(int, Lc), SH4, 0xF, 0xF, true)); \
                Lc += __builtin_bit_cast(float, __builtin_amdgcn_update_dpp(0, __builtin_bit_cast(int, Lc), SH8, 0xF, 0xF, true)); \
                const float L15 = __builtin_bit_cast(float, __builtin_amdgcn_update_dpp(0, __builtin_bit_cast(int, Lc), SHT, 0xF, 0xF, true)); \
                const float kaw = j < 4 ? ka0[j & 3] : ka1[j & 3]; \
                const float rs_c = (c & 1) ? bfhi(rsp[c >> 1]) : bflo(rsp[c >> 1]), ks_c = (c & 1) ? bfhi(ksp[c >> 1]) : bflo(ksp[c >> 1]), vs_c = (c & 1) ? bfhi(vsp[c >> 1]) : bflo(vsp[c >> 1]), kk_c = (c & 1) ? bfhi(kkp[c >> 1]) : bflo(kkp[c >> 1]); \
                const float kd = ks_c * (1.0f + (avv[j] - 1.0f) * kaw), kka = avv[j] * kk_c; \
                const float eW = __expf(Lc), ePrev = __expf(Lc - ldv[j]), eInv = __expf(-Lc), eEnd = __expf(L15 - Lc); \
                const unsigned bk = f2bf(kk_c * ePrev), br = f2bf(rs_c * eW), bh = f2bf(kd * eInv), ba = f2bf(kka * eInv); \
                if (j & 1) { xk[j >> 1] |= bk << 16; xr[j >> 1] |= br << 16; xh[j >> 1] |= bh << 16; xa[j >> 1] |= ba << 16; } else { xk[j >> 1] = bk; xr[j >> 1] = br; xh[j >> 1] = bh; xa[j >> 1] = ba; } \
                *(LAS unsigned short*)(VTt + (cq * 16 + c) * 32 + taud * 2) = (unsigned short)f2bf(vs_c); \
                *(LAS unsigned short*)(KWT + (cq * 16 + c) * 32 + taud * 2) = (unsigned short)f2bf(kd * eEnd); \
                *(LAS unsigned short*)(AWT + (cq * 16 + c) * 32 + taud * 2) = (unsigned short)f2bf(-kka * eEnd); \
                if (taud == 15) *(float*)(FR + (size_t)(RECID) * REC_BYTES + RO_WC + (cq * 16 + c) * 4) = __expf(Lc); } \
            *(LAS v4u*)(XK + taud * 144 + cq * 32 + hh * 16) = (v4u){xk[0], xk[1], xk[2], xk[3]}; *(LAS v4u*)(XR + taud * 144 + cq * 32 + hh * 16) = (v4u){xr[0], xr[1], xr[2], xr[3]}; \
            *(LAS v4u*)(XH + taud * 144 + cq * 32 + hh * 16) = (v4u){xh[0], xh[1], xh[2], xh[3]}; *(LAS v4u*)(XA + taud * 144 + cq * 32 + hh * 16) = (v4u){xa[0], xa[1], xa[2], xa[3]}; \
            __builtin_amdgcn_sched_barrier(0); } } while (0)
#define SP_STAGE2(RECID) do { \
        WAVE_LDS_SYNC(); \
        int ln__ = lane; asm volatile("" : "+v"(ln__)); const int lane_ = ln__, fr = ln__ & 15, fq = ln__ >> 4;     \
        v4u kf[2], rf[2], hf[2], af[2]; \
        _Pragma("unroll") for (int s = 0; s < 2; ++s) { kf[s] = *(const LAS v4u*)(XK + fr * 144 + 64 * s + 16 * fq); rf[s] = *(const LAS v4u*)(XR + fr * 144 + 64 * s + 16 * fq); \
            hf[s] = *(const LAS v4u*)(XH + fr * 144 + 64 * s + 16 * fq); af[s] = *(const LAS v4u*)(XA + fr * 144 + 64 * s + 16 * fq); } \
        const f32x4 z4 = (f32x4){0.f, 0.f, 0.f, 0.f}; \
        f32x4 Akk = mfma16(hf[0], kf[0], z4); Akk = mfma16(hf[1], kf[1], Akk); \
        f32x4 Aka = mfma16(af[0], kf[0], z4); Aka = mfma16(af[1], kf[1], Aka); \
        f32x4 Ark = mfma16(hf[0], rf[0], z4); Ark = mfma16(hf[1], rf[1], Ark); \
        f32x4 Ara = mfma16(af[0], rf[0], z4); Ara = mfma16(af[1], rf[1], Ara); \
        _Pragma("unroll") for (int j = 0; j < 4; ++j) { const int tp = 4 * fq + j; const bool lt = tp < fr, le = tp <= fr; \
            Akk[j] = lt ? Akk[j] : 0.f; Aka[j] = lt ? Aka[j] : 0.f; Ark[j] = le ? Ark[j] : 0.f; Ara[j] = le ? Ara[j] : 0.f; \
            At[(4 * fq + j) * 16 + fr] = Aka[j]; } \
        WAVE_LDS_SYNC(); \
        float Tr[16]; \
        _Pragma("unroll") for (int s = 0; s < 16; ++s) Tr[s] = (s == fr) ? 1.f : 0.f; \
        _Pragma("unroll") for (int c = 14; c >= 0; --c) { float arow[16]; \
            _Pragma("unroll") for (int g = 0; g < 4; ++g) { const f32x4 a4 = *(const LAS f32x4*)(At + c * 16 + 4 * g); arow[4 * g] = a4.x; arow[4 * g + 1] = a4.y; arow[4 * g + 2] = a4.z; arow[4 * g + 3] = a4.w; } \
            float acc = 0.f; \
            _Pragma("unroll") for (int s = c + 1; s < 16; ++s) acc += Tr[s] * arow[s]; \
            Tr[c] = (c < fr) ? -acc : Tr[c]; \
            if ((c & 1) == 0) __builtin_amdgcn_sched_barrier(0); } \
        float T4[4]; \
        _Pragma("unroll") for (int j = 0; j < 4; ++j) T4[j] = fq == 0 ? Tr[j] : (fq == 1 ? Tr[4 + j] : (fq == 2 ? Tr[8 + j] : Tr[12 + j])); \
        unsigned char* rec = FR + (size_t)(RECID) * REC_BYTES; \
        _Pragma("unroll") for (int s = 0; s < 2; ++s) { \
            const v2u klo = *(const LAS v2u*)(XK + fr * 144 + (32 * s + 4 * fq) * 2), khi = *(const LAS v2u*)(XK + fr * 144 + (32 * s + 16 + 4 * fq) * 2); \
            const v2u rlo = *(const LAS v2u*)(XR + fr * 144 + (32 * s + 4 * fq) * 2), rhi = *(const LAS v2u*)(XR + fr * 144 + (32 * s + 16 + 4 * fq) * 2); \
            *(v4u*)(rec + RO_KT + s * 1024 + lane_ * 16) = (v4u){klo.x, klo.y, khi.x, khi.y}; \
            *(v4u*)(rec + RO_RT + s * 1024 + lane_ * 16) = (v4u){rlo.x, rlo.y, rhi.x, rhi.y}; } \
        _Pragma("unroll") for (int kt = 0; kt < 4; ++kt) { const v2u kwv = *(const LAS v2u*)(KWT + (16 * kt + fr) * 32 + 8 * fq), awv = *(const LAS v2u*)(AWT + (16 * kt + fr) * 32 + 8 * fq); \
            *(v4u*)(rec + RO_KA + kt * 1024 + lane_ * 16) = (v4u){kwv.x, kwv.y, awv.x, awv.y}; } \
        *(v4u*)(rec + RO_OA + lane_ * 16) = (v4u){pk2(Ark[0], Ark[1]), pk2(Ark[2], Ark[3]), pk2(-Ara[0], -Ara[1]), pk2(-Ara[2], -Ara[3])}; \
        *(v2u*)(rec + RO_AK + lane_ * 8) = (v2u){pk2(Akk[0], Akk[1]), pk2(Akk[2], Akk[3])}; \
        *(v2u*)(rec + RO_TT + lane_ * 8) = (v2u){pk2(T4[0], T4[1]), pk2(T4[2], T4[3])}; \
        _Pragma("unroll") for (int w = 0; w < 4; ++w) VFR[((size_t)(RECID) * 4 + w) * 64 + lane_] = *(const LAS v2u*)(VTt + (16 * w + fr) * 32 + 8 * fq); \
        WAVE_LDS_SYNC(); } while (0)
    int t0_ = gw, tstep = NGW, tend = 16 * (NCHUNK - SP_NMID);
    if (mid) { const int nw = ((int)blockIdx.x - 32) * 8 + F.wave; tstep = 1 << 20; tend = 16 * SP_NMID; t0_ = (nw % 7 == 0) ? nw / 7 : tend; }
    for (int tk = t0_; tk < tend; tk += tstep) {
        int bh, blk;
        if (mid) { bh = tk >> 4; blk = SP_MID0 + (tk & 15); } else { bh = tk >> 9; const int j_ = tk & 511; blk = j_ < SP_MID0 ? j_ : j_ + SP_NMID; }
        static_assert(NCHUNK - SP_NMID == 512, "task decode");
        const int h = bh & 7, b = bh >> 3;
        int m0, t0, Tn;
        if (blk < CL / 16) { t0 = 16 * blk; Tn = CL; m0 = MLAT + b * CL + t0; } else { t0 = 16 * (blk - CL / 16); Tn = T; m0 = b * T + t0; }
        const int recF = ((b << 4) | (h << 1) | 0) * NCHUNK + blk;
        const int recB = ((b << 4) | (h << 1) | 1) * NCHUNK + (blk < CL / 16 ? CL / 16 - 1 - blk : NCHUNK - 1 - (blk - CL / 16));
        int lnt_ = lane; asm volatile("" : "+v"(lnt_)); const int tf_ = lnt_ & 15, cq_ = lnt_ >> 4;
        const int fr = tf_, fq = cq_;
        const int tf = tf_, cq = cq_, ch0 = h * 64 + cq * 16;
        const int tt = t0 + tf; const int m = m0 + tf;
        const bool okP = tt > 0, okN = tt < Tn - 1;
        const bf16* zc = Z + (size_t)m * NZ + ch0; const bf16* zp = Z + (size_t)(okP ? m - 1 : m) * NZ + ch0; const bf16* zn = Z + (size_t)(okN ? m + 1 : m) * NZ + ch0;
        const float kinv = KINV[(size_t)m * 8 + h];
        unsigned rsp[8], ksp[8], vsp[8], kkp[8];
#pragma unroll
        for (int hh = 0; hh < 2; ++hh) {
            int zo = 0; asm volatile("" : "+v"(zo));
            v4u raw[3][3];
#pragma unroll
            for (int tn = 0; tn < 3; ++tn) { raw[tn][0] = *(const v4u*)(zc + ZR + tn * 512 + hh * 8 + zo); raw[tn][1] = *(const v4u*)(zp + ZR + tn * 512 + hh * 8 + zo); raw[tn][2] = *(const v4u*)(zn + ZR + tn * 512 + hh * 8 + zo); }
            const f32x4 kw0 = *(const f32x4*)(KIN(KA, I_KKK) + l * 512 + ch0 + hh * 8 + zo), kw1 = *(const f32x4*)(KIN(KA, I_KKK) + l * 512 + ch0 + hh * 8 + 4 + zo);
            float xs_[3][8];
#pragma unroll
            for (int tn = 0; tn < 3; ++tn) { float c[8], p[8], n[8]; unpack8(raw[tn][0], c); unpack8(raw[tn][1], p); unpack8(raw[tn][2], n);
                const f32x4 mp0 = *(const f32x4*)(mu0 + tn * 512 + ch0 + hh * 8 + zo), mp1 = *(const f32x4*)(mu0 + tn * 512 + ch0 + hh * 8 + 4 + zo), mn0 = *(const f32x4*)(mu1 + tn * 512 + ch0 + hh * 8 + zo), mn1 = *(const f32x4*)(mu1 + tn * 512 + ch0 + hh * 8 + 4 + zo);
#pragma unroll
                for (int j = 0; j < 8; ++j) { const float wp = j < 4 ? mp0[j & 3] : mp1[j & 3], wn = j < 4 ? mn0[j & 3] : mn1[j & 3]; const float pv = okP ? p[j] : 0.f, nv = okN ? n[j] : 0.f;
                    const float x = c[j] + wp * (pv - c[j]) + wn * (nv - c[j]);
                    xs_[tn][j] = x; } }
#pragma unroll
            for (int j = 0; j < 8; j += 2) { const int q = hh * 4 + (j >> 1);
                rsp[q] = pk2(xs_[0][j], xs_[0][j + 1]); ksp[q] = pk2(xs_[1][j], xs_[1][j + 1]); vsp[q] = pk2(xs_[2][j], xs_[2][j + 1]);
                kkp[q] = pk2(xs_[1][j] * (j < 4 ? kw0[j & 3] : kw1[j & 3]) * kinv, xs_[1][j + 1] * (j + 1 < 4 ? kw0[(j + 1) & 3] : kw1[(j + 1) & 3]) * kinv); }
            __builtin_amdgcn_sched_barrier(0);
        }
        SP_DIR(0, 0x111, 0x112, 0x114, 0x118, 0x15F, LO + (size_t)m * NLORA, recF);
        SP_STAGE2(recF);
        SP_DIR(1, 0x101, 0x102, 0x104, 0x108, 0x150, LO + (size_t)m * NLORA + 512, recB);
        SP_STAGE2(recB);
    }
#undef SP_DIR
#undef SP_STAGE2
}
struct ScanRec { v4u kt[2], rt[2], ka[4], oa; v2u ak, tt, v; f32x4 wc[4]; };
constexpr int SC_OROW = 136, SC_OTILE = 16 * SC_OROW;
__device__ __forceinline__ void scan_step(const ScanRec& R, f32x4 (&Hk)[4], f32x4& oprev, LAS unsigned short* otp  , bool wr) {
    const f32x4 z4 = (f32x4){0.f, 0.f, 0.f, 0.f};
    if (wr) {
#pragma unroll
        for (int j = 0; j < 4; ++j) otp[j * (SC_OROW / 2)] = (unsigned short)f2bf(oprev[j]);
    }
    const v4u Hb0 = (v4u){pk2(Hk[0][0], Hk[0][1]), pk2(Hk[0][2], Hk[0][3]), pk2(Hk[1][0], Hk[1][1]), pk2(Hk[1][2], Hk[1][3])};
    const v4u Hb1 = (v4u){pk2(Hk[2][0], Hk[2][1]), pk2(Hk[2][2], Hk[2][3]), pk2(Hk[3][0], Hk[3][1]), pk2(Hk[3][2], Hk[3][3])};
    f32x4 U = mfma16(R.kt[0], Hb0, z4); U = mfma16(R.kt[1], Hb1, U);
    U = mfma16((v4u){R.ak.x, R.ak.y, 0u, 0u}, (v4u){R.v.x, R.v.y, 0u, 0u}, U);
    const f32x4 sa = mfma16((v4u){R.tt.x, R.tt.y, 0u, 0u}, (v4u){pk2(U[0], U[1]), pk2(U[2], U[3]), 0u, 0u}, z4);
    const v4u VS = (v4u){R.v.x, R.v.y, pk2(sa[0], sa[1]), pk2(sa[2], sa[3])};
    f32x4 o = mfma16(R.rt[0], Hb0, z4); o = mfma16(R.rt[1], Hb1, o); o = mfma16(R.oa, VS, o);
#pragma unroll
    for (int kt = 0; kt < 4; ++kt) Hk[kt] = mfma16(R.ka[kt], VS, Hk[kt] * R.wc[kt]);
    oprev = o;
}
constexpr int SC_SLOT = 12544, SC_R = 10, SC_D = 8, SC_V0 = 10496;
static_assert(SC_R * SC_SLOT + 2 * SC_OTILE <= LDSCTL_OFF, "scan ring + output tiles");
__device__ __forceinline__ void scan_load_lds(ScanRec& R, const LAS unsigned char* slot, int w, int lane, int fq) {
    R.kt[0] = *(const LAS v4u*)(slot + RO_KT + lane * 16); R.kt[1] = *(const LAS v4u*)(slot + RO_KT + 1024 + lane * 16);
    R.rt[0] = *(const LAS v4u*)(slot + RO_RT + lane * 16); R.rt[1] = *(const LAS v4u*)(slot + RO_RT + 1024 + lane * 16);
#pragma unroll
    for (int kt = 0; kt < 4; ++kt) { R.ka[kt] = *(const LAS v4u*)(slot + RO_KA + kt * 1024 + lane * 16); R.wc[kt] = *(const LAS f32x4*)(slot + RO_WC + (16 * kt + 4 * fq) * 4); }
    R.oa = *(const LAS v4u*)(slot + RO_OA + lane * 16); R.ak = *(const LAS v2u*)(slot + RO_AK + lane * 8); R.tt = *(const LAS v2u*)(slot + RO_TT + lane * 8);
    R.v = *(const LAS v2u*)(slot + SC_V0 + w * 512 + lane * 8);
}
__device__ __forceinline__ void scan3_block(Frame& F, int chain, unsigned* spcnt  ) {
    unsigned char* ws = F.ws;
    const int lane = F.lane, fr = lane & 15, fq = lane >> 4, wave = F.wave;
    const int d = chain & 1, h = (chain >> 1) & 7, b = chain >> 4;
    const unsigned char* FR = ws + WS_FRAG + (size_t)chain * NCHUNK * REC_BYTES; const unsigned char* VF = ws + WS_HB + (size_t)chain * NCHUNK * 2048;
    LAS unsigned char* ring = F.lds;
    if (wave >= 6) {
        const int k = wave - 6, sgn = d ? -1 : 1;
        const long rbc = d ? (long)MLAT + b * CL + CL - 1 : (long)MLAT + b * CL, rbl = (d ? (long)b * T + T - 1 : (long)b * T) - (long)sgn * CL;
        bf16* OFBK = (bf16*)(ws + WS_ARENA + AR_OFB) + (size_t)d * M * 512 + h * 64 + 4 * fr + (long)sgn * (8 * k + fq) * 512;
        const LAS unsigned char* otrk = ring + SC_R * SC_SLOT + (8 * k + fq) * SC_OROW + fr * 8;
#define SC_FLUSHK(c_) do { const int c__ = (c_); const LAS unsigned char* tp_ = otrk + (c__ & 1) * SC_OTILE; const v2u ova_ = *(const LAS v2u*)tp_, ovb_ = *(const LAS v2u*)(tp_ + 4 * SC_OROW); \
        const long rb_ = (c__ < CL / 16 ? rbc : rbl) + (long)sgn * 16 * c__; *(v2u*)(OFBK + rb_ * 512) = ova_; *(v2u*)(OFBK + (rb_ + 4 * sgn) * 512) = ovb_; asm volatile("s_waitcnt lgkmcnt(0)" ::: "memory"); } while (0)
        __builtin_amdgcn_s_barrier();
        for (int c = 0; c < NCHUNK; ++c) {
            if (c >= 3) SC_FLUSHK(c - 3);
            __builtin_amdgcn_s_barrier();
        }
        SC_FLUSHK(NCHUNK - 3);
        __builtin_amdgcn_s_barrier();
        SC_FLUSHK(NCHUNK - 2);
        __builtin_amdgcn_s_barrier();
        SC_FLUSHK(NCHUNK - 1);
        asm volatile("s_waitcnt vmcnt(0)" ::: "memory");
#undef SC_FLUSHK
    } else if (wave >= 4) {
        const int k = wave - 4;
#define SC_DMA16(g_, l_) __builtin_amdgcn_global_load_lds((const unsigned*)((g_) + lane * 16), (LAS unsigned*)(l_), 16, 0, 2)
#define SC_ISSUE(cc, slotidx) do { const unsigned char* rec_ = FR + (size_t)(cc) * REC_BYTES; const unsigned char* vf_ = VF + (size_t)(cc) * 2048; LAS unsigned char* sb_ = ring + (slotidx) * SC_SLOT; \
        if (k == 0) { _Pragma("unroll") for (int p_ = 0; p_ < 7; ++p_) SC_DMA16(rec_ + p_ * 1024, sb_ + p_ * 1024); } \
        else { _Pragma("unroll") for (int p_ = 7; p_ < 10; ++p_) SC_DMA16(rec_ + p_ * 1024, sb_ + p_ * 1024); \
            __builtin_amdgcn_global_load_lds((const unsigned*)(rec_ + RO_WC + lane * 4), (LAS unsigned*)(sb_ + RO_WC), 4, 0, 2); SC_DMA16(vf_, sb_ + SC_V0); SC_DMA16(vf_ + 1024, sb_ + SC_V0 + 1024); } } while (0)
#define SC_WAIT() do { if (k == 0) asm volatile("s_waitcnt vmcnt(56)" ::: "memory"); else asm volatile("s_waitcnt vmcnt(48)" ::: "memory"); } while (0)
        for (int c = 0; c <= SC_D; ++c) SC_ISSUE(c, c);
        SC_WAIT();
        __builtin_amdgcn_s_barrier();
        for (int c = 0; c < NCHUNK; ++c) {
            const int cc = c + SC_D + 1, ccl = cc < NCHUNK ? cc : NCHUNK - 1;
            if (cc == SP_MID0) {
                unsigned sp_ = 0; while (__hip_atomic_load(spcnt, RLX_AGENT) < (unsigned)(16 * SP_NMID) && ++sp_ < (1u << 20)) __builtin_amdgcn_s_sleep(4);
                __builtin_amdgcn_fence(__ATOMIC_ACQUIRE, "agent"); }
            SC_ISSUE(ccl, cc % SC_R);
            SC_WAIT();
            __builtin_amdgcn_s_barrier();
        }
        __builtin_amdgcn_s_barrier();
        __builtin_amdgcn_s_barrier();
        asm volatile("s_waitcnt vmcnt(0)" ::: "memory");
#undef SC_ISSUE
#undef SC_WAIT
#undef SC_DMA16
    } else {
        const int w = wave;
        LAS unsigned char* otile = ring + SC_R * SC_SLOT;
        LAS unsigned short* otw = (LAS unsigned short*)(otile + (4 * fq) * SC_OROW + (16 * w + fr) * 2);
        f32x4 Hk[4];
#pragma unroll
        for (int kt = 0; kt < 4; ++kt) Hk[kt] = (f32x4){0.f, 0.f, 0.f, 0.f};
        ScanRec RA, RB;
        __builtin_amdgcn_s_barrier();
        scan_load_lds(RA, ring, w, lane, fq);
        f32x4 oprev = (f32x4){0.f, 0.f, 0.f, 0.f};
        for (int ch = 0; ch < NCHUNK; ch += 2) {
            asm volatile("s_waitcnt lgkmcnt(0)" ::: "memory"); __builtin_amdgcn_s_barrier();
            scan_load_lds(RB, ring + ((ch + 1) % SC_R) * SC_SLOT, w, lane, fq);
            scan_step(RA, Hk, oprev, otw + SC_OTILE / 2, ch > 0);
            asm volatile("s_waitcnt lgkmcnt(0)" ::: "memory"); __builtin_amdgcn_s_barrier();
            if (ch + 2 < NCHUNK) scan_load_lds(RA, ring + ((ch + 2) % SC_R) * SC_SLOT, w, lane, fq);
            scan_step(RB, Hk, oprev, otw, true);
        }
        asm volatile("s_waitcnt lgkmcnt(0)" ::: "memory"); __builtin_amdgcn_s_barrier();
#pragma unroll
        for (int j = 0; j < 4; ++j) (otw + SC_OTILE / 2)[j * (SC_OROW / 2)] = (unsigned short)f2bf(oprev[j]);
        asm volatile("s_waitcnt lgkmcnt(0)" ::: "memory"); __builtin_amdgcn_s_barrier();
    }
}

__device__ __forceinline__ void nat_phase(Frame& F, const Args& args, int l, int nblk, int NW, bool ctxq) {
    frame_refresh(F); KArgs KA = kargs(); const int nwave = nblk * 8 + F.wave;
    unsigned char* ws = F.ws;
    const int lane = F.lane, fr = lane & 15, fq = lane >> 4;
    const bf16* QN = (const bf16*)(ws + WS_Y); const bf16* KN = QN + (size_t)M * 512;
    const bf16* VT = (const bf16*)(ws + WS_ARENA + AR_VT); const bf16* VTC = VT + (size_t)NB * 8 * 64 * T;
    bf16* BR = (bf16*)(ws + WS_ARENA + AR_BR);
    LAS float* rpb = (LAS float*)F.lds;
    LAS unsigned* bmax = (LAS unsigned*)(F.lds + 16384);
    if (F.tid == 0) *bmax = 0u;
    __syncthreads();
    { float mb = 0.f; for (int i = F.tid; i < 8 * 15 * 32; i += 512) { const int rw = i >> 5, co = i & 31; float v = 0.f; if (co < 31) { v = KIN(KA, I_RPB)[(size_t)l * 8 * 15 * 31 + rw * 31 + co]; mb = fmaxf(mb, fabsf(v)); } rpb[i] = v; }
      __hip_atomic_fetch_max(bmax, __float_as_uint(mb), __ATOMIC_RELAXED, __HIP_MEMORY_SCOPE_WORKGROUP); }
    __syncthreads();
    float mfix2;
    { float gq = 0.f, gk = 0.f;
#pragma unroll 8
      for (int i = 0; i < 64; ++i) { gq = fmaxf(gq, fabsf(KIN(KA, I_QNG)[l * 64 + i])); gk = fmaxf(gk, fabsf(KIN(KA, I_KNG)[l * 64 + i])); }
      mfix2 = (1.03f * 8.0f * gq * gk + __uint_as_float(*bmax) + 0.25f) * 1.4426950408889634f; }
    for (int i = F.tid; i < 8 * 15 * 32; i += 512) rpb[i] = (i & 31) < 31 ? rpb[i] * 1.4426950408889634f - mfix2 : -__builtin_inff();
    __syncthreads();
    constexpr int NWX = (256 - 32);
    const int xcd = (int)blockIdx.x & 7, wx = (nblk >> 3) * 8 + F.wave;
    {
        unsigned sink = 0u;
#pragma unroll 1
        for (int pp = 0; pp < 2; ++pp) { const int pair = 2 * xcd + pp, hh = pair & 7, bb = pair >> 3;
            const bf16* vt0 = VT + (size_t)(bb * 8 + hh) * 64 * T; const bf16* vc0 = VTC + (size_t)(bb * 8 + hh) * 64 * CL;
#pragma unroll 1
            for (int i = wx * 64 + lane; i < T + CL; i += NWX * 64) {
                const size_t row = i < T ? (size_t)bb * T + i : (size_t)MLAT + bb * CL + (i - T);
                sink ^= *(const unsigned*)(KN + row * 512 + hh * 64);
                sink ^= *(const unsigned*)(i < T ? vt0 + (size_t)i * 64 : vc0 + (size_t)(i - T) * 64); } }
        asm volatile("" :: "v"(sink));
    }
    constexpr int NLT = 512, NCT = 16;
    for (int task = wx; task < NLT + (ctxq ? NCT : 0); task += NWX) {
        const bool isl = task < NLT;
        int gp, h, r, b, rs = 0, cb0 = 0; int qm[2];
        unsigned boff[2][3][4];
        if (isl) { const int pair = 2 * xcd + (task >> 8); gp = task & 1; r = (task >> 1) & 127; h = pair & 7; b = pair >> 3;
            rs = r - 4 < 0 ? 0 : (r - 4 > GROWS - 8 ? GROWS - 8 : r - 4); cb0 = gp;
            const unsigned rowbase = (unsigned)((h * 15 + (rs - r + 7)) * 128);
#pragma unroll
            for (int t = 0; t < 2; ++t) { const int g = 2 * gp + t, c = 16 * g + fr, cs = c - 8 < 0 ? 0 : (c - 8 > 48 ? 48 : c - 8); qm[t] = b * T + r * 64 + c;
#pragma unroll
                for (int br = 0; br < 3; ++br)
#pragma unroll
                    for (int j = 0; j < 4; ++j) { const int kc = (cb0 + br) * 16 + 4 * fq + j; const bool ok = (unsigned)(kc - cs) < 16u; boff[t][br][j] = rowbase + (unsigned)(ok ? (kc - c + 15) * 4 : 31 * 4); } } }
        else { const int q = task - NLT, pair = 2 * xcd + (q >> 3); gp = q & 7; h = pair & 7; b = pair >> 3; r = 0;
#pragma unroll
            for (int t = 0; t < 2; ++t) { qm[t] = MLAT + b * CL + 16 * (2 * gp + t) + fr;
#pragma unroll
                for (int br = 0; br < 3; ++br)
#pragma unroll
                    for (int j = 0; j < 4; ++j) boff[t][br][j] = 0u; } }
        v4u q0[2], q1[2];
#pragma unroll
        for (int t = 0; t < 2; ++t) { q0[t] = *(const v4u*)(QN + (size_t)qm[t] * 512 + h * 64 + 8 * fq); q1[t] = *(const v4u*)(QN + (size_t)qm[t] * 512 + h * 64 + 32 + 8 * fq); }
        float lpart[2] = {0.f, 0.f};
        f32x4 O[2][4];
#pragma unroll
        for (int t = 0; t < 2; ++t)
#pragma unroll
            for (int dt = 0; dt < 4; ++dt) O[t][dt] = (f32x4){0.f, 0.f, 0.f, 0.f};
        const bf16* vt_lat = VT + ((size_t)(b * 8 + h) * 64 + fr) * T;
        const bf16* vt_ctx = VTC + ((size_t)(b * 8 + h) * 64 + fr) * CL;
        struct NatOps { v4u ka0, ka1, kb0, kb1; v2u va[4], vb[4]; };
#define NAT_LOAD(ks_, OP) do { const int ks__ = (ks_); const bool loc_ = isl && ks__ < 12; int tokA_, tokB_; const bf16* vA_; const bf16* vB_; size_t vst_; \
            if (loc_) { const int br_ = ks__ >> 2, i_ = ks__ & 3; const int ta_ = (rs + 2 * i_) * 64 + (cb0 + br_) * 16, tb_ = ta_ + 64; \
                tokA_ = b * T + ta_; tokB_ = b * T + tb_; vA_ = vt_lat + ta_ + 4 * fq; vB_ = vt_lat + tb_ + 4 * fq; vst_ = (size_t)16 * T; } \
            else { const int kc_ = isl ? ks__ - 12 : ks__; const int ta_ = 32 * kc_, tb_ = 32 * kc_ + 16; \
                tokA_ = MLAT + b * CL + ta_; tokB_ = MLAT + b * CL + tb_; vA_ = vt_ctx + ta_ + 4 * fq; vB_ = vt_ctx + tb_ + 4 * fq; vst_ = (size_t)16 * CL; } \
            const bf16* ka_ = KN + (size_t)(tokA_ + fr) * 512 + h * 64 + 8 * fq; const bf16* kb_ = KN + (size_t)(tokB_ + fr) * 512 + h * 64 + 8 * fq; \
            OP.ka0 = *(const v4u*)ka_; OP.ka1 = *(const v4u*)(ka_ + 32); OP.kb0 = *(const v4u*)kb_; OP.kb1 = *(const v4u*)(kb_ + 32); \
            _Pragma("unroll") for (int dt = 0; dt < 4; ++dt) { OP.va[dt] = *(const v2u*)(vA_ + dt * vst_); OP.vb[dt] = *(const v2u*)(vB_ + dt * vst_); } } while (0)
#define NAT_COMPUTE(LOCAL, br_, i_, OP) do { \
            _Pragma("unroll") for (int t = 0; t < 2; ++t) { \
                f32x4 sA = mfma16(OP.ka0, q0[t], (f32x4){0.f, 0.f, 0.f, 0.f}); sA = mfma16(OP.ka1, q1[t], sA); \
                f32x4 sB = mfma16(OP.kb0, q0[t], (f32x4){0.f, 0.f, 0.f, 0.f}); sB = mfma16(OP.kb1, q1[t], sB); \
                float ps = 0.f; f32x4 pA, pB; \
                if (LOCAL) { const unsigned ra_ = (unsigned)(2 * (i_)) * 128u; \
                    _Pragma("unroll") for (int j = 0; j < 4; ++j) { const LAS unsigned char* bp_ = (const LAS unsigned char*)rpb + (boff[t][br_][j] + ra_); \
                        pA[j] = __builtin_amdgcn_exp2f(sA[j] + *(const LAS float*)bp_); pB[j] = __builtin_amdgcn_exp2f(sB[j] + *(const LAS float*)(bp_ + 128)); ps += pA[j] + pB[j]; } } \
                else { _Pragma("unroll") for (int j = 0; j < 4; ++j) { pA[j] = __builtin_amdgcn_exp2f(sA[j] - mfix2); pB[j] = __builtin_amdgcn_exp2f(sB[j] - mfix2); ps += pA[j] + pB[j]; } } \
                lpart[t] += ps; \
                v4u pf; pf.x = pk2(pA[0], pA[1]); pf.y = pk2(pA[2], pA[3]); pf.z = pk2(pB[0], pB[1]); pf.w = pk2(pB[2], pB[3]); \
                _Pragma("unroll") for (int dt = 0; dt < 4; ++dt) { v4u vf; vf.x = OP.va[dt].x; vf.y = OP.va[dt].y; vf.z = OP.vb[dt].x; vf.w = OP.vb[dt].y; \
                    O[t][dt] = mfma16(vf, pf, O[t][dt]); } } } while (0)
        NatOps PA, PB;
        NAT_LOAD(0, PA);
        if (isl) {
#pragma unroll
            for (int br = 0; br < 3; ++br) {
#pragma unroll 1
                for (int i = 0; i < 4; i += 2) { const int ks = 4 * br + i;
                    NAT_LOAD(ks + 1, PB);
                    NAT_COMPUTE(true, br, i, PA);
                    NAT_LOAD(ks + 2, PA);
                    NAT_COMPUTE(true, br, i + 1, PB); } }
        }
        { const int k0 = isl ? 12 : 0;
#pragma unroll 1
          for (int kc = 0; kc < 8; kc += 2) {
              NAT_LOAD(k0 + kc + 1, PB);
              NAT_COMPUTE(false, 0, 0, PA);
              if (kc + 2 < 8) NAT_LOAD(k0 + kc + 2, PA);
              NAT_COMPUTE(false, 0, 0, PB); } }
#undef NAT_LOAD
#undef NAT_COMPUTE
#pragma unroll
        for (int t = 0; t < 2; ++t) {
            float lsum = lpart[t];
            lsum += __builtin_bit_cast(float, __builtin_amdgcn_ds_bpermute((lane ^ 16) << 2, __builtin_bit_cast(int, lsum)));
            lsum += __builtin_bit_cast(float, __builtin_amdgcn_ds_bpermute((lane ^ 32) << 2, __builtin_bit_cast(int, lsum)));
            const float inv = 1.0f / lsum;
#pragma unroll
            for (int dt = 0; dt < 4; ++dt) { v2u o; o.x = pk2(O[t][dt][0] * inv, O[t][dt][1] * inv); o.y = pk2(O[t][dt][2] * inv, O[t][dt][3] * inv);
                *(v2u*)(BR + (size_t)qm[t] * 1536 + 1024 + h * 64 + 16 * dt + 4 * fq) = o; } }
    }
}

__device__ __forceinline__ void readout_phase(Frame& F, const Args& args, int l, int mrows) {
    frame_refresh(F); KArgs KA = kargs();
    unsigned char* ws = F.ws;
    const int gw = F.vcu * 8 + F.wave, NGW = F.G * 8, lane = F.lane;
    const bf16* Z = (const bf16*)(ws + WS_ARENA + AR_Z); const bf16* LO = (const bf16*)(ws + WS_ARENA + AR_LO);
    const bf16* O0 = (const bf16*)(ws + WS_ARENA + AR_OFB); const bf16* O1 = O0 + (size_t)M * 512;
    bf16* BR = (bf16*)(ws + WS_ARENA + AR_BR);
    const float* mu0 = KIN(KA, I_SHMU) + (size_t)l * 2 * 1760; const float* mu1 = mu0 + 1760;
    const int ch = lane * 8;
    float kaw[8], brk[8], gg[8], gb[8];
#pragma unroll
    for (int j = 0; j < 8; ++j) { kaw[j] = KIN(KA, I_KKA)[l * 512 + ch + j]; brk[j] = KIN(KA, I_BONUS)[l * 512 + ch + j]; gg[j] = KIN(KA, I_GNG)[l * 512 + ch + j]; gb[j] = KIN(KA, I_GNB)[l * 512 + ch + j]; }
    for (int m = gw; m < mrows; m += NGW) {
        int seq0, t, Tn; seq_of_row(m, seq0, t, Tn);
        const v4u vo0 = *(const v4u*)(O0 + (size_t)m * 512 + ch), vo1 = *(const v4u*)(O1 + (size_t)m * 512 + ch);
        Sh8 sr, sk, sv; sh8_load(sr, Z, m, t, Tn, ZR + ch); sh8_load(sk, Z, m, t, Tn, ZK + ch); sh8_load(sv, Z, m, t, Tn, ZV + ch);
        const v4u va0 = *(const v4u*)(LO + (size_t)m * NLORA + 1024 + ch), va1 = *(const v4u*)(LO + (size_t)m * NLORA + 1536 + ch), vgt = *(const v4u*)(LO + (size_t)m * NLORA + 2048 + ch);
        asm volatile("" ::: "memory"); __builtin_amdgcn_sched_barrier(0);
        float o0[8], o1[8]; unpack8(vo0, o0); unpack8(vo1, o1);
        float s = 0.f;
#pragma unroll
        for (int j = 0; j < 8; ++j) { o0[j] += o1[j]; s += o0[j]; }
        const float mean = red8(s) * (1.f / 64.f); float q = 0.f;
#pragma unroll
        for (int j = 0; j < 8; ++j) { o0[j] -= mean; q += o0[j] * o0[j]; }
        const float rstd = 1.0f / sqrtf(red8(q) * (1.f / 64.f) + 64e-5f);
        float rs_[8], ks_[8], vs_[8];
        sh8_eval(sr, mu0 + ch, mu1 + ch, rs_);
        sh8_eval(sk, mu0 + 512 + ch, mu1 + 512 + ch, ks_);
        sh8_eval(sv, mu0 + 1024 + ch, mu1 + 1024 + ch, vs_);
        float a0[8], a1[8], gt[8];
        unpack8(va0, a0); unpack8(va1, a1); unpack8(vgt, gt);
        float bs = 0.f;
#pragma unroll
        for (int j = 0; j < 8; ++j) { const float kd = ks_[j] * ((1.0f + (a0[j] - 1.0f) * kaw[j]) + (1.0f + (a1[j] - 1.0f) * kaw[j])); bs += rs_[j] * kd * brk[j]; }
        bs = red8(bs);
        float out[8];
#pragma unroll
        for (int j = 0; j < 8; ++j) out[j] = (o0[j] * rstd * gg[j] + gb[j] + bs * vs_[j]) * gt[j];
        *(v4u*)(BR + (size_t)m * 1536 + 512 + ch) = pack8(out);
    }
}

__device__ __forceinline__ void sum_phase(Frame& F, int rbase, int rcount, int rblk, int rnb  ) {
    frame_refresh(F);
    rbase = __builtin_amdgcn_readfirstlane(rbase); rcount = __builtin_amdgcn_readfirstlane(rcount); rblk = __builtin_amdgcn_readfirstlane(rblk); rnb = __builtin_amdgcn_readfirstlane(rnb);
    asm volatile("" : "+s"(rbase), "+s"(rcount), "+s"(rblk), "+s"(rnb));
    unsigned char* ws = F.ws;
    const v4u* P = (const v4u*)(ws + WS_ARENA + AR_P) + (size_t)rbase * 384; v4u* U = (v4u*)(ws + WS_HB) + (size_t)rbase * 128;
    for (size_t i = (size_t)rblk * 512 + F.tid; i < (size_t)rcount * 128; i += (size_t)rnb * 512) {
        const size_t row = i >> 7, c = i & 127;
        float a[8], b[8], d[8]; unpack8(P[row * 384 + c], a); unpack8(P[row * 384 + 128 + c], b); unpack8(P[row * 384 + 256 + c], d);
#pragma unroll
        for (int j = 0; j < 8; ++j) a[j] += b[j] + d[j];
        U[i] = pack8(a);
    }
}

__device__ __forceinline__ void final_phase(Frame& F, const Args& args, int ymode, const float* gate_mod) {
    frame_refresh(F); KArgs KA = kargs();
    unsigned char* ws = F.ws;
    const int gw = F.vcu * 8 + F.wave, NGW = F.G * 8, lane = F.lane;
    const bf16* Y = (const bf16*)(ws + WS_Y); const bf16* YP = (const bf16*)(ws + WS_ARENA + AR_YP); const unsigned* RT = (const unsigned*)(ws + WS_RT);
    for (int m = gw; m < MLAT; m += NGW) {
        const int srow = m >> 13; float* xo = ((float*)(GAS float*)KA->out) + (size_t)m * D;
        unsigned r0 = 0, r1 = 0; float w0 = 0.f, w1 = 0.f;
        if (ymode == 2) { const v4u rt = *(const v4u*)(RT + (size_t)m * 8); const v4u rt2 = *(const v4u*)(RT + (size_t)m * 8 + 4); w0 = __uint_as_float(rt.z); w1 = __uint_as_float(rt.w); r0 = rt2.x; r1 = rt2.y; }
#pragma unroll
        for (int j = 0; j < 4; ++j) {
            const int col = 4 * lane + 256 * j; f32x4 v = *(const f32x4*)(xo + col); f32x4 yv;
            if (ymode == 1) { const v2u yy = *(const v2u*)(Y + (size_t)m * D + col); yv = (f32x4){bflo(yy.x), bfhi(yy.x), bflo(yy.y), bfhi(yy.y)}; }
            else { const v2u ya = *(const v2u*)(YP + (size_t)r0 * D + col), yb = *(const v2u*)(YP + (size_t)r1 * D + col);
                yv = (f32x4){w0 * bflo(ya.x) + w1 * bflo(yb.x), w0 * bfhi(ya.x) + w1 * bfhi(yb.x), w0 * bflo(ya.y) + w1 * bflo(yb.y), w0 * bfhi(ya.y) + w1 * bfhi(yb.y)}; }
            const f32x4 gt = *(const f32x4*)(gate_mod + (size_t)srow * 6 * D + col);
            *(f32x4*)(xo + col) = v + gt * yv;
        }
    }
}

template <bool FFN>
__device__ __forceinline__ void deferred_ctx_tile(Frame& F, const Args& args, int l  ) {
    frame_refresh(F);
    unsigned char* ws = F.ws; unsigned* ctl = (unsigned*)(ws + WS_CTL);
    const int bx = (int)blockIdx.x, khalf = FFN ? bx >> 3 : 0, tl = FFN ? bx & 7 : bx, panel = tl >> 2, pn = tl & 3;
    pg8::SingleSched S; S.pm = MLAT / 256 + panel; S.pn = pn;
    if (FFN) { const int j = l >> 1; S.a = (const char*)(ws + WS_ARENA + AR_ACT) + (size_t)S.pm * 256 * DFF * 2 + (size_t)khalf * (DFF / 2) * 2; S.b = (const char*)(ws + WS_W2) + (size_t)j * D * DFF * 2 + (size_t)pn * 256 * DFF * 2 + (size_t)khalf * (DFF / 2) * 2; }
    else { S.a = (const char*)(ws + WS_HB) + (size_t)S.pm * 256 * D * 2; S.b = (const char*)(ws + WS_WOUT) + (size_t)l * D * D * 2 + (size_t)pn * 256 * D * 2; }
    pg8::EpiBf16 E{khalf ? (bf16*)(ws + WS_Y2) - (size_t)MLAT * D : (bf16*)(ws + WS_Y), D};
    if (FFN) pg8::gemm_phase(F.lds, pg8::Gemm{DFF, DFF, DFF / 2}, S, E, F.wave); else pg8::gemm_phase(F.lds, pg8::Gemm{D, D, D}, S, E, F.wave);
    asm volatile("s_waitcnt vmcnt(0)" ::: "memory"); __syncthreads();
    frame_refresh(F);
    if (F.tid == 0) { unsigned* cnt = ctl + CW_DEF + ((l * 2 + (FFN ? 1 : 0)) * 2 + panel) * 64;
        __builtin_amdgcn_fence(__ATOMIC_RELEASE, "agent"); asm volatile("s_waitcnt vmcnt(0)" ::: "memory");
        __hip_atomic_fetch_add(cnt, 1u, RLX_AGENT); }
    __syncthreads();
}

__device__ __forceinline__ void deferred_ctx_branch(Frame& F, const Args& args, int l, bf16* Zb) {
    frame_refresh(F);
    unsigned char* ws = F.ws; unsigned* ctl = (unsigned*)(ws + WS_CTL);
    const int bx = (int)blockIdx.x, panel = bx / 12, pn = bx % 12;
    pg8::SingleSched S; S.pm = MLAT / 256 + panel; S.pn = pn;
    S.a = (const char*)(ws + WS_ARENA + AR_BR) + (size_t)S.pm * 256 * 1536 * 2 + (size_t)(pn / 4) * 512 * 2; S.b = (const char*)(ws + WS_WBR) + (size_t)l * 3072 * 512 * 2 + (size_t)pn * 256 * 512 * 2;
    pg8::EpiGate E{(bf16*)(ws + WS_ARENA + AR_P), Zb + ZG};
    pg8::gemm_phase(F.lds, pg8::Gemm{1536, 512, 512}, S, E, F.wave);
    asm volatile("s_waitcnt vmcnt(0)" ::: "memory"); __syncthreads();
    frame_refresh(F);
    if (F.tid == 0) { unsigned* cnt = ctl + CW_DEFB + (l * 2 + panel) * 64;
        __builtin_amdgcn_fence(__ATOMIC_RELEASE, "agent"); asm volatile("s_waitcnt vmcnt(0)" ::: "memory");
        __hip_atomic_fetch_add(cnt, 1u, RLX_AGENT);
        unsigned sp = 0; while (__hip_atomic_load(cnt, RLX_AGENT) < 12u && ++sp < (1u << 21)) __builtin_amdgcn_s_sleep(2);
        __builtin_amdgcn_fence(__ATOMIC_ACQUIRE, "agent"); asm volatile("s_waitcnt vmcnt(0)" ::: "memory"); }
    __syncthreads();
}

constexpr int NPH_LAYER = 14, PH_FINAL = 1 + DEPTH * NPH_LAYER, NPHASES = PH_FINAL + 1;
__global__ void __launch_bounds__(512, 2) mk_fwd(Args args) {
    extern __shared__ __attribute__((aligned(16))) unsigned char lds[];
    Frame F;
    F.lds = (LAS unsigned char*)lds; F.ws = args.ws;
    F.tid = threadIdx.x; F.lane = F.tid & 63; F.wave = __builtin_amdgcn_readfirstlane(F.tid >> 6);
    F.G = gridDim.x; { const int bx = blockIdx.x; F.vcu = (F.G % 8 == 0) ? (bx % 8) * (F.G / 8) + bx / 8 : bx; }
    volatile LAS unsigned* MISC = (volatile LAS unsigned*)(F.lds + MISC_OFF);
    unsigned char* ws = args.ws;
    unsigned* ctl = (unsigned*)(ws + WS_CTL);
    for (int u = F.tid; u < (LDS_BYTES - LDSCTL_OFF) / 4; u += 512) ((LAS unsigned*)(F.lds + LDSCTL_OFF))[u] = 0u;
    __syncthreads();
    XcdBarrier bar; bar.bar = ctl + CW_BAR; bar.x = 0; bar.st = nullptr;
    if (!MK_PER_PHASE) bar = xcd_barrier_post(ctl + CW_BAR, MISC + 8);
    const int lo = args.ph_lo, hi = args.ph_hi;
#define IN(k) (lo <= (k) && (k) < hi)
#define SEAM(k) do { if (!MK_PER_PHASE && IN((k) + 1)) xcd_barrier(bar, F.wave); } while (0)

    if (IN(0)) { p0_prologue(F, args); SEAM(0); }

    const float* MOD = (const float*)(ws + WS_MOD);
    bf16* Zb = (bf16*)(ws + WS_ARENA + AR_Z);
    for (int l = 0; l < DEPTH; ++l) {
        KArgs KA = kargs(); { unsigned long long w_ = (unsigned long long)ws; asm volatile("" : "+s"(w_)); ws = (unsigned char*)(GAS unsigned char*)w_; }
        const int pb = 1 + l * NPH_LAYER;
        const bool moe = (l & 1) != 0; const int j2 = l >> 1;
        const int mrows = l + 1 < DEPTH ? M : MLAT;
        const float* modl = MOD + (size_t)l * 3 * 6 * D;
        if (IN(pb + 0)) {
            const float* modp = MOD + (size_t)(l - 1) * 3 * 6 * D;
            const float* xl = l == 0 ? KIN(KA, I_X) : ((float*)(GAS float*)KA->out); const float* xc = l == 0 ? KIN(KA, I_CTX) : (const float*)(ws + WS_XSC);
            const int ymode = l == 0 ? 0 : (((l - 1) & 1) ? 2 : 1);
            if (l >= 1 && ((l - 1) & 1) == 0) {
                if (blockIdx.x < 16) deferred_ctx_tile<true>(F, args, l - 1);
                else norm_phase(F, args, xl, xc, ymode, modp + 5 * D, KIN(KA, I_NMG) + l * D, modl + 1 * D, modl + 0 * D, false, nullptr, 0, (int)blockIdx.x - 16, F.G - 16, 0, MLAT, ws + WS_HB8,
                                MLAT, MCTX, 3, ctl + CW_DEF + (((l - 1) * 2 + 1) * 2) * 64, 8u);
            } else norm_phase(F, args, xl, xc, ymode, l == 0 ? nullptr : modp + 5 * D, KIN(KA, I_NMG) + l * D, modl + 1 * D, modl + 0 * D, false, nullptr, 0, F.vcu, F.G, 0, M, ws + WS_HB8);
            SEAM(pb + 0);
        }
        if (IN(pb + 1)) {
            { pg8::DenseSched S; S.to.init(M / 256, NZB / 256, F.G, (int)blockIdx.x); S.A = (const char*)(ws + WS_HB); S.Bt = (const char*)(ws + WS_WIN) + (size_t)l * NZB * D * 2;
              S.a_tile = (size_t)256 * D * 2; S.b_tile = (size_t)256 * D * 2; S.acol_div = 1 << 20; S.acol_step = 0;
              pg8::EpiBf16 E{Zb, NZ};
              pg8::gemm_phase(F.lds, pg8::Gemm{D, D, D}, S, E, F.wave); }
            { pg8::DenseSched S; S.to.init(M / 256, NZG / 256, F.G, ((int)blockIdx.x + 32) % F.G); S.A = (const char*)(ws + WS_HB8); S.Bt = (const char*)(ws + WS_WING8) + (size_t)l * NZG * D;
              S.a_tile = (size_t)256 * D; S.b_tile = (size_t)256 * D; S.acol_div = 1 << 20; S.acol_step = 0;
              pg8::EpiBf16 E{Zb + ZG, NZ};
              pg8::gemm_phase<pg8::EpiBf16, pg8::DenseSched, true>(F.lds, pg8::Gemm{D / 2, D / 2, D / 2}, S, E, F.wave); }
            SEAM(pb + 1);
        }
        if (IN(pb + 2)) { prep_phase(F, args, l); SEAM(pb + 2); }
#pragma unroll 1
        for (int sp = 0; sp < 2; ++sp) {
            if (sp == 0 ? IN(pb + 4) : (IN(pb + 5) && blockIdx.x >= 32)) scanpre_phase(F, args, l, sp);
            if (sp == 0) { if (IN(pb + 4)) SEAM(pb + 4); }
            else if (IN(pb + 5)) {
                unsigned* spcnt = ctl + CW_SPM + l * 64;
                if (blockIdx.x < 32) { frame_refresh(F); scan3_block(F, (int)blockIdx.x, spcnt); }
                else {
                    { const int nw = ((int)blockIdx.x - 32) * 8 + F.wave;
                      if (nw % 7 == 0 && nw / 7 < 16 * SP_NMID) { asm volatile("s_waitcnt vmcnt(0)" ::: "memory"); __builtin_amdgcn_fence(__ATOMIC_RELEASE, "agent"); asm volatile("s_waitcnt vmcnt(0)" ::: "memory");
                          if (F.lane == 0) __hip_atomic_fetch_add(spcnt, 1u, RLX_AGENT); } }
                    __syncthreads();
                    nat_phase(F, args, l, (int)blockIdx.x - 32, (F.G - 32) * 8, l + 1 < DEPTH);
                }
                SEAM(pb + 5);
            }
        }
        if (IN(pb + 6)) { readout_phase(F, args, l, mrows); if (l == 2) moe_convert(F, args, 1); SEAM(pb + 6); }
        if (IN(pb + 7)) {
            pg8::DenseSched S; S.to.init(MLAT / 256, 12, F.G, (int)blockIdx.x); S.A = (const char*)(ws + WS_ARENA + AR_BR); S.Bt = (const char*)(ws + WS_WBR) + (size_t)l * 3072 * 512 * 2;
            S.a_tile = (size_t)256 * 1536 * 2; S.b_tile = (size_t)256 * 512 * 2; S.acol_div = 4; S.acol_step = 512 * 2;
            pg8::EpiGate E{(bf16*)(ws + WS_ARENA + AR_P), Zb + ZG};
            pg8::gemm_phase(F.lds, pg8::Gemm{1536, 512, 512}, S, E, F.wave);
            SEAM(pb + 7);
        }
        if (IN(pb + 8)) {
            if (l + 1 < DEPTH) {
                if (blockIdx.x < 24) { deferred_ctx_branch(F, args, l, Zb); sum_phase(F, MLAT + ((int)blockIdx.x / 12) * 256, 256, (int)blockIdx.x % 12, 12); }
                else sum_phase(F, 0, MLAT, (int)blockIdx.x - 24, F.G - 24);
            } else sum_phase(F, 0, MLAT, (int)blockIdx.x, F.G);
            SEAM(pb + 8);
        }
        if (IN(pb + 9)) {
            pg8::DenseSched S; S.to.init(MLAT / 256, D / 256, F.G, (int)blockIdx.x); S.A = (const char*)(ws + WS_HB); S.Bt = (const char*)(ws + WS_WOUT) + (size_t)l * D * D * 2;
            S.a_tile = (size_t)256 * D * 2; S.b_tile = (size_t)256 * D * 2; S.acol_div = 1 << 20; S.acol_step = 0;
            pg8::EpiBf16 E{(bf16*)(ws + WS_Y), D};
            pg8::gemm_phase(F.lds, pg8::Gemm{D, D, D}, S, E, F.wave);
            SEAM(pb + 9);
        }
        if (IN(pb + 10)) {
            if (l + 1 < DEPTH) {
                if (blockIdx.x < 8) deferred_ctx_tile<false>(F, args, l);
                else norm_phase(F, args, ((float*)(GAS float*)KA->out), (const float*)(ws + WS_XSC), 1, modl + 2 * D, KIN(KA, I_NFG) + l * D, modl + 4 * D, modl + 3 * D, moe, KIN(KA, I_ROUTER) + (size_t)j2 * D * 8, j2, (int)blockIdx.x - 8, F.G - 8, 0, MLAT, nullptr,
                                MLAT, MCTX, 1, ctl + CW_DEF + ((l * 2 + 0) * 2) * 64, 4u);
            } else norm_phase(F, args, ((float*)(GAS float*)KA->out), (const float*)(ws + WS_XSC), 1, modl + 2 * D, KIN(KA, I_NFG) + l * D, modl + 4 * D, modl + 3 * D, moe, KIN(KA, I_ROUTER) + (size_t)j2 * D * 8, j2, F.vcu, F.G, 0, MLAT);
            SEAM(pb + 10);
        }
        if (IN(pb + 11)) { if (moe) { moe_perm_phase(F, j2, mrows); SEAM(pb + 11); } }
        if (IN(pb + 12)) {
            if (moe) {
                pg8::GroupSched S; S.a_tile = (size_t)256 * D; S.b_tile = (size_t)256 * D; S.b_exp = (size_t)NF1 * D;
                unsigned cnt[8];
#pragma unroll
                for (int e = 0; e < 8; ++e) cnt[e] = ctl[CW_MOE + j2 * 64 + e];
                moe_prefix(cnt, S.pe); S.A = (const char*)(ws + WS_ARENA + AR_HP); S.Bt = (const char*)(ws + WS_MW13); S.to.init(S.pe[8], NF1 / 256, F.G, (int)blockIdx.x);
                pg8::EpiSwiglu8 E{ws + WS_ARENA + AR_ACT};
                pg8::gemm_phase<pg8::EpiSwiglu8, pg8::GroupSched, true>(F.lds, pg8::Gemm{D / 2, D / 2, D / 2}, S, E, F.wave);
            } else {
                pg8::GroupSched S; S.a_tile = (size_t)256 * D * 2; S.b_tile = (size_t)256 * D * 2; S.b_exp = (size_t)NF1 * D * 2;
#pragma unroll
                for (int e = 0; e < 9; ++e) S.pe[e] = e == 0 ? 0 : M / 256;
                S.A = (const char*)(ws + WS_HB); S.Bt = (const char*)(ws + WS_W13) + (size_t)j2 * NF1 * D * 2; S.to.init(M / 256, NF1 / 256, F.G, (int)blockIdx.x);
                pg8::EpiSwiglu E{(bf16*)(ws + WS_ARENA + AR_ACT)};
                pg8::gemm_phase(F.lds, pg8::Gemm{D, D, D}, S, E, F.wave);
            }
            SEAM(pb + 12);
        }
        if (IN(pb + 13)) {
            if (moe) {
                pg8::GroupSched S; S.a_tile = (size_t)256 * DFF; S.b_tile = (size_t)256 * DFF; S.b_exp = (size_t)D * DFF;
                unsigned cnt[8];
#pragma unroll
                for (int e = 0; e < 8; ++e) cnt[e] = ctl[CW_MOE + j2 * 64 + e];
                moe_prefix(cnt, S.pe); S.A = (const char*)(ws + WS_ARENA + AR_ACT); S.Bt = (const char*)(ws + WS_MW2); S.to.init(S.pe[8], D / 256, F.G, (int)blockIdx.x);
                pg8::EpiBf16 E{(bf16*)(ws + WS_ARENA + AR_YP), D};
                pg8::gemm_phase<pg8::EpiBf16, pg8::GroupSched, true>(F.lds, pg8::Gemm{DFF / 2, DFF / 2, DFF / 2}, S, E, F.wave);
            } else {
                pg8::GroupSched S; S.a_tile = (size_t)256 * DFF * 2; S.b_tile = (size_t)256 * DFF * 2; S.b_exp = (size_t)D * DFF * 2;
#pragma unroll
                for (int e = 0; e < 9; ++e) S.pe[e] = e == 0 ? 0 : M / 256;
                S.A = (const char*)(ws + WS_ARENA + AR_ACT); S.Bt = (const char*)(ws + WS_W2) + (size_t)j2 * D * DFF * 2; S.to.init(MLAT / 256, D / 256, F.G, (int)blockIdx.x);
                pg8::EpiBf16 E{(bf16*)(ws + WS_Y), D};
                pg8::gemm_phase(F.lds, pg8::Gemm{DFF, DFF, DFF}, S, E, F.wave);
            }
            SEAM(pb + 13);
        }
    }
    if (IN(PH_FINAL)) { final_phase(F, args, ((DEPTH - 1) & 1) ? 2 : 1, MOD + (size_t)(DEPTH - 1) * 3 * 6 * D + 5 * D); }
#undef IN
#undef SEAM
}

extern "C" void kernel_launch(void* const* d_in, const int* in_sizes, int n_in, void* d_out, int out_size, void* d_ws, size_t ws_size, hipStream_t stream) {
    static int grid = 0;
    if (grid == 0) {
        if (n_in != 34 || out_size != MLAT * D || ws_size < WS_END) { fprintf(stderr, "kernel_launch: unexpected shapes (n_in %d, out %d, ws %zu < %zu)\n", n_in, out_size, ws_size, (size_t)WS_END); grid = -1; return; }
        int dev = 0, cus = 0, per_cu = 0;
        if (hipGetDevice(&dev) != hipSuccess || hipDeviceGetAttribute(&cus, hipDeviceAttributeMultiprocessorCount, dev) != hipSuccess) { grid = -1; return; }
        if (hipFuncSetAttribute((const void*)mk_fwd, hipFuncAttributeMaxDynamicSharedMemorySize, LDS_BYTES) != hipSuccess) { fprintf(stderr, "kernel_launch: hipFuncSetAttribute failed\n"); grid = -1; return; }
        if (hipOccupancyMaxActiveBlocksPerMultiprocessor(&per_cu, (const void*)mk_fwd, 512, LDS_BYTES) != hipSuccess || per_cu < 1) fprintf(stderr, "kernel_launch: occupancy query says %d\n", per_cu);
        (void)hipGetLastError();
        if (cus != 256) { fprintf(stderr, "kernel_launch: this kernel is laid out for 256 CUs (found %d)\n", cus); grid = -1; return; }
        grid = cus;
    }
    if (grid < 0) return;
    if (hipMemsetAsync((char*)d_ws + WS_CTL, 0, CTL_ZERO_BYTES, stream) != hipSuccess) return;
    Args a{};
    for (int i = 0; i < 34; ++i) a.in[i] = (const float*)d_in[i];
    a.out = (float*)d_out; a.ws = (unsigned char*)d_ws;
#if MK_PER_PHASE
    for (int p = 0; p < NPHASES; ++p) { a.ph_lo = p; a.ph_hi = p + 1; hipLaunchKernelGGL(mk_fwd, dim3(grid), dim3(512), LDS_BYTES, stream, a); }
#else
    a.ph_lo = 0; a.ph_hi = NPHASES;
    hipLaunchKernelGGL(mk_fwd, dim3(grid), dim3(512), LDS_BYTES, stream, a);
#endif
}
```
